# Optimizing an MI355X kernel written in HIP

```python
import math
import jax, jax.numpy as jnp
from jax import lax
import numpy as np

D_MODEL = 2048
BATCH = 1
SEQ = 8192
DEPTH = 1

CHUNK = 64
N_META = 16
META_PAD = (-N_META) % CHUNK
Q_BLOCK = 128
PAD_CHUNK = 2 ** 30
M_HEADS = 4
M_DQK = 128
M_DV = 256
M_QK = M_HEADS * M_DQK
M_V = M_HEADS * M_DV
CONV_W = 4
A_HEADS = 8
A_DH = 64
A_DV = 2 * A_DH
A_QK = A_HEADS * 2 * A_DH
A_V = A_HEADS * A_DV
ROT_DIM = A_DH // 4
ROPE_THETA = 500000.0
D_FF = 5632
EPS = 1e-6
IN_SPLITS = (M_QK, M_QK, M_V, M_V, M_HEADS, M_HEADS, A_QK, A_QK, A_V, D_MODEL, D_MODEL)
N_IN = sum(IN_SPLITS)
F_GATE_OFFSET = 2 * M_QK + 2 * M_V + M_HEADS

kernel_name = "hybrid_mlstm_diffattn_macaron_block"


def rmsnorm(x, g):
    xf = x.astype(jnp.float32)
    xf = xf * lax.rsqrt(jnp.mean(xf * xf, axis=-1, keepdims=True) + EPS)
    return xf.astype(x.dtype) * g


def head_rmsnorm(t, g):
    H, d = t.shape[-2], t.shape[-1]
    return rmsnorm(t, g.reshape(H, d))


def swiglu(x, w_gate, w_up, w_down):
    return (jax.nn.silu(x @ w_gate) * (x @ w_up)) @ w_down


def causal_depthwise_conv(x, w, b):
    K, C = w.shape
    y = lax.conv_general_dilated(x, w[:, None, :].astype(x.dtype), window_strides=(1,),
                                 padding=[(K - 1, 0)], dimension_numbers=('NWC', 'WIO', 'NWC'),
                                 feature_group_count=C)
    return y + b


def chunk_ids(L):
    p = jnp.arange(L, dtype=jnp.int32)
    return jnp.where(p < N_META, 0, 1 + (p - N_META) // CHUNK).astype(jnp.int32)


def rope_tables(L):
    inv_freq = ROPE_THETA ** (-jnp.arange(0, ROT_DIM, 2, dtype=jnp.float32) / ROT_DIM)
    ang = jnp.arange(L, dtype=jnp.float32)[:, None] * inv_freq[None, :]
    return jnp.cos(ang), jnp.sin(ang)


def partial_rope(x, cos, sin):
    half = ROT_DIM // 2
    x1 = x[..., :half].astype(jnp.float32)
    x2 = x[..., half:ROT_DIM].astype(jnp.float32)
    r1 = x1 * cos - x2 * sin
    r2 = x2 * cos + x1 * sin
    return jnp.concatenate([r1.astype(x.dtype), r2.astype(x.dtype), x[..., ROT_DIM:]], axis=-1)


def mlstm_chunkwise(q, k, v, log_i, log_f):
    out_dtype = v.dtype
    f32 = jnp.float32
    q, k, v = q.astype(f32), k.astype(f32), v.astype(f32)
    log_i, log_f = log_i.astype(f32), log_f.astype(f32)
    B, H, L, dk = q.shape
    dv = v.shape[-1]
    pw = ((0, 0), (0, 0), (META_PAD, 0))
    q = jnp.pad(q, pw + ((0, 0),))
    k = jnp.pad(k, pw + ((0, 0),))
    v = jnp.pad(v, pw + ((0, 0),))
    log_i = jnp.pad(log_i, pw, constant_values=-jnp.inf)
    log_f = jnp.pad(log_f, pw)
    Lm = L + META_PAD
    nc = Lm // CHUNK
    to_chunks = lambda t: jnp.moveaxis(t.reshape(B, H, nc, CHUNK, *t.shape[3:]), 2, 0)
    qc, kc, vc, lic = to_chunks(q), to_chunks(k), to_chunks(v), to_chunks(log_i)
    bc = jnp.cumsum(to_chunks(log_f), axis=-1)
    tril = jnp.tril(jnp.ones((CHUNK, CHUNK), dtype=bool))

    def step(carry, inp):
        C, n, m = carry
        qi, ki, vi, li, bi = inp
        g = bi[..., -1]
        logD = jnp.where(tril, bi[..., :, None] - bi[..., None, :] + li[..., None, :], -jnp.inf)
        m_inter = bi + m[..., None]
        m_row = jnp.maximum(m_inter, jnp.max(logD, axis=-1))
        w_inter = jnp.exp(m_inter - m_row)
        s = jnp.einsum('bhid,bhjd->bhij', qi, ki) * jnp.exp(logD - m_row[..., None])
        num = w_inter[..., None] * jnp.einsum('bhid,bhde->bhie', qi, C) + jnp.einsum('bhij,bhje->bhie', s, vi)
        den = w_inter * jnp.einsum('bhid,bhd->bhi', qi, n) + jnp.sum(s, axis=-1)
        h = num / jnp.maximum(jnp.abs(den), jnp.exp(-m_row))[..., None]
        log_w = g[..., None] - bi + li
        m_new = jnp.maximum(g + m, jnp.max(log_w, axis=-1))
        wk = jnp.exp(log_w - m_new[..., None])
        decay = jnp.exp(g + m - m_new)
        C_new = decay[..., None, None] * C + jnp.einsum('bhj,bhjd,bhje->bhde', wk, ki, vi)
        n_new = decay[..., None] * n + jnp.einsum('bhj,bhjd->bhd', wk, ki)
        return (C_new, n_new, m_new), h

    init = (jnp.zeros((B, H, dk, dv), f32), jnp.zeros((B, H, dk), f32), jnp.zeros((B, H), f32))
    _, hs = lax.scan(step, init, (qc, kc, vc, lic, bc))
    hs = jnp.moveaxis(hs, 0, 2).reshape(B, H, Lm, dv)[:, :, META_PAD:]
    return hs.astype(out_dtype)


def diff_attention(q, k, v, lam, cid):
    B, H, _, L, dh = q.shape
    Lp = -(-L // Q_BLOCK) * Q_BLOCK
    pad = Lp - L
    q = jnp.pad(q, ((0, 0), (0, 0), (0, 0), (0, pad), (0, 0)))
    k = jnp.pad(k, ((0, 0), (0, 0), (0, 0), (0, pad), (0, 0)))
    v = jnp.pad(v, ((0, 0), (0, 0), (0, pad), (0, 0)))
    cidp = jnp.concatenate([cid, jnp.full((pad,), PAD_CHUNK, cid.dtype)])
    nqb = Lp // Q_BLOCK
    qb = q.reshape(B, H, 2, nqb, Q_BLOCK, dh).transpose(3, 0, 1, 2, 4, 5)
    cqb = cidp.reshape(nqb, Q_BLOCK)
    scale = dh ** -0.5

    def block(args):
        qi, ci = args
        s = jnp.einsum('bhmqd,bhmkd->bhmqk', qi, k).astype(jnp.float32) * scale
        vis = cidp[None, :] <= ci[:, None]
        p = jax.nn.softmax(jnp.where(vis, s, -jnp.inf), axis=-1)
        a = p[:, :, 0] - lam * p[:, :, 1]
        return jnp.einsum('bhqk,bhke->bhqe', a.astype(v.dtype), v)

    o = lax.map(block, (qb, cqb))
    return o.transpose(1, 2, 0, 3, 4).reshape(B, H, Lp, -1)[:, :, :L]


def lambda_init_fn(layer):
    return 0.8 - 0.6 * math.exp(-0.3 * layer)


def hybrid_mixer(u, w_in, b_in, conv_w, conv_b, m_norm_g, m_w_branch, lq1, lk1, lq2, lk2,
                 a_norm_g, a_w_branch, w_out, cos, sin, cid, lam_init):
    B, L, _ = u.shape
    z = u @ w_in + b_in
    split_idx = [int(i) for i in np.cumsum(IN_SPLITS)[:-1]]
    mq, mk, mv, mo, mi, mf, aq, ak, av, gm, ga = jnp.split(z, split_idx, axis=-1)
    qk = jax.nn.silu(causal_depthwise_conv(jnp.concatenate([mq, mk], axis=-1), conv_w, conv_b))
    mq, mk = jnp.split(qk, 2, axis=-1)
    q = mq.reshape(B, L, M_HEADS, M_DQK).transpose(0, 2, 1, 3)
    k = mk.reshape(B, L, M_HEADS, M_DQK).transpose(0, 2, 1, 3) * (M_DQK ** -0.5)
    v = mv.reshape(B, L, M_HEADS, M_DV).transpose(0, 2, 1, 3)
    log_i = mi.transpose(0, 2, 1)
    log_f = jax.nn.log_sigmoid(mf.astype(jnp.float32)).transpose(0, 2, 1)
    hm = mlstm_chunkwise(q, k, v, log_i, log_f)
    hm = head_rmsnorm(hm.transpose(0, 2, 1, 3), m_norm_g).reshape(B, L, M_V)
    br_m = (jax.nn.sigmoid(mo) * hm) @ m_w_branch
    aq = partial_rope(aq.reshape(B, L, A_HEADS, 2, A_DH).transpose(0, 2, 3, 1, 4), cos, sin)
    ak = partial_rope(ak.reshape(B, L, A_HEADS, 2, A_DH).transpose(0, 2, 3, 1, 4), cos, sin)
    av = av.reshape(B, L, A_HEADS, A_DV).transpose(0, 2, 1, 3)
    f32 = jnp.float32
    lam = (jnp.exp(jnp.sum(lq1.astype(f32) * lk1.astype(f32)))
           - jnp.exp(jnp.sum(lq2.astype(f32) * lk2.astype(f32))) + lam_init)
    ha = diff_attention(aq, ak, av, lam, cid)
    ha = (head_rmsnorm(ha.transpose(0, 2, 1, 3), a_norm_g) * (1.0 - lam_init)).reshape(B, L, A_V)
    br_a = ha @ a_w_branch
    y = jax.nn.sigmoid(gm) * br_m + jax.nn.sigmoid(ga) * br_a
    return y @ w_out


def setup_inputs(seed: int = 0) -> dict:
    key = jax.random.key(seed)
    ks = jax.random.split(key, 32)
    f32 = jnp.float32
    nrm = lambda k, shape, scale: jax.random.normal(k, shape, f32) * scale
    gain = lambda k, shape: 1.0 + 0.02 * jax.random.normal(k, shape, f32)
    b_in = nrm(ks[11], (DEPTH, N_IN), 0.02)
    f_bias = jnp.linspace(3.0, 6.0, M_HEADS, dtype=f32)
    b_in = b_in.at[:, F_GATE_OFFSET:F_GATE_OFFSET + M_HEADS].add(f_bias)
    return {
        "x": nrm(ks[0], (BATCH, SEQ, D_MODEL), 1.0),
        "meta": nrm(ks[1], (N_META, D_MODEL), 1.0),
        "ffn1_pre_g": gain(ks[2], (DEPTH, D_MODEL)),
        "ffn1_post_g": gain(ks[3], (DEPTH, D_MODEL)),
        "ffn1_w_gate": nrm(ks[4], (DEPTH, D_MODEL, D_FF), D_MODEL ** -0.5),
        "ffn1_w_up": nrm(ks[5], (DEPTH, D_MODEL, D_FF), D_MODEL ** -0.5),
        "ffn1_w_down": nrm(ks[6], (DEPTH, D_FF, D_MODEL), D_FF ** -0.5),
        "mix_pre_g": gain(ks[7], (DEPTH, D_MODEL)),
        "mix_post_g": gain(ks[8], (DEPTH, D_MODEL)),
        "w_in": nrm(ks[9], (DEPTH, D_MODEL, N_IN), D_MODEL ** -0.5),
        "b_in": b_in,
        "m_conv_w": nrm(ks[12], (DEPTH, CONV_W, 2 * M_QK), CONV_W ** -0.5),
        "m_conv_b": nrm(ks[13], (DEPTH, 2 * M_QK), 0.02),
        "m_norm_g": gain(ks[14], (DEPTH, M_V)),
        "m_w_branch": nrm(ks[15], (DEPTH, M_V, D_MODEL), M_V ** -0.5),
        "a_lambda_q1": nrm(ks[16], (DEPTH, A_DH), 0.1),
        "a_lambda_k1": nrm(ks[17], (DEPTH, A_DH), 0.1),
        "a_lambda_q2": nrm(ks[18], (DEPTH, A_DH), 0.1),
        "a_lambda_k2": nrm(ks[19], (DEPTH, A_DH), 0.1),
        "a_norm_g": gain(ks[20], (DEPTH, A_V)),
        "a_w_branch": nrm(ks[21], (DEPTH, A_V, D_MODEL), A_V ** -0.5),
        "w_out": nrm(ks[22], (DEPTH, D_MODEL, D_MODEL), D_MODEL ** -0.5),
        "ffn2_pre_g": gain(ks[23], (DEPTH, D_MODEL)),
        "ffn2_post_g": gain(ks[24], (DEPTH, D_MODEL)),
        "ffn2_w_gate": nrm(ks[25], (DEPTH, D_MODEL, D_FF), D_MODEL ** -0.5),
        "ffn2_w_up": nrm(ks[26], (DEPTH, D_MODEL, D_FF), D_MODEL ** -0.5),
        "ffn2_w_down": nrm(ks[27], (DEPTH, D_FF, D_MODEL), D_FF ** -0.5),
    }


def reference(x, meta, ffn1_pre_g, ffn1_post_g, ffn1_w_gate, ffn1_w_up, ffn1_w_down,
              mix_pre_g, mix_post_g, w_in, b_in, m_conv_w, m_conv_b, m_norm_g, m_w_branch,
              a_lambda_q1, a_lambda_k1, a_lambda_q2, a_lambda_k2, a_norm_g, a_w_branch, w_out,
              ffn2_pre_g, ffn2_post_g, ffn2_w_gate, ffn2_w_up, ffn2_w_down):
    B = x.shape[0]
    h = jnp.concatenate([jnp.broadcast_to(meta[None].astype(x.dtype), (B, N_META, D_MODEL)), x], axis=1)
    L = h.shape[1]
    cid = chunk_ids(L)
    cos, sin = rope_tables(L)
    for l in range(DEPTH):
        u = rmsnorm(h, ffn1_pre_g[l])
        h = h + 0.5 * rmsnorm(swiglu(u, ffn1_w_gate[l], ffn1_w_up[l], ffn1_w_down[l]), ffn1_post_g[l])
        u = rmsnorm(h, mix_pre_g[l])
        y = hybrid_mixer(u, w_in[l], b_in[l], m_conv_w[l], m_conv_b[l], m_norm_g[l], m_w_branch[l],
                         a_lambda_q1[l], a_lambda_k1[l], a_lambda_q2[l], a_lambda_k2[l],
                         a_norm_g[l], a_w_branch[l], w_out[l], cos, sin, cid, lambda_init_fn(l))
        h = h + rmsnorm(y, mix_post_g[l])
        u = rmsnorm(h, ffn2_pre_g[l])
        h = h + 0.5 * rmsnorm(swiglu(u, ffn2_w_gate[l], ffn2_w_up[l], ffn2_w_down[l]), ffn2_post_g[l])
    return h[:, N_META:]
```

```cpp
#include <hip/hip_runtime.h>
#include <cstdio>
#include <cstdint>

constexpr int DM = 2048, SEQ = 8192, NMETA = 16, DFF = 5632, NUP = 2 * DFF, NIN = 10240, NIN_SRC = 10248;
constexpr int MP = 8448, ROW_X0 = 256, ROW_META0 = 240, ROW_PAD0 = 192, NCHUNK = 129;
constexpr float EPS = 1e-6f;
constexpr float QSCALE = 0.125f * 1.4426950408889634f;

constexpr size_t MiB = 1u << 20;
constexpr size_t WS_CTL = 0, CTL_ZERO_BYTES = 1 * MiB;
constexpr size_t WS_ROPE = 1 * MiB;
constexpr size_t WS_BIAS = 2 * MiB;
constexpr size_t WS_GW = 2 * MiB + 64 * 1024;
constexpr size_t WS_METAH = 2 * MiB + 256 * 1024;
constexpr size_t WS_GATES = 3 * MiB;
constexpr size_t WS_WUP = 4 * MiB;
constexpr size_t WS_WDN = 48 * MiB;
constexpr size_t WS_WIN = 70 * MiB;
constexpr size_t WS_WMB = 110 * MiB;
constexpr size_t WS_WAB = 114 * MiB;
constexpr size_t WS_WOUT = 118 * MiB;
constexpr size_t WS_XA = 126 * MiB;
constexpr size_t WS_U = 159 * MiB;
constexpr size_t WS_HID = WS_U;
constexpr size_t WS_Y = WS_U + 91 * MiB;
constexpr size_t WS_Z = WS_U;
constexpr size_t ZPIECE = (size_t)MP * 1024;
constexpr size_t WS_YG = WS_U;
constexpr size_t WS_HMG = 324 * MiB;
constexpr size_t WS_HA = WS_HMG + (size_t)MP * 1024 * 2;
constexpr size_t WS_HM = 357 * MiB;
constexpr size_t WS_END = 390 * MiB;
static_assert(WS_WUP + (size_t)NUP * DM * 2 <= WS_WDN && WS_WDN + (size_t)DM * DFF * 2 <= WS_WIN && WS_WIN + (size_t)NIN * DM * 2 <= WS_WMB, "ws map 1");
static_assert(WS_XA + (size_t)MP * DM * 2 <= WS_U && WS_HID + (size_t)MP * DFF * 2 <= WS_Y && WS_Y + (size_t)MP * DM * 4 <= WS_HMG, "ws map 2");
static_assert(WS_Z + (6 * ZPIECE + 2 * (size_t)MP * 2048) * 2 <= WS_HMG && WS_HA + (size_t)MP * 1024 * 2 <= WS_HM && WS_HM + (size_t)MP * 1024 * 4 <= WS_END, "ws map 3");
static_assert(WS_YG + (size_t)MP * 2048 * 2 <= WS_Y, "YG must not overlap Y");
constexpr int CW_BAR = 4096;

namespace pg8 {
#define PG8_LAS __attribute__((address_space(3)))
typedef unsigned short bf16_t;
typedef short bf16x8 __attribute__((ext_vector_type(8)));
typedef float f32x4 __attribute__((ext_vector_type(4)));
typedef unsigned u32x4 __attribute__((ext_vector_type(4)));
constexpr int BM = 256, BK = 64, HALF = 128, HTB = HALF * BK * 2  , STAGE_BYTES = 8 * HTB, NXCD = 8, WGM = 8;

__host__ __device__ __forceinline__ int lds_byte(int r, int c) { const int st = (r >> 4) * 2 + (c >> 5), rr = r & 15, cc = c & 31, ob = rr * 64 + cc * 2; return st * 1024 + (ob ^ (((ob >> 9) & 1) << 5)); }
__host__ __device__ __forceinline__ void stage_rc(int b, int& R, int& C) { const int st = b / 1024, sb = b % 1024, swz = sb ^ (((sb >> 9) & 1) << 5); R = (st >> 1) * 16 + swz / 64; C = (st & 1) * 32 + (swz % 64) / 2; }
__host__ __device__ __forceinline__ int perm32(int rho) { const int n = rho >> 4, i = rho & 15; return 8 * (i >> 2) + 4 * n + (i & 3); }

struct Unit { int pm, pn; };
struct Gemm { const bf16_t* A; const bf16_t* Bt; int M, N, K; };

struct StaticOrder {
    int nM, nN, nwg, G, c;
    __host__ __device__ void init(int M, int N, int G_, int c_) { nM = M / BM; nN = N / BM; nwg = nM * nN; G = G_; c = c_; }
    __host__ __device__ bool next(int i, Unit& u) const {
        const long L = (long)i * G + c; if (L >= nwg) return false;
        int wgid = (int)L; { const int q = nwg / NXCD, r = nwg % NXCD, xcd = wgid % NXCD, off = wgid / NXCD; wgid = (xcd < r ? xcd * (q + 1) : r * (q + 1) + (xcd - r) * q) + off; }
        const int nig = WGM * nN, gid = wgid / nig, fm = gid * WGM, gsz = (nM - fm) < WGM ? (nM - fm) : WGM;
        u.pm = fm + ((wgid % nig) % gsz); u.pn = (wgid % nig) / gsz; return true;
    }
    __device__ __forceinline__ void a_ready(const Unit&) const {}
    __device__ __forceinline__ void done(const Unit&) const {}
};

__device__ __forceinline__ unsigned cvt_pk_bf16(float lo, float hi) { unsigned r; asm volatile("v_cvt_pk_bf16_f32 %0, %1, %2" : "=v"(r) : "v"(lo), "v"(hi)); return r; }
typedef float f32x2 __attribute__((ext_vector_type(2)));
__device__ __forceinline__ float sigm(float x) { return __builtin_amdgcn_rcpf(1.0f + __expf(-x)); }
__device__ __forceinline__ float bflo(unsigned w) { return __uint_as_float(w << 16); }
__device__ __forceinline__ float bfhi(unsigned w) { return __uint_as_float(w & 0xffff0000u); }

struct EpiF32 {
    static constexpr bool PERM = false, AFTER_DRAIN = false;
    float* C; int ldc;
    __device__ __forceinline__ void operator()(const f32x4 (&acc)[2][2][4][2], const Unit& u, int wr, int wc, int fr, int fq) const {
        const int row0 = u.pm * BM + wr * 64 + fr, col0 = u.pn * BM + wc * 32 + 4 * fq;
#pragma unroll
        for (int ai = 0; ai < 2; ++ai)
#pragma unroll
            for (int m = 0; m < 4; ++m) { float* rowp = C + (size_t)(row0 + ai * HALF + m * 16) * ldc + col0;
#pragma unroll
                for (int bj = 0; bj < 2; ++bj)
#pragma unroll
                    for (int n = 0; n < 2; ++n) *(f32x4*)(rowp + bj * HALF + n * 16) = acc[ai][bj][m][n]; }
    }
};

struct EpiSwiglu {
    static constexpr bool PERM = true, AFTER_DRAIN = false;
    bf16_t* O; int ldc;
    __device__ __forceinline__ void operator()(const f32x4 (&acc)[2][2][4][2], const Unit& u, int wr, int wc, int fr, int fq) const {
        const int row0 = u.pm * BM + wr * 64 + fr, col0 = u.pn * HALF + wc * 32 + 8 * fq;
#pragma unroll
        for (int ai = 0; ai < 2; ++ai)
#pragma unroll
            for (int m = 0; m < 4; ++m) { bf16_t* rowp = O + (size_t)(row0 + ai * HALF + m * 16) * ldc + col0;
                const f32x4 g0 = acc[ai][0][m][0], g1 = acc[ai][0][m][1], u0 = acc[ai][1][m][0], u1 = acc[ai][1][m][1];
                float r[8];
#pragma unroll
                for (int i = 0; i < 4; ++i) { r[i] = g0[i] * sigm(g0[i]) * u0[i]; r[4 + i] = g1[i] * sigm(g1[i]) * u1[i]; }
                u32x4 w; w.x = cvt_pk_bf16(r[0], r[1]); w.y = cvt_pk_bf16(r[2], r[3]); w.z = cvt_pk_bf16(r[4], r[5]); w.w = cvt_pk_bf16(r[6], r[7]);
                *(u32x4*)rowp = w; }
    }
};

struct EpiZ {
    static constexpr bool PERM = true, AFTER_DRAIN = false;
    bf16_t* Z; const float* bias; const float* rope;
    __device__ __forceinline__ void operator()(const f32x4 (&acc)[2][2][4][2], const Unit& u, int wr, int wc, int fr, int fq) const {
        const int pn = u.pn, row0 = u.pm * BM + wr * 64 + fr;
        bf16_t* base; int ldc, colt;
        if (pn < 24) { base = Z + (size_t)(pn >> 2) * ZPIECE; ldc = 1024; colt = (pn & 3) * 256; }
        else { const int q = pn - 24; base = Z + 6 * ZPIECE + (size_t)(q >> 3) * ((size_t)MP * 2048); ldc = 2048; colt = (q & 7) * 256; }
        const int mode = ((pn >= 8 && pn < 12) || pn >= 24) ? 1 : ((pn >= 12 && pn < 20) ? 2 : 0);
        const float qs = (pn >= 12 && pn < 16) ? QSCALE : 1.0f;
        const int col0 = colt + wc * 32 + 8 * fq, bcol0 = pn * BM + wc * 32 + 8 * fq;
        f32x4 bv[2][2];
#pragma unroll
        for (int bj = 0; bj < 2; ++bj)
#pragma unroll
            for (int n = 0; n < 2; ++n) bv[bj][n] = *(const f32x4*)(bias + bcol0 + bj * HALF + 4 * n);
        const bool rot = ((wc & 1) == 0) && (fq < 2);
        const float sgn = (fq == 0) ? -1.0f : 1.0f;
#pragma unroll
        for (int ai = 0; ai < 2; ++ai)
#pragma unroll
            for (int m = 0; m < 4; ++m) { const int row = row0 + ai * HALF + m * 16; bf16_t* rowp = base + (size_t)row * ldc + col0;
#pragma unroll
                for (int bj = 0; bj < 2; ++bj) { f32x4 v0 = acc[ai][bj][m][0] + bv[bj][0], v1 = acc[ai][bj][m][1] + bv[bj][1];
                    if (mode == 1) {
#pragma unroll
                        for (int i = 0; i < 4; ++i) { v0[i] = sigm(v0[i]); v1[i] = sigm(v1[i]); }
                    } else if (mode == 2) {
                        f32x4 p0, p1;
#pragma unroll
                        for (int i = 0; i < 4; ++i) { p0[i] = __shfl_xor(v0[i], 16); p1[i] = __shfl_xor(v1[i], 16); }
                        if (rot) { int pos = row - ROW_META0; pos = pos < 0 ? 0 : pos; const float* rp = rope + (size_t)pos * 16;
                            const f32x4 c0 = *(const f32x4*)(rp), c1 = *(const f32x4*)(rp + 4), s0 = *(const f32x4*)(rp + 8), s1 = *(const f32x4*)(rp + 12);
#pragma unroll
                            for (int i = 0; i < 4; ++i) { v0[i] = v0[i] * c0[i] + sgn * p0[i] * s0[i]; v1[i] = v1[i] * c1[i] + sgn * p1[i] * s1[i]; } }
                        v0 = v0 * qs; v1 = v1 * qs;
                    }
                    u32x4 w; w.x = cvt_pk_bf16(v0[0], v0[1]); w.y = cvt_pk_bf16(v0[2], v0[3]); w.z = cvt_pk_bf16(v1[0], v1[1]); w.w = cvt_pk_bf16(v1[2], v1[3]);
                    *(u32x4*)(rowp + bj * HALF) = w; } }
    }
};

struct EpiGate {
    static constexpr bool PERM = true, AFTER_DRAIN = false;
    const bf16_t* G; bf16_t* O; int ldc; int accum;
    __device__ __forceinline__ void operator()(const f32x4 (&acc)[2][2][4][2], const Unit& u, int wr, int wc, int fr, int fq) const {
        const int row0 = u.pm * BM + wr * 64 + fr, col0 = u.pn * BM + wc * 32 + 8 * fq;
#pragma unroll
        for (int ai = 0; ai < 2; ++ai)
#pragma unroll
            for (int m = 0; m < 4; ++m) { const size_t off = (size_t)(row0 + ai * HALF + m * 16) * ldc + col0;
#pragma unroll
                for (int bj = 0; bj < 2; ++bj) { const u32x4 gw = *(const u32x4*)(G + off + bj * HALF);
                    f32x4 v0 = acc[ai][bj][m][0], v1 = acc[ai][bj][m][1];
                    v0[0] *= bflo(gw.x); v0[1] *= bfhi(gw.x); v0[2] *= bflo(gw.y); v0[3] *= bfhi(gw.y);
                    v1[0] *= bflo(gw.z); v1[1] *= bfhi(gw.z); v1[2] *= bflo(gw.w); v1[3] *= bfhi(gw.w);
                    if (accum) { const u32x4 ow = *(const u32x4*)(O + off + bj * HALF);
                        v0[0] += bflo(ow.x); v0[1] += bfhi(ow.x); v0[2] += bflo(ow.y); v0[3] += bfhi(ow.y);
                        v1[0] += bflo(ow.z); v1[1] += bfhi(ow.z); v1[2] += bflo(ow.w); v1[3] += bfhi(ow.w); }
                    u32x4 w; w.x = cvt_pk_bf16(v0[0], v0[1]); w.y = cvt_pk_bf16(v0[2], v0[3]); w.z = cvt_pk_bf16(v1[0], v1[1]); w.w = cvt_pk_bf16(v1[2], v1[3]);
                    *(u32x4*)(O + off + bj * HALF) = w; } }
    }
};

template <class Epi, class Sched, bool ALIGN_EPI = false, bool SP2 = false>
__device__ __forceinline__ void gemm_phase(PG8_LAS unsigned char* lds, const Gemm g, const Sched& S, const Epi& E) {
    int tid_ = threadIdx.x; asm volatile("" : "+v"(tid_));
    const int tid = tid_, wid = __builtin_amdgcn_readfirstlane(tid >> 6), lane = tid & 63, wr = wid >> 2, wc = wid & 3, fr = lane & 15, fq = lane >> 4;
    const int K = g.K, nt = K / BK;
    unsigned voffA[2], voffB[2];
#pragma unroll
    for (int i = 0; i < 2; ++i) { int R, C; stage_rc(tid * 16 + i * 8192, R, C); const int Rb = Epi::PERM ? ((R & ~31) + perm32(R & 31)) : R;
        voffA[i] = (unsigned)(R * K + C) * 2u; voffB[i] = (unsigned)(Rb * K + C) * 2u; }
    const size_t kstep = (size_t)(BK * 2);
    const size_t hstep = (size_t)HALF * K * 2;
    const size_t tstep = 2 * hstep;
    const unsigned ldsw = (unsigned)wid * 1024u;
    const int aoff = lds_byte(wr * 64 + fr, fq * 8), boff = lds_byte(wc * 32 + fr, fq * 8);
#define PG8_SA(b, h) (((b) * 2 + (h)) * HTB)
#define PG8_SB(b, h) ((4 + (b) * 2 + (h)) * HTB)
#define PG8_STAGE(bufoff, gbase, voff) do { _Pragma("unroll") for (int _i = 0; _i < 2; ++_i) \
        __builtin_amdgcn_global_load_lds((const unsigned*)((const char*)(gbase) + (voff)[_i]), (PG8_LAS unsigned*)(lds + (bufoff) + ldsw + _i * 8192), 16, 0, 0); } while (0)
#define PG8_LDA(dst, b, h) do { _Pragma("unroll") for (int m = 0; m < 4; ++m) _Pragma("unroll") for (int k = 0; k < 2; ++k) dst[m][k] = *(const PG8_LAS bf16x8*)(lds + PG8_SA(b, h) + aoff + m * 2048 + k * 1024); } while (0)
#define PG8_LDB(dst, b, h) do { _Pragma("unroll") for (int n = 0; n < 2; ++n) _Pragma("unroll") for (int k = 0; k < 2; ++k) dst[n][k] = *(const PG8_LAS bf16x8*)(lds + PG8_SB(b, h) + boff + n * 2048 + k * 1024); } while (0)
#define PG8_MMA(ai, bj, At, Bt) do { __builtin_amdgcn_s_setprio(1); _Pragma("unroll") for (int m = 0; m < 4; ++m) _Pragma("unroll") for (int n = 0; n < 2; ++n) _Pragma("unroll") for (int k = 0; k < 2; ++k) \
        acc[ai][bj][m][n] = __builtin_amdgcn_mfma_f32_16x16x32_bf16(Bt[n][k], At[m][k], acc[ai][bj][m][n], 0, 0, 0); __builtin_amdgcn_s_setprio(0); } while (0)
#define PG8_WAIT_V(n) asm volatile("s_waitcnt vmcnt(" #n ")" ::: "memory")
#define PG8_WAIT_L(n) asm volatile("s_waitcnt lgkmcnt(" #n ")" ::: "memory")
#define PG8_BAR __builtin_amdgcn_s_barrier()
#define PG8_SCHED __builtin_amdgcn_sched_barrier(0)
    Unit cur, nxt; int ui = 0;
    if (!S.next(0, cur)) return;
    f32x4 acc[2][2][4][2];
#pragma unroll
    for (int a = 0; a < 2; ++a)
#pragma unroll
        for (int b = 0; b < 2; ++b)
#pragma unroll
            for (int m = 0; m < 4; ++m)
#pragma unroll
                for (int n = 0; n < 2; ++n) acc[a][b][m][n] = (f32x4){0.f, 0.f, 0.f, 0.f};
    bf16x8 At[4][2], B0[2][2], B1[2][2];
    const char* cA = (const char*)g.A + (size_t)cur.pm * tstep; const char* cB = (const char*)g.Bt + (size_t)cur.pn * tstep;
    S.a_ready(cur);
    if constexpr (SP2) {
        PG8_STAGE(PG8_SB(0, 0), cB, voffB); PG8_STAGE(PG8_SB(0, 1), cB + hstep, voffB); PG8_STAGE(PG8_SA(0, 0), cA, voffA); PG8_STAGE(PG8_SA(0, 1), cA + hstep, voffA);
        if (wr == 1) PG8_BAR;
        PG8_WAIT_V(2); PG8_BAR;
        PG8_STAGE(PG8_SB(1, 0), cB + kstep, voffB); PG8_STAGE(PG8_SA(1, 0), cA + kstep, voffA); PG8_STAGE(PG8_SB(1, 1), cB + hstep + kstep, voffB);
        PG8_WAIT_V(6); PG8_BAR;
    } else {
        PG8_STAGE(PG8_SB(0, 0), cB, voffB); PG8_STAGE(PG8_SA(0, 0), cA, voffA); PG8_STAGE(PG8_SB(0, 1), cB + hstep, voffB); PG8_STAGE(PG8_SA(0, 1), cA + hstep, voffA);
        if (wr == 1) PG8_BAR;
        PG8_WAIT_V(4); PG8_BAR;
        PG8_STAGE(PG8_SB(1, 0), cB + kstep, voffB); PG8_STAGE(PG8_SA(1, 0), cA + kstep, voffA); PG8_STAGE(PG8_SB(1, 1), cB + hstep + kstep, voffB);
        PG8_WAIT_V(6); PG8_BAR;
    }
    for (;;) {
        const bool has_next = S.next(ui + 1, nxt);
        const char* nA = has_next ? (const char*)g.A + (size_t)nxt.pm * tstep : cA; const char* nB = has_next ? (const char*)g.Bt + (size_t)nxt.pn * tstep : cB;
        for (int t = 0; t < nt; t += 2) {
            const bool last = (t == nt - 2);
            const char* a1 = cA + (size_t)(t + 1) * kstep;
            const char* a2 = last ? nA : cA + (size_t)(t + 2) * kstep; const char* b2 = last ? nB : cB + (size_t)(t + 2) * kstep;
            const char* a3 = a2 + kstep; const char* b3 = b2 + kstep;
            if (last && has_next) S.a_ready(nxt);
            if constexpr (SP2) {
            PG8_LDB(B0, 0, 0); PG8_LDB(B1, 0, 1); PG8_SCHED; PG8_LDA(At, 0, 0); PG8_STAGE(PG8_SA(1, 1), a1 + hstep, voffA);
            PG8_WAIT_V(8); PG8_WAIT_L(0); PG8_BAR; PG8_MMA(0, 0, At, B0); PG8_MMA(0, 1, At, B1); PG8_BAR; PG8_SCHED;
            PG8_LDA(At, 0, 1); PG8_STAGE(PG8_SB(0, 0), b2, voffB); PG8_STAGE(PG8_SB(0, 1), b2 + hstep, voffB); PG8_STAGE(PG8_SA(0, 0), a2, voffA);
            PG8_WAIT_V(8); PG8_WAIT_L(0); PG8_BAR; PG8_MMA(1, 0, At, B0); PG8_MMA(1, 1, At, B1); PG8_BAR; PG8_SCHED;
            PG8_LDB(B0, 1, 0); PG8_LDB(B1, 1, 1); PG8_SCHED; PG8_LDA(At, 1, 0); PG8_STAGE(PG8_SA(0, 1), a2 + hstep, voffA);
            PG8_WAIT_V(8); PG8_WAIT_L(0); PG8_BAR; PG8_MMA(0, 0, At, B0); PG8_MMA(0, 1, At, B1); PG8_BAR; PG8_SCHED;
            PG8_LDA(At, 1, 1); PG8_STAGE(PG8_SB(1, 0), b3, voffB); PG8_STAGE(PG8_SB(1, 1), b3 + hstep, voffB); PG8_STAGE(PG8_SA(1, 0), a3, voffA);
            PG8_WAIT_V(8); PG8_WAIT_L(0); PG8_BAR; PG8_MMA(1, 0, At, B0); PG8_MMA(1, 1, At, B1); PG8_BAR; PG8_SCHED;
            } else {
            PG8_LDB(B0, 0, 0); PG8_SCHED; PG8_LDA(At, 0, 0); PG8_STAGE(PG8_SA(1, 1), a1 + hstep, voffA);
            PG8_WAIT_L(8); PG8_BAR; PG8_WAIT_L(0); PG8_MMA(0, 0, At, B0); PG8_BAR; PG8_SCHED;
            PG8_LDB(B1, 0, 1); PG8_STAGE(PG8_SB(0, 0), b2, voffB);
            PG8_BAR; PG8_WAIT_L(0); PG8_MMA(0, 1, At, B1); PG8_BAR;
            PG8_LDA(At, 0, 1); PG8_STAGE(PG8_SA(0, 0), a2, voffA);
            PG8_BAR; PG8_WAIT_L(0); PG8_MMA(1, 0, At, B0); PG8_BAR; PG8_SCHED;
            PG8_STAGE(PG8_SB(0, 1), b2 + hstep, voffB);
            PG8_WAIT_V(6); PG8_BAR; PG8_MMA(1, 1, At, B1); PG8_BAR;
            PG8_LDB(B0, 1, 0); PG8_SCHED; PG8_LDA(At, 1, 0); PG8_STAGE(PG8_SA(0, 1), a2 + hstep, voffA);
            PG8_WAIT_L(8); PG8_BAR; PG8_WAIT_L(0); PG8_MMA(0, 0, At, B0); PG8_BAR; PG8_SCHED;
            PG8_LDB(B1, 1, 1); PG8_STAGE(PG8_SB(1, 0), b3, voffB);
            PG8_BAR; PG8_WAIT_L(0); PG8_MMA(0, 1, At, B1); PG8_BAR;
            PG8_LDA(At, 1, 1); PG8_STAGE(PG8_SA(1, 0), a3, voffA);
            PG8_BAR; PG8_WAIT_L(0); PG8_MMA(1, 0, At, B0); PG8_BAR; PG8_SCHED;
            PG8_STAGE(PG8_SB(1, 1), b3 + hstep, voffB);
            PG8_WAIT_V(6); PG8_BAR; PG8_MMA(1, 1, At, B1); PG8_BAR;
            }
        }
        if constexpr (ALIGN_EPI) { if (wr == 0) PG8_BAR; }
        if constexpr (!Epi::AFTER_DRAIN) { E(acc, cur, wr, wc, fr, fq); S.done(cur); }
        if (!has_next) break;
#pragma unroll
        for (int a = 0; a < 2; ++a)
#pragma unroll
            for (int b = 0; b < 2; ++b)
#pragma unroll
                for (int m = 0; m < 4; ++m)
#pragma unroll
                    for (int n = 0; n < 2; ++n) acc[a][b][m][n] = (f32x4){0.f, 0.f, 0.f, 0.f};
        cur = nxt; cA = nA; cB = nB; ++ui;
        if constexpr (ALIGN_EPI) { if (wr == 1) PG8_BAR; }
    }
    PG8_WAIT_V(0);
    if constexpr (!ALIGN_EPI) { if (wr == 0) PG8_BAR; }
    PG8_BAR;
    if constexpr (Epi::AFTER_DRAIN) { E.fused(acc, cur, wr, wc, fr, fq, lds, wid, lane); S.done(cur); }
#undef PG8_SA
#undef PG8_SB
#undef PG8_STAGE
#undef PG8_LDA
#undef PG8_LDB
#undef PG8_MMA
#undef PG8_WAIT_V
#undef PG8_WAIT_L
#undef PG8_BAR
#undef PG8_SCHED
}
}
#define GAS __attribute__((address_space(1)))
#define LAS __attribute__((address_space(3)))
typedef unsigned short bf16;
typedef unsigned v4u __attribute__((ext_vector_type(4)));
typedef float f32x4 __attribute__((ext_vector_type(4)));
typedef short bf16x8 __attribute__((ext_vector_type(8)));
typedef GAS unsigned gu32;
typedef GAS unsigned long long gu64;
#define RLX_AGENT __ATOMIC_RELAXED, __HIP_MEMORY_SCOPE_AGENT
#define LDS_WAIT() asm volatile("s_waitcnt lgkmcnt(0)" ::: "memory")
#define VM_WAIT() asm volatile("s_waitcnt vmcnt(0)" ::: "memory")
__device__ __forceinline__ unsigned long long rt() { return __builtin_amdgcn_s_memrealtime(); }
__device__ __forceinline__ unsigned f2bf(float f) { unsigned u = __builtin_bit_cast(unsigned, f); return (u + 0x7fffu + ((u >> 16) & 1u)) >> 16; }
__device__ __forceinline__ unsigned pk2(float lo, float hi) { return f2bf(lo) | (f2bf(hi) << 16); }

#define XB_TMO      128
#define XB_XCNT(j)  (256  + 64 * (j))
#define XB_XSUB(j)  (1280 + 64 * (j))
#define XB_XGEN(j)  (2304 + 64 * (j))
#define XB_TOP      3328
#define XB_TOPGEN   3392
#define XCD_BAR_WORDS 3456
#define XB_SPIN_CAP (1u << 18)

__device__ __forceinline__ unsigned xb_ld(unsigned* p)              { return __hip_atomic_load(p, __ATOMIC_RELAXED, __HIP_MEMORY_SCOPE_AGENT); }
__device__ __forceinline__ unsigned xb_add(unsigned* p, unsigned v) { return __hip_atomic_fetch_add(p, v, __ATOMIC_RELAXED, __HIP_MEMORY_SCOPE_AGENT); }
__device__ __forceinline__ unsigned xb_xcc_id() { return (unsigned)__builtin_amdgcn_s_getreg((3 << 11) | 20) & 0xFu; }
#define XB_SPIN(cond, bar) do { unsigned _sp = 0; while (cond) { __builtin_amdgcn_s_sleep(1); \
    if ((++_sp & 255u) == 0u) { if (xb_ld(&(bar)[XB_TMO])) break; if (_sp > XB_SPIN_CAP) { atomicAdd(&(bar)[XB_TMO], 1u); break; } } } } while (0)

struct XcdBarrier {
    unsigned* bar; unsigned x;
    volatile LAS unsigned* st;
};

__device__ __forceinline__ XcdBarrier xcd_barrier_post(unsigned* bar, volatile LAS unsigned* st) {
    XcdBarrier b; b.bar = bar; b.x = xb_xcc_id(); b.st = st;
    if (threadIdx.x == 0) (void)xb_add(&bar[XB_XCNT(b.x)], 1u);
    return b;
}
__device__ __forceinline__ void xcd_barrier_complete(unsigned* bar, unsigned x, unsigned& nloc, unsigned& nx) {
    const unsigned G = gridDim.x * gridDim.y * gridDim.z;
    unsigned sum, cnt, mine, sp = 0u;
    for (;;) {
        sum = 0u; cnt = 0u; mine = 0u;
#pragma unroll
        for (unsigned j = 0; j < 16; ++j) { const unsigned c = xb_ld(&bar[XB_XCNT(j)]); sum += c; cnt += (c > 0u) ? 1u : 0u; mine = (j == x) ? c : mine; }
        if (sum == G) break;
        __builtin_amdgcn_s_sleep(1);
        if ((++sp & 255u) == 0u) { if (xb_ld(&bar[XB_TMO])) break; if (sp > XB_SPIN_CAP) { atomicAdd(&bar[XB_TMO], 1u); break; } }
    }
    nloc = mine > 0u ? mine : 1u; nx = cnt > 0u ? cnt : 1u;
}

__device__ __forceinline__ void xcd_barrier(const XcdBarrier& b) {
    asm volatile("s_waitcnt vmcnt(0)" ::: "memory");
    __syncthreads();
    if (threadIdx.x == 0) {
        unsigned* bar = b.bar;
        __builtin_amdgcn_s_waitcnt(0);
        unsigned nloc = b.st[0], nx = b.st[1];
        if (nloc == 0u) { xcd_barrier_complete(bar, b.x, nloc, nx); b.st[0] = nloc; b.st[1] = nx; }
        const unsigned old = xb_add(&bar[XB_XSUB(b.x)], 1u);
        const unsigned gen = old / nloc;
        if (old + 1u == (gen + 1u) * nloc) {
            __builtin_amdgcn_fence(__ATOMIC_RELEASE, "agent");
            asm volatile("s_waitcnt vmcnt(0)" ::: "memory");
            const unsigned og = xb_add(&bar[XB_TOP], 1u);
            const unsigned tg = og / nx;
            if (og + 1u == (tg + 1u) * nx) xb_add(&bar[XB_TOPGEN], 1u);
            else XB_SPIN(xb_ld(&bar[XB_TOPGEN]) == tg, bar);
            __builtin_amdgcn_fence(__ATOMIC_ACQUIRE, "agent");
            xb_add(&bar[XB_XGEN(b.x)], 1u);
            asm volatile("s_waitcnt vmcnt(0)" ::: "memory");
        } else {
            XB_SPIN(xb_ld(&bar[XB_XGEN(b.x)]) == gen, bar);
            __builtin_amdgcn_fence(__ATOMIC_ACQUIRE, "agent");
            asm volatile("s_waitcnt vmcnt(0)" ::: "memory");
        }
    }
    __syncthreads();
}
constexpr int NWAVES = 8, NTHREADS = 512;
constexpr int RING_BYTES = 131072, LDSCTL_OFF = RING_BYTES, MISC_OFF = LDSCTL_OFF + 320, LDS_BYTES = 147456;
typedef unsigned v2u __attribute__((ext_vector_type(2)));

#ifndef PH_MASK
#define PH_MASK 0xffff
#endif
struct Args { const float* in[27]; float* out; unsigned char* ws; };
enum { I_X = 0, I_META, I_F1PRE, I_F1POST, I_F1G, I_F1U, I_F1D, I_MIXPRE, I_MIXPOST, I_WIN, I_BIN, I_CONVW, I_CONVB, I_MNORM, I_MWB, I_LQ1, I_LK1, I_LQ2, I_LK2, I_ANORM, I_AWB, I_WOUT, I_F2PRE, I_F2POST, I_F2G, I_F2U, I_F2D };

__device__ __forceinline__ float wave_sum(float v) {
#pragma unroll
    for (int o = 1; o < 64; o <<= 1) v += __shfl_xor(v, o);
    return v;
}
__device__ __forceinline__ float bf2f(bf16 b) { return __uint_as_float(((unsigned)b) << 16); }

__device__ __forceinline__ void tr_item(const float* W, int ldw, int src_col0, int k0, bf16* WT, int K, int dst_row0, const float* sk, float scal, LAS float* scr, int lane) {
#pragma unroll 8
    for (int i = 0; i < 32; ++i) { const int kk = 2 * i + (lane >> 5);
        const float w = W[(size_t)(k0 + kk) * ldw + src_col0 + (lane & 31)];
        const float s = sk ? sk[k0 + kk] * scal : scal;
        scr[kk * 33 + (lane & 31)] = w * s; }
    LDS_WAIT(); asm volatile("" ::: "memory");
    const int c = lane & 7;
#pragma unroll
    for (int j = 0; j < 4; ++j) { const int n = (lane >> 3) + 8 * j; const LAS float* s = scr + (8 * c) * 33 + n;
        v4u o; o.x = pk2(s[0 * 33], s[1 * 33]); o.y = pk2(s[2 * 33], s[3 * 33]); o.z = pk2(s[4 * 33], s[5 * 33]); o.w = pk2(s[6 * 33], s[7 * 33]);
        *(GAS v4u*)(WT + (size_t)(dst_row0 + n) * K + k0 + 8 * c) = o; }
    LDS_WAIT(); asm volatile("" ::: "memory");
}

__device__ __forceinline__ void convert_ffn(const float* wg, const float* wu, const float* wd, const float* preg, bf16* WUP, bf16* WDN, LAS float* scr, int gw, int NGW, int lane) {
    constexpr int N_UP = (DM / 64) * (NUP / 32), N_DN = (DFF / 64) * (DM / 32);
    for (int it = gw; it < N_UP + N_DN; it += NGW) {
        if (it < N_UP) { const int nblk = NUP / 32, kb = it / nblk, nb = it % nblk, row0 = 32 * nb, pn = row0 >> 8, j = row0 & 255;
            const float* src = (j < 128) ? wg : wu; const int col0 = 128 * pn + (j & 127);
            tr_item(src, DFF, col0, 64 * kb, WUP, DM, row0, preg, 1.0f, scr, lane); }
        else { const int r = it - N_UP, nblk = DM / 32, kb = r / nblk, nb = r % nblk;
            tr_item(wd, DM, 32 * nb, 64 * kb, WDN, DFF, 32 * nb, nullptr, 1.0f, scr, lane); }
    }
}

__device__ __forceinline__ void sincos_small(double r, double& s, double& c) {
    const double r2 = r * r; double ts = 1.0, tc = 1.0;
#pragma unroll
    for (int k = 13; k >= 1; --k) { ts = 1.0 - ts * r2 / (double)((2 * k) * (2 * k + 1)); tc = 1.0 - tc * r2 / (double)((2 * k - 1) * (2 * k)); }
    s = r * ts; c = tc;
}

__device__ __forceinline__ void load_row(const float* p, int lane, f32x4 (&v)[8]) {
    const GAS f32x4* r = (const GAS f32x4*)p + lane;
#pragma unroll
    for (int j = 0; j < 8; ++j) v[j] = r[64 * j];
}
__device__ __forceinline__ float row_ssq(const f32x4 (&v)[8]) {
    float s = 0.f;
#pragma unroll
    for (int j = 0; j < 8; ++j) s += (v[j].x * v[j].x + v[j].y * v[j].y) + (v[j].z * v[j].z + v[j].w * v[j].w);
    return wave_sum(s);
}
__device__ __forceinline__ void store_row_bf16(bf16* p, int lane, const f32x4 (&v)[8], float sc) {
    GAS v2u* o = (GAS v2u*)p + lane;
#pragma unroll
    for (int j = 0; j < 8; ++j) { v2u w; w.x = pk2(v[j].x * sc, v[j].y * sc); w.y = pk2(v[j].z * sc, v[j].w * sc); o[64 * j] = w; }
}

__device__ __forceinline__ float log_sigmoid(float x) { return fminf(x, 0.f) - log1pf(__expf(-fabsf(x))); }

__device__ __forceinline__ void mlstm_naive(LAS float* L, int h, int s, const bf16* QK, const bf16* MV, const float* GATES, const float* convw, const float* convb, float* HM, int tid) {
    LAS float* qs = L;
    LAS float* ks = qs + 64 * 129;
    LAS float* vs = ks + 64 * 129;
    LAS float* Ss = vs + 64 * 32;
    LAS float* Cs = Ss + 64 * 65;
    LAS float* ns = Cs + 128 * 33;
    LAS float* bb = ns + 128;
    LAS float* aa = bb + 64;
    LAS float* lis = aa + 64;
    LAS float* lfs = lis + 64;
    LAS float* mrow = lfs + 64;
    LAS float* wint = mrow + 64;
    LAS float* den = wint + 64;
    LAS float* sc = den + 64;
    for (int i = tid; i < 128 * 33; i += NTHREADS) Cs[i] = 0.f;
    if (tid < 128) ns[tid] = 0.f;
    float mst = 0.f;
    __syncthreads();
    for (int c = 0; c < NCHUNK; ++c) {
        const int R0 = ROW_PAD0 + 64 * c;
#pragma unroll 1
        for (int idx = tid; idx < 64 * 256; idx += NTHREADS) { const int j = idx >> 8, col = idx & 255; const bool isk = col >= 128;
            const int cc = isk ? (512 + h * 128 + (col - 128)) : (h * 128 + col); const int R = R0 + j; float val = 0.f;
            if (R >= ROW_META0) { float a = convb[cc];
#pragma unroll
                for (int jj = 0; jj < 4; ++jj) { const int Rr = R - 3 + jj; const float xv = (Rr >= ROW_META0) ? bf2f(QK[(size_t)Rr * 1024 + cc]) : 0.f; a += convw[jj * 1024 + cc] * xv; }
                val = a * pg8::sigm(a); if (isk) val *= 0.08838834764831845f; }
            if (isk) ks[j * 129 + (col - 128)] = val; else qs[j * 129 + col] = val; }
        for (int idx = tid; idx < 64 * 32; idx += NTHREADS) { const int j = idx >> 5, e = idx & 31; const int R = R0 + j;
            vs[idx] = (R >= ROW_META0) ? bf2f(MV[(size_t)R * 1024 + h * 256 + s * 32 + e]) : 0.f; }
        if (tid < 64) { const int R = R0 + tid; lis[tid] = GATES[(size_t)R * 8 + h]; lfs[tid] = GATES[(size_t)R * 8 + 4 + h]; }
        __syncthreads();
        if (tid == 0) { float b = 0.f;
#pragma unroll 1
            for (int j = 0; j < 64; ++j) { b += lfs[j]; bb[j] = b; }
            const float g = b; float ml = -INFINITY;
#pragma unroll 1
            for (int j = 0; j < 64; ++j) { const float a = g - bb[j] + lis[j]; aa[j] = a; ml = fmaxf(ml, a); }
            sc[0] = g; sc[1] = ml; }
        __syncthreads();
        const float g = sc[0], mloc = sc[1]; const float mnew = fmaxf(g + mst, mloc);
        if (tid < 64) { const int i = tid; float mx = bb[i] + mst;
#pragma unroll 1
            for (int j = 0; j <= i; ++j) mx = fmaxf(mx, bb[i] - bb[j] + lis[j]); mrow[i] = mx; wint[i] = __expf(bb[i] + mst - mx); }
        __syncthreads();
        { const int i = tid >> 3, j0 = tid & 7; float acc[8];
#pragma unroll
            for (int jj = 0; jj < 8; ++jj) acc[jj] = 0.f;
#pragma unroll 2
            for (int d = 0; d < 128; ++d) { const float qv = qs[i * 129 + d];
#pragma unroll
                for (int jj = 0; jj < 8; ++jj) acc[jj] += qv * ks[(j0 + 8 * jj) * 129 + d]; }
#pragma unroll
            for (int jj = 0; jj < 8; ++jj) { const int j = j0 + 8 * jj; Ss[i * 65 + j] = (j <= i) ? acc[jj] * __expf(bb[i] - bb[j] + lis[j] - mrow[i]) : 0.f; } }
        __syncthreads();
        if (tid < 64) { const int i = tid; float a = 0.f;
#pragma unroll 4
            for (int d = 0; d < 128; ++d) a += qs[i * 129 + d] * ns[d];
            float b = 0.f;
#pragma unroll 4
            for (int j = 0; j < 64; ++j) b += Ss[i * 65 + j];
            den[i] = wint[i] * a + b; }
        __syncthreads();
        { const int i = tid >> 3, e0 = (tid & 7) * 4; float a[4] = {0.f, 0.f, 0.f, 0.f}, b[4] = {0.f, 0.f, 0.f, 0.f};
#pragma unroll 2
            for (int d = 0; d < 128; ++d) { const float qv = qs[i * 129 + d];
#pragma unroll
                for (int e = 0; e < 4; ++e) a[e] += qv * Cs[d * 33 + e0 + e]; }
#pragma unroll 2
            for (int j = 0; j < 64; ++j) { const float sv = Ss[i * 65 + j];
#pragma unroll
                for (int e = 0; e < 4; ++e) b[e] += sv * vs[j * 32 + e0 + e]; }
            const float dn = fmaxf(fabsf(den[i]), __expf(-mrow[i])); const float w = wint[i];
            f32x4 o; o.x = (w * a[0] + b[0]) / dn; o.y = (w * a[1] + b[1]) / dn; o.z = (w * a[2] + b[2]) / dn; o.w = (w * a[3] + b[3]) / dn;
            *(f32x4*)(HM + (size_t)(R0 + i) * 1024 + h * 256 + s * 32 + e0) = o; }
        __syncthreads();
        if (tid < 64) aa[tid] = __expf(aa[tid] - mnew);
        __syncthreads();
        { const float decay = __expf(g + mst - mnew); const int d = tid >> 2, e0 = (tid & 3) * 8; float a[8];
#pragma unroll
            for (int e = 0; e < 8; ++e) a[e] = decay * Cs[d * 33 + e0 + e];
#pragma unroll 2
            for (int j = 0; j < 64; ++j) { const float kv = aa[j] * ks[j * 129 + d];
#pragma unroll
                for (int e = 0; e < 8; ++e) a[e] += kv * vs[j * 32 + e0 + e]; }
#pragma unroll
            for (int e = 0; e < 8; ++e) Cs[d * 33 + e0 + e] = a[e];
            if (tid < 128) { float nn = decay * ns[tid];
#pragma unroll 4
                for (int j = 0; j < 64; ++j) nn += aa[j] * ks[j * 129 + tid];
                ns[tid] = nn; } }
        mst = mnew;
        __syncthreads();
    }
}

__device__ __forceinline__ void attn_naive_unit(LAS float* L, int hh, int c, const bf16* AQ, const bf16* AK, const bf16* AV, float lam, bf16* HA, int tid) {
    LAS float* Qs = L;
    LAS float* Ks = Qs + 64 * 65;
    LAS float* Vs = Ks + 64 * 65;
    LAS float* Ss = Vs + 64 * 129;
    const int i = tid >> 3, sub = tid & 7; const int Rq0 = ROW_PAD0 + 64 * c;
    float o1[16];
#pragma unroll
    for (int e = 0; e < 16; ++e) o1[e] = 0.f;
    for (int map = 0; map < 2; ++map) {
        __syncthreads();
        for (int idx = tid; idx < 64 * 64; idx += NTHREADS) { const int r = idx >> 6, d = idx & 63; Qs[r * 65 + d] = bf2f(AQ[(size_t)(Rq0 + r) * 1024 + hh * 128 + map * 64 + d]); }
        float mi = -INFINITY, l = 0.f, O[16];
#pragma unroll
        for (int e = 0; e < 16; ++e) O[e] = 0.f;
        for (int t = 0; t <= c; ++t) { const int Rk0 = ROW_PAD0 + 64 * t;
            __syncthreads();
            for (int idx = tid; idx < 64 * 64; idx += NTHREADS) { const int r = idx >> 6, d = idx & 63; Ks[r * 65 + d] = bf2f(AK[(size_t)(Rk0 + r) * 1024 + hh * 128 + map * 64 + d]); }
            for (int idx = tid; idx < 64 * 128; idx += NTHREADS) { const int r = idx >> 7, e = idx & 127; Vs[r * 129 + e] = bf2f(AV[(size_t)(Rk0 + r) * 1024 + hh * 128 + e]); }
            __syncthreads();
            { float acc[8];
#pragma unroll
                for (int jj = 0; jj < 8; ++jj) acc[jj] = 0.f;
#pragma unroll 2
                for (int d = 0; d < 64; ++d) { const float qv = Qs[i * 65 + d];
#pragma unroll
                    for (int jj = 0; jj < 8; ++jj) acc[jj] += qv * Ks[(sub + 8 * jj) * 65 + d]; }
#pragma unroll
                for (int jj = 0; jj < 8; ++jj) { const int j = sub + 8 * jj; Ss[i * 65 + j] = (t == 0 && j < 48) ? -INFINITY : acc[jj]; } }
            __syncthreads();
            float mx = mi;
#pragma unroll 4
            for (int j = 0; j < 64; ++j) mx = fmaxf(mx, Ss[i * 65 + j]);
            const float alpha = exp2f(mi - mx); float lp = 0.f;
#pragma unroll
            for (int e = 0; e < 16; ++e) O[e] *= alpha;
#pragma unroll 2
            for (int j = 0; j < 64; ++j) { const float p = exp2f(Ss[i * 65 + j] - mx); lp += p;
#pragma unroll
                for (int e = 0; e < 16; ++e) O[e] += p * Vs[j * 129 + sub * 16 + e]; }
            l = l * alpha + lp; mi = mx;
        }
        const float il = 1.0f / l;
        if (map == 0) {
#pragma unroll
            for (int e = 0; e < 16; ++e) o1[e] = O[e] * il;
        } else {
#pragma unroll
            for (int e = 0; e < 16; ++e) o1[e] = o1[e] - lam * (O[e] * il);
        }
    }
    float ss = 0.f;
#pragma unroll
    for (int e = 0; e < 16; ++e) ss += o1[e] * o1[e];
    ss += __shfl_xor(ss, 1); ss += __shfl_xor(ss, 2); ss += __shfl_xor(ss, 4);
    const float rs = 1.0f / sqrtf(ss * (1.0f / 128.0f) + EPS);
    v4u w0, w1;
    w0.x = pk2(o1[0] * rs, o1[1] * rs); w0.y = pk2(o1[2] * rs, o1[3] * rs); w0.z = pk2(o1[4] * rs, o1[5] * rs); w0.w = pk2(o1[6] * rs, o1[7] * rs);
    w1.x = pk2(o1[8] * rs, o1[9] * rs); w1.y = pk2(o1[10] * rs, o1[11] * rs); w1.z = pk2(o1[12] * rs, o1[13] * rs); w1.w = pk2(o1[14] * rs, o1[15] * rs);
    bf16* op = HA + (size_t)(Rq0 + i) * 1024 + hh * 128 + sub * 16;
    *(v4u*)op = w0; *(v4u*)(op + 8) = w1;
}

__global__ void __launch_bounds__(NTHREADS, 2) mega_fwd(Args args) {
    extern __shared__ __attribute__((aligned(16))) unsigned char lds_raw[];
    LAS unsigned char* lds = (LAS unsigned char*)lds_raw;
    volatile LAS unsigned* MISC = (volatile LAS unsigned*)(lds + MISC_OFF);
    const int tid = threadIdx.x, lane = tid & 63, wave = __builtin_amdgcn_readfirstlane(tid >> 6);
    const int G = gridDim.x, bx = blockIdx.x;
    const int vcu = (G % 8 == 0) ? (bx % 8) * (G / 8) + bx / 8 : bx;
    unsigned char* ws = args.ws;
    gu32* ctl = (gu32*)(ws + WS_CTL);
    for (int u = tid; u < (LDS_BYTES - LDSCTL_OFF) / 4; u += NTHREADS) ((LAS unsigned*)(lds + LDSCTL_OFF))[u] = 0u;
    __syncthreads();
    XcdBarrier bar = xcd_barrier_post((unsigned*)(ctl + CW_BAR), MISC + 8);
#define GRID_BAR() xcd_barrier(bar)

    float* ROPE = (float*)(ws + WS_ROPE); float* BIAS = (float*)(ws + WS_BIAS); float* GW = (float*)(ws + WS_GW); float* METAH = (float*)(ws + WS_METAH);
    float* GATES = (float*)(ws + WS_GATES);
    bf16* WUP = (bf16*)(ws + WS_WUP); bf16* WDN = (bf16*)(ws + WS_WDN); bf16* WIN = (bf16*)(ws + WS_WIN); bf16* WMB = (bf16*)(ws + WS_WMB); bf16* WAB = (bf16*)(ws + WS_WAB); bf16* WOUT = (bf16*)(ws + WS_WOUT);
    bf16* XA = (bf16*)(ws + WS_XA); bf16* HID = (bf16*)(ws + WS_HID); float* Y = (float*)(ws + WS_Y); bf16* Z = (bf16*)(ws + WS_Z); bf16* YG = (bf16*)(ws + WS_YG);
    bf16* HMG = (bf16*)(ws + WS_HMG); bf16* HA = (bf16*)(ws + WS_HA); float* HM = (float*)(ws + WS_HM);
    bf16* ZQK = Z; bf16* ZMV = Z + ZPIECE; bf16* ZMO = Z + 2 * ZPIECE; bf16* ZAQ = Z + 3 * ZPIECE; bf16* ZAK = Z + 4 * ZPIECE; bf16* ZAV = Z + 5 * ZPIECE;
    bf16* ZGM = Z + 6 * ZPIECE; bf16* ZGA = ZGM + (size_t)MP * 2048;
    const int gw = vcu * NWAVES + wave, NGW = G * NWAVES;
    LAS float* scr = (LAS float*)(lds + wave * 16384);

#if PH_MASK & (1 << 0)
    {
        convert_ffn(args.in[I_F1G], args.in[I_F1U], args.in[I_F1D], args.in[I_F1PRE], WUP, WDN, scr, gw, NGW, lane);
        constexpr int N_IN = (DM / 64) * (NIN / 32), N_MB = (1024 / 64) * (DM / 32), N_WO = (DM / 64) * (DM / 32);
        for (int it = gw; it < N_IN + 2 * N_MB + N_WO; it += NGW) {
            int r = it;
            if (r < N_IN) { const int nblk = NIN / 32, kb = r / nblk, nb = r % nblk, row0 = 32 * nb; const int col0 = row0 < 3072 ? row0 : row0 + 8;
                tr_item(args.in[I_WIN], NIN_SRC, col0, 64 * kb, WIN, DM, row0, args.in[I_MIXPRE], 1.0f, scr, lane); continue; } r -= N_IN;
            if (r < N_MB) { const int nblk = DM / 32, kb = r / nblk, nb = r % nblk; tr_item(args.in[I_MWB], DM, 32 * nb, 64 * kb, WMB, 1024, 32 * nb, args.in[I_MNORM], 1.0f, scr, lane); continue; } r -= N_MB;
            if (r < N_MB) { const int nblk = DM / 32, kb = r / nblk, nb = r % nblk; tr_item(args.in[I_AWB], DM, 32 * nb, 64 * kb, WAB, 1024, 32 * nb, args.in[I_ANORM], 0.8f, scr, lane); continue; } r -= N_MB;
            { const int nblk = DM / 32, kb = r / nblk, nb = r % nblk; tr_item(args.in[I_WOUT], DM, 32 * nb, 64 * kb, WOUT, DM, 32 * nb, nullptr, 1.0f, scr, lane); }
        }
        const int gt = vcu * NTHREADS + tid, NGT = G * NTHREADS;
        for (int i = gt; i < NIN; i += NGT) BIAS[i] = args.in[I_BIN][i < 3072 ? i : i + 8];
        for (int i = gt; i < 8 * DM; i += NGT) { const int c = i / DM, k = i % DM; GW[i] = args.in[I_WIN][(size_t)k * NIN_SRC + 3072 + c] * args.in[I_MIXPRE][k]; }
        for (int i = gt; i < (SEQ + NMETA) * 8; i += NGT) { const int pos = i >> 3, k = i & 7;
            const float invf = k == 0 ? 1.0f : k == 1 ? 0.19392274474868576f : k == 2 ? 0.03760603093086393f : k == 3 ? 0.007292664737217109f : k == 4 ? 0.001414213562373095f : k == 5 ? 0.0002742481756762073f : k == 6 ? 5.318295896944988e-05f : 1.031338537721246e-05f;
            const float ang = (float)pos * invf; const double a = (double)ang;
            const double q = rint(a * 0.15915494309189535); const double rr = a - q * 6.283185307179586476925;
            double s, c; sincos_small(rr, s, c);
            ROPE[(size_t)pos * 16 + k] = (float)c; ROPE[(size_t)pos * 16 + 8 + k] = (float)s; }
        for (int R = gw; R < MP; R += NGW) {
            bf16* xo = XA + (size_t)R * DM;
            if (R < ROW_META0) { GAS v2u* o = (GAS v2u*)xo + lane; v2u z; z.x = 0u; z.y = 0u;
#pragma unroll
                for (int j = 0; j < 8; ++j) o[64 * j] = z; }
            else { const float* hp = (R >= ROW_X0) ? args.in[I_X] + (size_t)(R - ROW_X0) * DM : args.in[I_META] + (size_t)(R - ROW_META0) * DM;
                f32x4 v[8]; load_row(hp, lane, v); const float r1 = 1.0f / sqrtf(row_ssq(v) * (1.0f / DM) + EPS); store_row_bf16(xo, lane, v, r1); }
        }
    }
#endif
    GRID_BAR();

#if PH_MASK & (1 << 1)
    { pg8::Gemm g{XA, WUP, MP, NUP, DM}; pg8::StaticOrder S; S.init(MP, NUP, G, bx); pg8::EpiSwiglu E{HID, DFF};
      pg8::gemm_phase<pg8::EpiSwiglu, pg8::StaticOrder, true, true>(lds, g, S, E); }
#endif
    GRID_BAR();
#if PH_MASK & (1 << 2)
    { pg8::Gemm g{HID, WDN, MP, DM, DFF}; pg8::StaticOrder S; S.init(MP, DM, G, bx); pg8::EpiF32 E{Y, DM};
      pg8::gemm_phase<pg8::EpiF32, pg8::StaticOrder, true, true>(lds, g, S, E); }
#endif
    GRID_BAR();
#if PH_MASK & (1 << 3)
    {
        for (int R = ROW_PAD0 + gw; R < MP; R += NGW) {
            if (R < ROW_META0) { if (lane < 8) GATES[(size_t)R * 8 + lane] = (lane < 4) ? -INFINITY : 0.f; continue; }
            const float* hp = (R >= ROW_X0) ? args.in[I_X] + (size_t)(R - ROW_X0) * DM : args.in[I_META] + (size_t)(R - ROW_META0) * DM;
            float* ho = (R >= ROW_X0) ? args.out + (size_t)(R - ROW_X0) * DM : METAH + (size_t)(R - ROW_META0) * DM;
            f32x4 y[8], h[8], g[8]; load_row(Y + (size_t)R * DM, lane, y); load_row(hp, lane, h); load_row(args.in[I_F1POST], lane, g);
            const float rs = 0.5f / sqrtf(row_ssq(y) * (1.0f / DM) + EPS);
#pragma unroll
            for (int j = 0; j < 8; ++j) h[j] = h[j] + (y[j] * rs) * g[j];
            { GAS f32x4* o = (GAS f32x4*)ho + lane;
#pragma unroll
              for (int j = 0; j < 8; ++j) o[64 * j] = h[j]; }
            const float r2 = 1.0f / sqrtf(row_ssq(h) * (1.0f / DM) + EPS);
            store_row_bf16(XA + (size_t)R * DM, lane, h, r2);
            float gv = 0.f;
#pragma unroll 1
            for (int c = 0; c < 8; ++c) { const GAS f32x4* wp = (const GAS f32x4*)(GW + (size_t)c * DM) + lane; float s = 0.f;
#pragma unroll
                for (int j = 0; j < 8; ++j) { const f32x4 w = wp[64 * j]; s += (h[j].x * w.x + h[j].y * w.y) + (h[j].z * w.z + h[j].w * w.w); }
                s = wave_sum(s); if (lane == c) gv = s; }
            if (lane < 8) { float v = gv * r2 + args.in[I_BIN][3072 + lane]; if (lane >= 4) v = log_sigmoid(v); GATES[(size_t)R * 8 + lane] = v; }
        }
        convert_ffn(args.in[I_F2G], args.in[I_F2U], args.in[I_F2D], args.in[I_F2PRE], WUP, WDN, scr, gw, NGW, lane);
    }
#endif
    GRID_BAR();
#if PH_MASK & (1 << 4)
    { pg8::Gemm g{XA, WIN, MP, NIN, DM}; pg8::StaticOrder S; S.init(MP, NIN, G, bx); pg8::EpiZ E{Z, BIAS, ROPE};
      pg8::gemm_phase<pg8::EpiZ, pg8::StaticOrder, true, true>(lds, g, S, E); }
#endif
    GRID_BAR();
#if PH_MASK & (1 << 5)
    {
        const int NM = (G > 64) ? 32 : 0;
        if (bx < NM) { mlstm_naive((LAS float*)lds, bx >> 3, bx & 7, ZQK, ZMV, GATES, args.in[I_CONVW], args.in[I_CONVB], HM, tid); }
        else {
            float s1 = 0.f, s2 = 0.f;
            for (int i = 0; i < 64; ++i) { s1 += args.in[I_LQ1][i] * args.in[I_LK1][i]; s2 += args.in[I_LQ2][i] * args.in[I_LK2][i]; }
            const float lam = expf(s1) - expf(s2) + 0.2f;
            for (int u = bx - NM; u < 8 * 128; u += G - NM) { const int c = 128 - (u >> 3), hh = u & 7; attn_naive_unit((LAS float*)lds, hh, c, ZAQ, ZAK, ZAV, lam, HA, tid); }
        }
        if (NM == 0) { for (int u = bx; u < 32; u += G) mlstm_naive((LAS float*)lds, u >> 3, u & 7, ZQK, ZMV, GATES, args.in[I_CONVW], args.in[I_CONVB], HM, tid); }
    }
#endif
    GRID_BAR();
#if PH_MASK & (1 << 6)
    {
        for (int R = ROW_X0 + gw; R < MP; R += NGW) {
            const GAS f32x4* hp = (const GAS f32x4*)(HM + (size_t)R * 1024) + lane; const GAS v2u* mp = (const GAS v2u*)(ZMO + (size_t)R * 1024) + lane; GAS v2u* op = (GAS v2u*)(HMG + (size_t)R * 1024) + lane;
#pragma unroll
            for (int j = 0; j < 4; ++j) { const f32x4 v = hp[64 * j]; const float ss = wave_sum((v.x * v.x + v.y * v.y) + (v.z * v.z + v.w * v.w));
                const float rs = 1.0f / sqrtf(ss * (1.0f / 256.0f) + EPS); const v2u mo = mp[64 * j];
                v2u w; w.x = pk2(v.x * rs * pg8::bflo(mo.x), v.y * rs * pg8::bfhi(mo.x)); w.y = pk2(v.z * rs * pg8::bflo(mo.y), v.w * rs * pg8::bfhi(mo.y)); op[64 * j] = w; }
        }
    }
#endif
    GRID_BAR();
#if PH_MASK & (1 << 7)
    { pg8::Gemm g{HMG + (size_t)ROW_X0 * 1024, WMB, SEQ, DM, 1024}; pg8::StaticOrder S; S.init(SEQ, DM, G, bx); pg8::EpiGate E{ZGM + (size_t)ROW_X0 * 2048, YG + (size_t)ROW_X0 * 2048, DM, 0};
      pg8::gemm_phase<pg8::EpiGate, pg8::StaticOrder, true, true>(lds, g, S, E); }
#endif
    GRID_BAR();
#if PH_MASK & (1 << 8)
    { pg8::Gemm g{HA + (size_t)ROW_X0 * 1024, WAB, SEQ, DM, 1024}; pg8::StaticOrder S; S.init(SEQ, DM, G, bx); pg8::EpiGate E{ZGA + (size_t)ROW_X0 * 2048, YG + (size_t)ROW_X0 * 2048, DM, 1};
      pg8::gemm_phase<pg8::EpiGate, pg8::StaticOrder, true, true>(lds, g, S, E); }
#endif
    GRID_BAR();
#if PH_MASK & (1 << 9)
    { pg8::Gemm g{YG + (size_t)ROW_X0 * 2048, WOUT, SEQ, DM, DM}; pg8::StaticOrder S; S.init(SEQ, DM, G, bx); pg8::EpiF32 E{Y + (size_t)ROW_X0 * DM, DM};
      pg8::gemm_phase<pg8::EpiF32, pg8::StaticOrder, true, true>(lds, g, S, E); }
#endif
    GRID_BAR();
#if PH_MASK & (1 << 10)
    {
        for (int R = ROW_X0 + gw; R < MP; R += NGW) {
            float* ho = args.out + (size_t)(R - ROW_X0) * DM;
            f32x4 y[8], h[8], g[8]; load_row(Y + (size_t)R * DM, lane, y); load_row(ho, lane, h); load_row(args.in[I_MIXPOST], lane, g);
            const float rs = 1.0f / sqrtf(row_ssq(y) * (1.0f / DM) + EPS);
#pragma unroll
            for (int j = 0; j < 8; ++j) h[j] = h[j] + (y[j] * rs) * g[j];
            { GAS f32x4* o = (GAS f32x4*)ho + lane;
#pragma unroll
              for (int j = 0; j < 8; ++j) o[64 * j] = h[j]; }
            const float r2 = 1.0f / sqrtf(row_ssq(h) * (1.0f / DM) + EPS);
            store_row_bf16(XA + (size_t)R * DM, lane, h, r2);
        }
    }
#endif
    GRID_BAR();
#if PH_MASK & (1 << 11)
    { pg8::Gemm g{XA + (size_t)ROW_X0 * DM, WUP, SEQ, NUP, DM}; pg8::StaticOrder S; S.init(SEQ, NUP, G, bx); pg8::EpiSwiglu E{HID + (size_t)ROW_X0 * DFF, DFF};
      pg8::gemm_phase<pg8::EpiSwiglu, pg8::StaticOrder, true, true>(lds, g, S, E); }
#endif
    GRID_BAR();
#if PH_MASK & (1 << 12)
    { pg8::Gemm g{HID + (size_t)ROW_X0 * DFF, WDN, SEQ, DM, DFF}; pg8::StaticOrder S; S.init(SEQ, DM, G, bx); pg8::EpiF32 E{Y + (size_t)ROW_X0 * DM, DM};
      pg8::gemm_phase<pg8::EpiF32, pg8::StaticOrder, true, true>(lds, g, S, E); }
#endif
    GRID_BAR();
#if PH_MASK & (1 << 13)
    {
        for (int R = ROW_X0 + gw; R < MP; R += NGW) {
            float* ho = args.out + (size_t)(R - ROW_X0) * DM;
            f32x4 y[8], h[8], g[8]; load_row(Y + (size_t)R * DM, lane, y); load_row(ho, lane, h); load_row(args.in[I_F2POST], lane, g);
            const float rs = 0.5f / sqrtf(row_ssq(y) * (1.0f / DM) + EPS);
            GAS f32x4* o = (GAS f32x4*)ho + lane;
#pragma unroll
            for (int j = 0; j < 8; ++j) o[64 * j] = h[j] + (y[j] * rs) * g[j];
        }
    }
#endif
}

extern "C" void kernel_launch(void* const* d_in, const int* in_sizes, int n_in, void* d_out, int out_size, void* d_ws, size_t ws_size, hipStream_t stream) {
    static int grid = 0;
    if (grid == 0) {
        if (n_in != 27 || in_sizes[0] != SEQ * DM || out_size != SEQ * DM || ws_size < WS_END) { fprintf(stderr, "kernel_launch: unexpected shapes (n_in %d, in0 %d, out %d, ws %zu); nothing launched\n", n_in, n_in > 0 ? in_sizes[0] : -1, out_size, ws_size); grid = -1; return; }
        int dev = 0, cus = 0, per_cu = 0;
        if (hipGetDevice(&dev) != hipSuccess || hipDeviceGetAttribute(&cus, hipDeviceAttributeMultiprocessorCount, dev) != hipSuccess) { grid = -1; return; }
        if (hipFuncSetAttribute((const void*)mega_fwd, hipFuncAttributeMaxDynamicSharedMemorySize, LDS_BYTES) != hipSuccess) { fprintf(stderr, "kernel_launch: hipFuncSetAttribute failed\n"); grid = -1; return; }
        if (hipOccupancyMaxActiveBlocksPerMultiprocessor(&per_cu, (const void*)mega_fwd, NTHREADS, LDS_BYTES) != hipSuccess || per_cu < 1) { fprintf(stderr, "kernel_launch: occupancy query says %d blocks per CU\n", per_cu); (void)hipGetLastError(); grid = -1; return; }
        grid = cus;
    }
    if (grid < 0) return;
    if (hipMemsetAsync((char*)d_ws + WS_CTL, 0, CTL_ZERO_BYTES, stream) != hipSuccess) { fprintf(stderr, "kernel_launch: memset failed\n"); return; }
    Args a{};
    for (int i = 0; i < 27; ++i) a.in[i] = (const float*)d_in[i];
    a.out = (float*)d_out; a.ws = (unsigned char*)d_ws;
    hipLaunchKernelGGL(mega_fwd, dim3(grid), dim3(NTHREADS), LDS_BYTES, stream, a);
}
```

```cpp
#include <hip/hip_runtime.h>
#include <cstdio>
#include <cstdint>

constexpr int DM = 2048, SEQ = 8192, NMETA = 16, DFF = 5632, NUP = 2 * DFF, NIN = 10240, NIN_SRC = 10248;
constexpr int MP = 8448, ROW_X0 = 256, ROW_META0 = 240, ROW_PAD0 = 192, NCHUNK = 129;
constexpr float EPS = 1e-6f;
constexpr float QSCALE = 0.125f * 1.4426950408889634f;

constexpr size_t MiB = 1u << 20;
constexpr size_t WS_CTL = 0, CTL_ZERO_BYTES = 1 * MiB;
constexpr size_t WS_ROPE = 1 * MiB;
constexpr size_t WS_BIAS = 2 * MiB;
constexpr size_t WS_GW = 2 * MiB + 64 * 1024;
constexpr size_t WS_METAH = 2 * MiB + 256 * 1024;
constexpr size_t WS_GATES = 3 * MiB;
constexpr size_t WS_WUP = 4 * MiB;
constexpr size_t WS_WDN = 48 * MiB;
constexpr size_t WS_WIN = 70 * MiB;
constexpr size_t WS_WMB = 110 * MiB;
constexpr size_t WS_WAB = 114 * MiB;
constexpr size_t WS_WOUT = 118 * MiB;
constexpr size_t WS_XA = 126 * MiB;
constexpr size_t WS_U = 159 * MiB;
constexpr size_t WS_HID = WS_U;
constexpr size_t WS_Y = WS_U + 91 * MiB;
constexpr size_t WS_Z = WS_U;
constexpr size_t ZPIECE = (size_t)MP * 1024;
constexpr size_t WS_YG = WS_U;
constexpr size_t WS_HMG = 324 * MiB;
constexpr size_t WS_HA = WS_HMG + (size_t)MP * 1024 * 2;
constexpr size_t WS_HM = 357 * MiB;
constexpr size_t WS_END = 390 * MiB;
static_assert(WS_WUP + (size_t)NUP * DM * 2 <= WS_WDN && WS_WDN + (size_t)DM * DFF * 2 <= WS_WIN && WS_WIN + (size_t)NIN * DM * 2 <= WS_WMB, "ws map 1");
static_assert(WS_XA + (size_t)MP * DM * 2 <= WS_U && WS_HID + (size_t)MP * DFF * 2 <= WS_Y && WS_Y + (size_t)MP * DM * 4 <= WS_HMG, "ws map 2");
static_assert(WS_Z + (6 * ZPIECE + 2 * (size_t)MP * 2048) * 2 <= WS_HMG && WS_HA + (size_t)MP * 1024 * 2 <= WS_HM && WS_HM + (size_t)MP * 1024 * 4 <= WS_END, "ws map 3");
static_assert(WS_YG + (size_t)MP * 2048 * 2 <= WS_Y, "YG must not overlap Y");
constexpr int CW_BAR = 4096;

namespace pg8 {
#define PG8_LAS __attribute__((address_space(3)))
typedef unsigned short bf16_t;
typedef short bf16x8 __attribute__((ext_vector_type(8)));
typedef float f32x4 __attribute__((ext_vector_type(4)));
typedef unsigned u32x4 __attribute__((ext_vector_type(4)));
constexpr int BM = 256, BK = 64, HALF = 128, HTB = HALF * BK * 2  , STAGE_BYTES = 8 * HTB, NXCD = 8, WGM = 8;

__host__ __device__ __forceinline__ int lds_byte(int r, int c) { const int st = (r >> 4) * 2 + (c >> 5), rr = r & 15, cc = c & 31, ob = rr * 64 + cc * 2; return st * 1024 + (ob ^ (((ob >> 9) & 1) << 5)); }
__host__ __device__ __forceinline__ void stage_rc(int b, int& R, int& C) { const int st = b / 1024, sb = b % 1024, swz = sb ^ (((sb >> 9) & 1) << 5); R = (st >> 1) * 16 + swz / 64; C = (st & 1) * 32 + (swz % 64) / 2; }
__host__ __device__ __forceinline__ int perm32(int rho) { const int n = rho >> 4, i = rho & 15; return 8 * (i >> 2) + 4 * n + (i & 3); }

struct Unit { int pm, pn; };
struct Gemm { const bf16_t* A; const bf16_t* Bt; int M, N, K; };

struct StaticOrder {
    int nM, nN, nwg, G, c;
    __host__ __device__ void init(int M, int N, int G_, int c_) { nM = M / BM; nN = N / BM; nwg = nM * nN; G = G_; c = c_; }
    __host__ __device__ bool next(int i, Unit& u) const {
        const long L = (long)i * G + c; if (L >= nwg) return false;
        int wgid = (int)L; { const int q = nwg / NXCD, r = nwg % NXCD, xcd = wgid % NXCD, off = wgid / NXCD; wgid = (xcd < r ? xcd * (q + 1) : r * (q + 1) + (xcd - r) * q) + off; }
        const int nig = WGM * nN, gid = wgid / nig, fm = gid * WGM, gsz = (nM - fm) < WGM ? (nM - fm) : WGM;
        u.pm = fm + ((wgid % nig) % gsz); u.pn = (wgid % nig) / gsz; return true;
    }
    __device__ __forceinline__ void a_ready(const Unit&) const {}
    __device__ __forceinline__ void done(const Unit&) const {}
};

__device__ __forceinline__ unsigned cvt_pk_bf16(float lo, float hi) { unsigned r; asm volatile("v_cvt_pk_bf16_f32 %0, %1, %2" : "=v"(r) : "v"(lo), "v"(hi)); return r; }
typedef float f32x2 __attribute__((ext_vector_type(2)));
__device__ __forceinline__ float sigm(float x) { return __builtin_amdgcn_rcpf(1.0f + __expf(-x)); }
__device__ __forceinline__ float bflo(unsigned w) { return __uint_as_float(w << 16); }
__device__ __forceinline__ float bfhi(unsigned w) { return __uint_as_float(w & 0xffff0000u); }

struct EpiF32 {
    static constexpr bool PERM = false, AFTER_DRAIN = false;
    float* C; int ldc;
    __device__ __forceinline__ void operator()(const f32x4 (&acc)[2][2][4][2], const Unit& u, int wr, int wc, int fr, int fq) const {
        const int row0 = u.pm * BM + wr * 64 + fr, col0 = u.pn * BM + wc * 32 + 4 * fq;
#pragma unroll
        for (int ai = 0; ai < 2; ++ai)
#pragma unroll
            for (int m = 0; m < 4; ++m) { float* rowp = C + (size_t)(row0 + ai * HALF + m * 16) * ldc + col0;
#pragma unroll
                for (int bj = 0; bj < 2; ++bj)
#pragma unroll
                    for (int n = 0; n < 2; ++n) *(f32x4*)(rowp + bj * HALF + n * 16) = acc[ai][bj][m][n]; }
    }
};

struct EpiSwiglu {
    static constexpr bool PERM = true, AFTER_DRAIN = false;
    bf16_t* O; int ldc;
    __device__ __forceinline__ void operator()(const f32x4 (&acc)[2][2][4][2], const Unit& u, int wr, int wc, int fr, int fq) const {
        const int row0 = u.pm * BM + wr * 64 + fr, col0 = u.pn * HALF + wc * 32 + 8 * fq;
#pragma unroll
        for (int ai = 0; ai < 2; ++ai)
#pragma unroll
            for (int m = 0; m < 4; ++m) { bf16_t* rowp = O + (size_t)(row0 + ai * HALF + m * 16) * ldc + col0;
                const f32x4 g0 = acc[ai][0][m][0], g1 = acc[ai][0][m][1], u0 = acc[ai][1][m][0], u1 = acc[ai][1][m][1];
                float r[8];
#pragma unroll
                for (int i = 0; i < 4; ++i) { r[i] = g0[i] * sigm(g0[i]) * u0[i]; r[4 + i] = g1[i] * sigm(g1[i]) * u1[i]; }
                u32x4 w; w.x = cvt_pk_bf16(r[0], r[1]); w.y = cvt_pk_bf16(r[2], r[3]); w.z = cvt_pk_bf16(r[4], r[5]); w.w = cvt_pk_bf16(r[6], r[7]);
                *(u32x4*)rowp = w; }
    }
};

struct EpiZ {
    static constexpr bool PERM = true, AFTER_DRAIN = false;
    bf16_t* Z; const float* bias; const float* rope;
    __device__ __forceinline__ void operator()(const f32x4 (&acc)[2][2][4][2], const Unit& u, int wr, int wc, int fr, int fq) const {
        const int pn = u.pn, row0 = u.pm * BM + wr * 64 + fr;
        bf16_t* base; int ldc, colt;
        if (pn < 24) { base = Z + (size_t)(pn >> 2) * ZPIECE; ldc = 1024; colt = (pn & 3) * 256; }
        else { const int q = pn - 24; base = Z + 6 * ZPIECE + (size_t)(q >> 3) * ((size_t)MP * 2048); ldc = 2048; colt = (q & 7) * 256; }
        const int mode = ((pn >= 8 && pn < 12) || pn >= 24) ? 1 : ((pn >= 12 && pn < 20) ? 2 : 0);
        const float qs = (pn >= 12 && pn < 16) ? QSCALE : 1.0f;
        const int col0 = colt + wc * 32 + 8 * fq, bcol0 = pn * BM + wc * 32 + 8 * fq;
        f32x4 bv[2][2];
#pragma unroll
        for (int bj = 0; bj < 2; ++bj)
#pragma unroll
            for (int n = 0; n < 2; ++n) bv[bj][n] = *(const f32x4*)(bias + bcol0 + bj * HALF + 4 * n);
        const bool rot = ((wc & 1) == 0) && (fq < 2);
        const float sgn = (fq == 0) ? -1.0f : 1.0f;
#pragma unroll
        for (int ai = 0; ai < 2; ++ai)
#pragma unroll
            for (int m = 0; m < 4; ++m) { const int row = row0 + ai * HALF + m * 16; bf16_t* rowp = base + (size_t)row * ldc + col0;
#pragma unroll
                for (int bj = 0; bj < 2; ++bj) { f32x4 v0 = acc[ai][bj][m][0] + bv[bj][0], v1 = acc[ai][bj][m][1] + bv[bj][1];
                    if (mode == 1) {
#pragma unroll
                        for (int i = 0; i < 4; ++i) { v0[i] = sigm(v0[i]); v1[i] = sigm(v1[i]); }
                    } else if (mode == 2) {
                        f32x4 p0, p1;
#pragma unroll
                        for (int i = 0; i < 4; ++i) { p0[i] = __shfl_xor(v0[i], 16); p1[i] = __shfl_xor(v1[i], 16); }
                        if (rot) { int pos = row - ROW_META0; pos = pos < 0 ? 0 : pos; const float* rp = rope + (size_t)pos * 16;
                            const f32x4 c0 = *(const f32x4*)(rp), c1 = *(const f32x4*)(rp + 4), s0 = *(const f32x4*)(rp + 8), s1 = *(const f32x4*)(rp + 12);
#pragma unroll
                            for (int i = 0; i < 4; ++i) { v0[i] = v0[i] * c0[i] + sgn * p0[i] * s0[i]; v1[i] = v1[i] * c1[i] + sgn * p1[i] * s1[i]; } }
                        v0 = v0 * qs; v1 = v1 * qs;
                    }
                    u32x4 w; w.x = cvt_pk_bf16(v0[0], v0[1]); w.y = cvt_pk_bf16(v0[2], v0[3]); w.z = cvt_pk_bf16(v1[0], v1[1]); w.w = cvt_pk_bf16(v1[2], v1[3]);
                    *(u32x4*)(rowp + bj * HALF) = w; } }
    }
};

struct EpiGate {
    static constexpr bool PERM = true, AFTER_DRAIN = false;
    const bf16_t* G; bf16_t* O; int ldc; int accum;
    __device__ __forceinline__ void operator()(const f32x4 (&acc)[2][2][4][2], const Unit& u, int wr, int wc, int fr, int fq) const {
        const int row0 = u.pm * BM + wr * 64 + fr, col0 = u.pn * BM + wc * 32 + 8 * fq;
#pragma unroll
        for (int ai = 0; ai < 2; ++ai)
#pragma unroll
            for (int m = 0; m < 4; ++m) { const size_t off = (size_t)(row0 + ai * HALF + m * 16) * ldc + col0;
#pragma unroll
                for (int bj = 0; bj < 2; ++bj) { const u32x4 gw = *(const u32x4*)(G + off + bj * HALF);
                    f32x4 v0 = acc[ai][bj][m][0], v1 = acc[ai][bj][m][1];
                    v0[0] *= bflo(gw.x); v0[1] *= bfhi(gw.x); v0[2] *= bflo(gw.y); v0[3] *= bfhi(gw.y);
                    v1[0] *= bflo(gw.z); v1[1] *= bfhi(gw.z); v1[2] *= bflo(gw.w); v1[3] *= bfhi(gw.w);
                    if (accum) { const u32x4 ow = *(const u32x4*)(O + off + bj * HALF);
                        v0[0] += bflo(ow.x); v0[1] += bfhi(ow.x); v0[2] += bflo(ow.y); v0[3] += bfhi(ow.y);
                        v1[0] += bflo(ow.z); v1[1] += bfhi(ow.z); v1[2] += bflo(ow.w); v1[3] += bfhi(ow.w); }
                    u32x4 w; w.x = cvt_pk_bf16(v0[0], v0[1]); w.y = cvt_pk_bf16(v0[2], v0[3]); w.z = cvt_pk_bf16(v1[0], v1[1]); w.w = cvt_pk_bf16(v1[2], v1[3]);
                    *(u32x4*)(O + off + bj * HALF) = w; } }
    }
};

template <class Epi, class Sched, bool ALIGN_EPI = false, bool SP2 = false>
__device__ __forceinline__ void gemm_phase(PG8_LAS unsigned char* lds, const Gemm g, const Sched& S, const Epi& E) {
    int tid_ = threadIdx.x; asm volatile("" : "+v"(tid_));
    const int tid = tid_, wid = __builtin_amdgcn_readfirstlane(tid >> 6), lane = tid & 63, wr = wid >> 2, wc = wid & 3, fr = lane & 15, fq = lane >> 4;
    const int K = g.K, nt = K / BK;
    unsigned voffA[2], voffB[2];
#pragma unroll
    for (int i = 0; i < 2; ++i) { int R, C; stage_rc(tid * 16 + i * 8192, R, C); const int Rb = Epi::PERM ? ((R & ~31) + perm32(R & 31)) : R;
        voffA[i] = (unsigned)(R * K + C) * 2u; voffB[i] = (unsigned)(Rb * K + C) * 2u; }
    const size_t kstep = (size_t)(BK * 2);
    const size_t hstep = (size_t)HALF * K * 2;
    const size_t tstep = 2 * hstep;
    const unsigned ldsw = (unsigned)wid * 1024u;
    const int aoff = lds_byte(wr * 64 + fr, fq * 8), boff = lds_byte(wc * 32 + fr, fq * 8);
#define PG8_SA(b, h) (((b) * 2 + (h)) * HTB)
#define PG8_SB(b, h) ((4 + (b) * 2 + (h)) * HTB)
#define PG8_STAGE(bufoff, gbase, voff) do { _Pragma("unroll") for (int _i = 0; _i < 2; ++_i) \
        __builtin_amdgcn_global_load_lds((const unsigned*)((const char*)(gbase) + (voff)[_i]), (PG8_LAS unsigned*)(lds + (bufoff) + ldsw + _i * 8192), 16, 0, 0); } while (0)
#define PG8_LDA(dst, b, h) do { _Pragma("unroll") for (int m = 0; m < 4; ++m) _Pragma("unroll") for (int k = 0; k < 2; ++k) dst[m][k] = *(const PG8_LAS bf16x8*)(lds + PG8_SA(b, h) + aoff + m * 2048 + k * 1024); } while (0)
#define PG8_LDB(dst, b, h) do { _Pragma("unroll") for (int n = 0; n < 2; ++n) _Pragma("unroll") for (int k = 0; k < 2; ++k) dst[n][k] = *(const PG8_LAS bf16x8*)(lds + PG8_SB(b, h) + boff + n * 2048 + k * 1024); } while (0)
#define PG8_MMA(ai, bj, At, Bt) do { __builtin_amdgcn_s_setprio(1); _Pragma("unroll") for (int m = 0; m < 4; ++m) _Pragma("unroll") for (int n = 0; n < 2; ++n) _Pragma("unroll") for (int k = 0; k < 2; ++k) \
        acc[ai][bj][m][n] = __builtin_amdgcn_mfma_f32_16x16x32_bf16(Bt[n][k], At[m][k], acc[ai][bj][m][n], 0, 0, 0); __builtin_amdgcn_s_setprio(0); } while (0)
#define PG8_WAIT_V(n) asm volatile("s_waitcnt vmcnt(" #n ")" ::: "memory")
#define PG8_WAIT_L(n) asm volatile("s_waitcnt lgkmcnt(" #n ")" ::: "memory")
#define PG8_BAR __builtin_amdgcn_s_barrier()
#define PG8_SCHED __builtin_amdgcn_sched_barrier(0)
    Unit cur, nxt; int ui = 0;
    if (!S.next(0, cur)) return;
    f32x4 acc[2][2][4][2];
#pragma unroll
    for (int a = 0; a < 2; ++a)
#pragma unroll
        for (int b = 0; b < 2; ++b)
#pragma unroll
            for (int m = 0; m < 4; ++m)
#pragma unroll
                for (int n = 0; n < 2; ++n) acc[a][b][m][n] = (f32x4){0.f, 0.f, 0.f, 0.f};
    bf16x8 At[4][2], B0[2][2], B1[2][2];
    const char* cA = (const char*)g.A + (size_t)cur.pm * tstep; const char* cB = (const char*)g.Bt + (size_t)cur.pn * tstep;
    S.a_ready(cur);
    if constexpr (SP2) {
        PG8_STAGE(PG8_SB(0, 0), cB, voffB); PG8_STAGE(PG8_SB(0, 1), cB + hstep, voffB); PG8_STAGE(PG8_SA(0, 0), cA, voffA); PG8_STAGE(PG8_SA(0, 1), cA + hstep, voffA);
        if (wr == 1) PG8_BAR;
        PG8_WAIT_V(2); PG8_BAR;
        PG8_STAGE(PG8_SB(1, 0), cB + kstep, voffB); PG8_STAGE(PG8_SA(1, 0), cA + kstep, voffA); PG8_STAGE(PG8_SB(1, 1), cB + hstep + kstep, voffB);
        PG8_WAIT_V(6); PG8_BAR;
    } else {
        PG8_STAGE(PG8_SB(0, 0), cB, voffB); PG8_STAGE(PG8_SA(0, 0), cA, voffA); PG8_STAGE(PG8_SB(0, 1), cB + hstep, voffB); PG8_STAGE(PG8_SA(0, 1), cA + hstep, voffA);
        if (wr == 1) PG8_BAR;
        PG8_WAIT_V(4); PG8_BAR;
        PG8_STAGE(PG8_SB(1, 0), cB + kstep, voffB); PG8_STAGE(PG8_SA(1, 0), cA + kstep, voffA); PG8_STAGE(PG8_SB(1, 1), cB + hstep + kstep, voffB);
        PG8_WAIT_V(6); PG8_BAR;
    }
    for (;;) {
        const bool has_next = S.next(ui + 1, nxt);
        const char* nA = has_next ? (const char*)g.A + (size_t)nxt.pm * tstep : cA; const char* nB = has_next ? (const char*)g.Bt + (size_t)nxt.pn * tstep : cB;
        for (int t = 0; t < nt; t += 2) {
            const bool last = (t == nt - 2);
            const char* a1 = cA + (size_t)(t + 1) * kstep;
            const char* a2 = last ? nA : cA + (size_t)(t + 2) * kstep; const char* b2 = last ? nB : cB + (size_t)(t + 2) * kstep;
            const char* a3 = a2 + kstep; const char* b3 = b2 + kstep;
            if (last && has_next) S.a_ready(nxt);
            if constexpr (SP2) {
            PG8_LDB(B0, 0, 0); PG8_LDB(B1, 0, 1); PG8_SCHED; PG8_LDA(At, 0, 0); PG8_STAGE(PG8_SA(1, 1), a1 + hstep, voffA);
            PG8_WAIT_V(8); PG8_WAIT_L(0); PG8_BAR; PG8_MMA(0, 0, At, B0); PG8_MMA(0, 1, At, B1); PG8_BAR; PG8_SCHED;
            PG8_LDA(At, 0, 1); PG8_STAGE(PG8_SB(0, 0), b2, voffB); PG8_STAGE(PG8_SB(0, 1), b2 + hstep, voffB); PG8_STAGE(PG8_SA(0, 0), a2, voffA);
            PG8_WAIT_V(8); PG8_WAIT_L(0); PG8_BAR; PG8_MMA(1, 0, At, B0); PG8_MMA(1, 1, At, B1); PG8_BAR; PG8_SCHED;
            PG8_LDB(B0, 1, 0); PG8_LDB(B1, 1, 1); PG8_SCHED; PG8_LDA(At, 1, 0); PG8_STAGE(PG8_SA(0, 1), a2 + hstep, voffA);
            PG8_WAIT_V(8); PG8_WAIT_L(0); PG8_BAR; PG8_MMA(0, 0, At, B0); PG8_MMA(0, 1, At, B1); PG8_BAR; PG8_SCHED;
            PG8_LDA(At, 1, 1); PG8_STAGE(PG8_SB(1, 0), b3, voffB); PG8_STAGE(PG8_SB(1, 1), b3 + hstep, voffB); PG8_STAGE(PG8_SA(1, 0), a3, voffA);
            PG8_WAIT_V(8); PG8_WAIT_L(0); PG8_BAR; PG8_MMA(1, 0, At, B0); PG8_MMA(1, 1, At, B1); PG8_BAR; PG8_SCHED;
            } else {
            PG8_LDB(B0, 0, 0); PG8_SCHED; PG8_LDA(At, 0, 0); PG8_STAGE(PG8_SA(1, 1), a1 + hstep, voffA);
            PG8_WAIT_L(8); PG8_BAR; PG8_WAIT_L(0); PG8_MMA(0, 0, At, B0); PG8_BAR; PG8_SCHED;
            PG8_LDB(B1, 0, 1); PG8_STAGE(PG8_SB(0, 0), b2, voffB);
            PG8_BAR; PG8_WAIT_L(0); PG8_MMA(0, 1, At, B1); PG8_BAR;
            PG8_LDA(At, 0, 1); PG8_STAGE(PG8_SA(0, 0), a2, voffA);
            PG8_BAR; PG8_WAIT_L(0); PG8_MMA(1, 0, At, B0); PG8_BAR; PG8_SCHED;
            PG8_STAGE(PG8_SB(0, 1), b2 + hstep, voffB);
            PG8_WAIT_V(6); PG8_BAR; PG8_MMA(1, 1, At, B1); PG8_BAR;
            PG8_LDB(B0, 1, 0); PG8_SCHED; PG8_LDA(At, 1, 0); PG8_STAGE(PG8_SA(0, 1), a2 + hstep, voffA);
            PG8_WAIT_L(8); PG8_BAR; PG8_WAIT_L(0); PG8_MMA(0, 0, At, B0); PG8_BAR; PG8_SCHED;
            PG8_LDB(B1, 1, 1); PG8_STAGE(PG8_SB(1, 0), b3, voffB);
            PG8_BAR; PG8_WAIT_L(0); PG8_MMA(0, 1, At, B1); PG8_BAR;
            PG8_LDA(At, 1, 1); PG8_STAGE(PG8_SA(1, 0), a3, voffA);
            PG8_BAR; PG8_WAIT_L(0); PG8_MMA(1, 0, At, B0); PG8_BAR; PG8_SCHED;
            PG8_STAGE(PG8_SB(1, 1), b3 + hstep, voffB);
            PG8_WAIT_V(6); PG8_BAR; PG8_MMA(1, 1, At, B1); PG8_BAR;
            }
        }
        if constexpr (ALIGN_EPI) { if (wr == 0) PG8_BAR; }
        if constexpr (!Epi::AFTER_DRAIN) { E(acc, cur, wr, wc, fr, fq); S.done(cur); }
        if (!has_next) break;
#pragma unroll
        for (int a = 0; a < 2; ++a)
#pragma unroll
            for (int b = 0; b < 2; ++b)
#pragma unroll
                for (int m = 0; m < 4; ++m)
#pragma unroll
                    for (int n = 0; n < 2; ++n) acc[a][b][m][n] = (f32x4){0.f, 0.f, 0.f, 0.f};
        cur = nxt; cA = nA; cB = nB; ++ui;
        if constexpr (ALIGN_EPI) { if (wr == 1) PG8_BAR; }
    }
    PG8_WAIT_V(0);
    if constexpr (!ALIGN_EPI) { if (wr == 0) PG8_BAR; }
    PG8_BAR;
    if constexpr (Epi::AFTER_DRAIN) { E.fused(acc, cur, wr, wc, fr, fq, lds, wid, lane); S.done(cur); }
#undef PG8_SA
#undef PG8_SB
#undef PG8_STAGE
#undef PG8_LDA
#undef PG8_LDB
#undef PG8_MMA
#undef PG8_WAIT_V
#undef PG8_WAIT_L
#undef PG8_BAR
#undef PG8_SCHED
}
}
#define GAS __attribute__((address_space(1)))
#define LAS __attribute__((address_space(3)))
typedef unsigned short bf16;
typedef unsigned v4u __attribute__((ext_vector_type(4)));
typedef float f32x4 __attribute__((ext_vector_type(4)));
typedef short bf16x8 __attribute__((ext_vector_type(8)));
typedef GAS unsigned gu32;
typedef GAS unsigned long long gu64;
#define RLX_AGENT __ATOMIC_RELAXED, __HIP_MEMORY_SCOPE_AGENT
#define LDS_WAIT() asm volatile("s_waitcnt lgkmcnt(0)" ::: "memory")
#define VM_WAIT() asm volatile("s_waitcnt vmcnt(0)" ::: "memory")
__device__ __forceinline__ unsigned long long rt() { return __builtin_amdgcn_s_memrealtime(); }
__device__ __forceinline__ unsigned f2bf(float f) { unsigned u = __builtin_bit_cast(unsigned, f); return (u + 0x7fffu + ((u >> 16) & 1u)) >> 16; }
__device__ __forceinline__ unsigned pk2(float lo, float hi) { return f2bf(lo) | (f2bf(hi) << 16); }

#define XB_TMO      128
#define XB_XCNT(j)  (256  + 64 * (j))
#define XB_XSUB(j)  (1280 + 64 * (j))
#define XB_XGEN(j)  (2304 + 64 * (j))
#define XB_TOP      3328
#define XB_TOPGEN   3392
#define XCD_BAR_WORDS 3456
#define XB_SPIN_CAP (1u << 18)

__device__ __forceinline__ unsigned xb_ld(unsigned* p)              { return __hip_atomic_load(p, __ATOMIC_RELAXED, __HIP_MEMORY_SCOPE_AGENT); }
__device__ __forceinline__ unsigned xb_add(unsigned* p, unsigned v) { return __hip_atomic_fetch_add(p, v, __ATOMIC_RELAXED, __HIP_MEMORY_SCOPE_AGENT); }
__device__ __forceinline__ unsigned xb_xcc_id() { return (unsigned)__builtin_amdgcn_s_getreg((3 << 11) | 20) & 0xFu; }
#define XB_SPIN(cond, bar) do { unsigned _sp = 0; while (cond) { __builtin_amdgcn_s_sleep(1); \
    if ((++_sp & 255u) == 0u) { if (xb_ld(&(bar)[XB_TMO])) break; if (_sp > XB_SPIN_CAP) { atomicAdd(&(bar)[XB_TMO], 1u); break; } } } } while (0)

struct XcdBarrier {
    unsigned* bar; unsigned x;
    volatile LAS unsigned* st;
};

__device__ __forceinline__ XcdBarrier xcd_barrier_post(unsigned* bar, volatile LAS unsigned* st) {
    XcdBarrier b; b.bar = bar; b.x = xb_xcc_id(); b.st = st;
    if (threadIdx.x == 0) (void)xb_add(&bar[XB_XCNT(b.x)], 1u);
    return b;
}
__device__ __forceinline__ void xcd_barrier_complete(unsigned* bar, unsigned x, unsigned& nloc, unsigned& nx) {
    const unsigned G = gridDim.x * gridDim.y * gridDim.z;
    unsigned sum, cnt, mine, sp = 0u;
    for (;;) {
        sum = 0u; cnt = 0u; mine = 0u;
#pragma unroll
        for (unsigned j = 0; j < 16; ++j) { const unsigned c = xb_ld(&bar[XB_XCNT(j)]); sum += c; cnt += (c > 0u) ? 1u : 0u; mine = (j == x) ? c : mine; }
        if (sum == G) break;
        __builtin_amdgcn_s_sleep(1);
        if ((++sp & 255u) == 0u) { if (xb_ld(&bar[XB_TMO])) break; if (sp > XB_SPIN_CAP) { atomicAdd(&bar[XB_TMO], 1u); break; } }
    }
    nloc = mine > 0u ? mine : 1u; nx = cnt > 0u ? cnt : 1u;
}

__device__ __forceinline__ void xcd_barrier(const XcdBarrier& b) {
    asm volatile("s_waitcnt vmcnt(0)" ::: "memory");
    __syncthreads();
    if (threadIdx.x == 0) {
        unsigned* bar = b.bar;
        __builtin_amdgcn_s_waitcnt(0);
        unsigned nloc = b.st[0], nx = b.st[1];
        if (nloc == 0u) { xcd_barrier_complete(bar, b.x, nloc, nx); b.st[0] = nloc; b.st[1] = nx; }
        const unsigned old = xb_add(&bar[XB_XSUB(b.x)], 1u);
        const unsigned gen = old / nloc;
        if (old + 1u == (gen + 1u) * nloc) {
            __builtin_amdgcn_fence(__ATOMIC_RELEASE, "agent");
            asm volatile("s_waitcnt vmcnt(0)" ::: "memory");
            const unsigned og = xb_add(&bar[XB_TOP], 1u);
            const unsigned tg = og / nx;
            if (og + 1u == (tg + 1u) * nx) xb_add(&bar[XB_TOPGEN], 1u);
            else XB_SPIN(xb_ld(&bar[XB_TOPGEN]) == tg, bar);
            __builtin_amdgcn_fence(__ATOMIC_ACQUIRE, "agent");
            xb_add(&bar[XB_XGEN(b.x)], 1u);
            asm volatile("s_waitcnt vmcnt(0)" ::: "memory");
        } else {
            XB_SPIN(xb_ld(&bar[XB_XGEN(b.x)]) == gen, bar);
            __builtin_amdgcn_fence(__ATOMIC_ACQUIRE, "agent");
            asm volatile("s_waitcnt vmcnt(0)" ::: "memory");
        }
    }
    __syncthreads();
}
constexpr int NWAVES = 8, NTHREADS = 512;
constexpr int RING_BYTES = 131072, LDSCTL_OFF = RING_BYTES, MISC_OFF = LDSCTL_OFF + 320, LDS_BYTES = 147456;
typedef unsigned v2u __attribute__((ext_vector_type(2)));

#ifndef PH_MASK
#define PH_MASK 0xffff
#endif
struct Args { const float* in[27]; float* out; unsigned char* ws; };
enum { I_X = 0, I_META, I_F1PRE, I_F1POST, I_F1G, I_F1U, I_F1D, I_MIXPRE, I_MIXPOST, I_WIN, I_BIN, I_CONVW, I_CONVB, I_MNORM, I_MWB, I_LQ1, I_LK1, I_LQ2, I_LK2, I_ANORM, I_AWB, I_WOUT, I_F2PRE, I_F2POST, I_F2G, I_F2U, I_F2D };

__device__ __forceinline__ float wave_sum(float v) {
#pragma unroll
    for (int o = 1; o < 64; o <<= 1) v += __shfl_xor(v, o);
    return v;
}
__device__ __forceinline__ float bf2f(bf16 b) { return __uint_as_float(((unsigned)b) << 16); }

__device__ __forceinline__ void tr_item(const float* W, int ldw, int src_col0, int k0, bf16* WT, int K, int dst_row0, const float* sk, float scal, LAS float* scr, int lane) {
#pragma unroll 8
    for (int i = 0; i < 32; ++i) { const int kk = 2 * i + (lane >> 5);
        const float w = W[(size_t)(k0 + kk) * ldw + src_col0 + (lane & 31)];
        const float s = sk ? sk[k0 + kk] * scal : scal;
        scr[kk * 33 + (lane & 31)] = w * s; }
    LDS_WAIT(); asm volatile("" ::: "memory");
    const int c = lane & 7;
#pragma unroll
    for (int j = 0; j < 4; ++j) { const int n = (lane >> 3) + 8 * j; const LAS float* s = scr + (8 * c) * 33 + n;
        v4u o; o.x = pk2(s[0 * 33], s[1 * 33]); o.y = pk2(s[2 * 33], s[3 * 33]); o.z = pk2(s[4 * 33], s[5 * 33]); o.w = pk2(s[6 * 33], s[7 * 33]);
        *(GAS v4u*)(WT + (size_t)(dst_row0 + n) * K + k0 + 8 * c) = o; }
    LDS_WAIT(); asm volatile("" ::: "memory");
}

__device__ __forceinline__ void convert_ffn(const float* wg, const float* wu, const float* wd, const float* preg, bf16* WUP, bf16* WDN, LAS float* scr, int gw, int NGW, int lane) {
    constexpr int N_UP = (DM / 64) * (NUP / 32), N_DN = (DFF / 64) * (DM / 32);
    for (int it = gw; it < N_UP + N_DN; it += NGW) {
        if (it < N_UP) { const int nblk = NUP / 32, kb = it / nblk, nb = it % nblk, row0 = 32 * nb, pn = row0 >> 8, j = row0 & 255;
            const float* src = (j < 128) ? wg : wu; const int col0 = 128 * pn + (j & 127);
            tr_item(src, DFF, col0, 64 * kb, WUP, DM, row0, preg, 1.0f, scr, lane); }
        else { const int r = it - N_UP, nblk = DM / 32, kb = r / nblk, nb = r % nblk;
            tr_item(wd, DM, 32 * nb, 64 * kb, WDN, DFF, 32 * nb, nullptr, 1.0f, scr, lane); }
    }
}

__device__ __forceinline__ void sincos_small(double r, double& s, double& c) {
    const double r2 = r * r; double ts = 1.0, tc = 1.0;
#pragma unroll
    for (int k = 13; k >= 1; --k) { ts = 1.0 - ts * r2 / (double)((2 * k) * (2 * k + 1)); tc = 1.0 - tc * r2 / (double)((2 * k - 1) * (2 * k)); }
    s = r * ts; c = tc;
}

__device__ __forceinline__ void load_row(const float* p, int lane, f32x4 (&v)[8]) {
    const GAS f32x4* r = (const GAS f32x4*)p + lane;
#pragma unroll
    for (int j = 0; j < 8; ++j) v[j] = r[64 * j];
}
__device__ __forceinline__ float row_ssq(const f32x4 (&v)[8]) {
    float s = 0.f;
#pragma unroll
    for (int j = 0; j < 8; ++j) s += (v[j].x * v[j].x + v[j].y * v[j].y) + (v[j].z * v[j].z + v[j].w * v[j].w);
    return wave_sum(s);
}
__device__ __forceinline__ void store_row_bf16(bf16* p, int lane, const f32x4 (&v)[8], float sc) {
    GAS v2u* o = (GAS v2u*)p + lane;
#pragma unroll
    for (int j = 0; j < 8; ++j) { v2u w; w.x = pk2(v[j].x * sc, v[j].y * sc); w.y = pk2(v[j].z * sc, v[j].w * sc); o[64 * j] = w; }
}

__device__ __forceinline__ float log_sigmoid(float x) { return fminf(x, 0.f) - log1pf(__expf(-fabsf(x))); }

__device__ __forceinline__ void mlstm_naive(LAS float* L, int h, int s, const bf16* QK, const bf16* MV, const float* GATES, const float* convw, const float* convb, float* HM, int tid) {
    LAS float* qs = L;
    LAS float* ks = qs + 64 * 129;
    LAS float* vs = ks + 64 * 129;
    LAS float* Ss = vs + 64 * 32;
    LAS float* Cs = Ss + 64 * 65;
    LAS float* ns = Cs + 128 * 33;
    LAS float* bb = ns + 128;
    LAS float* aa = bb + 64;
    LAS float* lis = aa + 64;
    LAS float* lfs = lis + 64;
    LAS float* mrow = lfs + 64;
    LAS float* wint = mrow + 64;
    LAS float* den = wint + 64;
    LAS float* sc = den + 64;
    for (int i = tid; i < 128 * 33; i += NTHREADS) Cs[i] = 0.f;
    if (tid < 128) ns[tid] = 0.f;
    float mst = 0.f;
    __syncthreads();
    for (int c = 0; c < NCHUNK; ++c) {
        const int R0 = ROW_PAD0 + 64 * c;
#pragma unroll 1
        for (int idx = tid; idx < 64 * 256; idx += NTHREADS) { const int j = idx >> 8, col = idx & 255; const bool isk = col >= 128;
            const int cc = isk ? (512 + h * 128 + (col - 128)) : (h * 128 + col); const int R = R0 + j; float val = 0.f;
            if (R >= ROW_META0) { float a = convb[cc];
#pragma unroll
                for (int jj = 0; jj < 4; ++jj) { const int Rr = R - 3 + jj; const float xv = (Rr >= ROW_META0) ? bf2f(QK[(size_t)Rr * 1024 + cc]) : 0.f; a += convw[jj * 1024 + cc] * xv; }
                val = a * pg8::sigm(a); if (isk) val *= 0.08838834764831845f; }
            if (isk) ks[j * 129 + (col - 128)] = val; else qs[j * 129 + col] = val; }
        for (int idx = tid; idx < 64 * 32; idx += NTHREADS) { const int j = idx >> 5, e = idx & 31; const int R = R0 + j;
            vs[idx] = (R >= ROW_META0) ? bf2f(MV[(size_t)R * 1024 + h * 256 + s * 32 + e]) : 0.f; }
        if (tid < 64) { const int R = R0 + tid; lis[tid] = GATES[(size_t)R * 8 + h]; lfs[tid] = GATES[(size_t)R * 8 + 4 + h]; }
        __syncthreads();
        if (tid == 0) { float b = 0.f;
#pragma unroll 1
            for (int j = 0; j < 64; ++j) { b += lfs[j]; bb[j] = b; }
            const float g = b; float ml = -INFINITY;
#pragma unroll 1
            for (int j = 0; j < 64; ++j) { const float a = g - bb[j] + lis[j]; aa[j] = a; ml = fmaxf(ml, a); }
            sc[0] = g; sc[1] = ml; }
        __syncthreads();
        const float g = sc[0], mloc = sc[1]; const float mnew = fmaxf(g + mst, mloc);
        if (tid < 64) { const int i = tid; float mx = bb[i] + mst;
#pragma unroll 1
            for (int j = 0; j <= i; ++j) mx = fmaxf(mx, bb[i] - bb[j] + lis[j]); mrow[i] = mx; wint[i] = __expf(bb[i] + mst - mx); }
        __syncthreads();
        { const int i = tid >> 3, j0 = tid & 7; float acc[8];
#pragma unroll
            for (int jj = 0; jj < 8; ++jj) acc[jj] = 0.f;
#pragma unroll 2
            for (int d = 0; d < 128; ++d) { const float qv = qs[i * 129 + d];
#pragma unroll
                for (int jj = 0; jj < 8; ++jj) acc[jj] += qv * ks[(j0 + 8 * jj) * 129 + d]; }
#pragma unroll
            for (int jj = 0; jj < 8; ++jj) { const int j = j0 + 8 * jj; Ss[i * 65 + j] = (j <= i) ? acc[jj] * __expf(bb[i] - bb[j] + lis[j] - mrow[i]) : 0.f; } }
        __syncthreads();
        if (tid < 64) { const int i = tid; float a = 0.f;
#pragma unroll 4
            for (int d = 0; d < 128; ++d) a += qs[i * 129 + d] * ns[d];
            float b = 0.f;
#pragma unroll 4
            for (int j = 0; j < 64; ++j) b += Ss[i * 65 + j];
            den[i] = wint[i] * a + b; }
        __syncthreads();
        { const int i = tid >> 3, e0 = (tid & 7) * 4; float a[4] = {0.f, 0.f, 0.f, 0.f}, b[4] = {0.f, 0.f, 0.f, 0.f};
#pragma unroll 2
            for (int d = 0; d < 128; ++d) { const float qv = qs[i * 129 + d];
#pragma unroll
                for (int e = 0; e < 4; ++e) a[e] += qv * Cs[d * 33 + e0 + e]; }
#pragma unroll 2
            for (int j = 0; j < 64; ++j) { const float sv = Ss[i * 65 + j];
#pragma unroll
                for (int e = 0; e < 4; ++e) b[e] += sv * vs[j * 32 + e0 + e]; }
            const float dn = fmaxf(fabsf(den[i]), __expf(-mrow[i])); const float w = wint[i];
            f32x4 o; o.x = (w * a[0] + b[0]) / dn; o.y = (w * a[1] + b[1]) / dn; o.z = (w * a[2] + b[2]) / dn; o.w = (w * a[3] + b[3]) / dn;
            *(f32x4*)(HM + (size_t)(R0 + i) * 1024 + h * 256 + s * 32 + e0) = o; }
        __syncthreads();
        if (tid < 64) aa[tid] = __expf(aa[tid] - mnew);
        __syncthreads();
        { const float decay = __expf(g + mst - mnew); const int d = tid >> 2, e0 = (tid & 3) * 8; float a[8];
#pragma unroll
            for (int e = 0; e < 8; ++e) a[e] = decay * Cs[d * 33 + e0 + e];
#pragma unroll 2
            for (int j = 0; j < 64; ++j) { const float kv = aa[j] * ks[j * 129 + d];
#pragma unroll
                for (int e = 0; e < 8; ++e) a[e] += kv * vs[j * 32 + e0 + e]; }
#pragma unroll
            for (int e = 0; e < 8; ++e) Cs[d * 33 + e0 + e] = a[e];
            if (tid < 128) { float nn = decay * ns[tid];
#pragma unroll 4
                for (int j = 0; j < 64; ++j) nn += aa[j] * ks[j * 129 + tid];
                ns[tid] = nn; } }
        mst = mnew;
        __syncthreads();
    }
}

namespace fa {
typedef float f32x16 __attribute__((ext_vector_type(16)));
typedef short s16x4 __attribute__((ext_vector_type(4)));
typedef short v4i16_t __attribute__((ext_vector_type(4)));
constexpr int KSLOT = 8192, VSLOT = 16384;
constexpr int L_K = 0, L_V = 2 * KSLOT, L_WS = L_V + 2 * VSLOT, L_END = L_WS + 8 * 256;
__device__ __forceinline__ int crow(int r, int hi) { return (r & 3) + 8 * (r >> 2) + 4 * hi; }
__device__ __forceinline__ s16x4 vtr(const LAS unsigned char* p) { return __builtin_bit_cast(s16x4, __builtin_amdgcn_ds_read_tr16_b64_v4i16((LAS v4i16_t*)p)); }
__device__ __forceinline__ unsigned cvtpk(float lo, float hi) { return pg8::cvt_pk_bf16(lo, hi); }

__device__ __forceinline__ void attn_unit(LAS unsigned char* lds, int sh, int qb, const bf16* AQ, const bf16* AK, const bf16* AV, bf16* OS) {
    int tid_ = threadIdx.x; asm volatile("" : "+v"(tid_));
    const int tid = tid_, lane = tid & 63, r32 = lane & 31, hi = lane >> 5, wid = __builtin_amdgcn_readfirstlane(tid >> 6);
    const int hh = sh >> 1, NT = 4 * qb + 5, cq = 4 * qb + 1 + (wid >> 1);
    const int qrow0 = ROW_X0 + 256 * qb + 32 * wid;
    bf16x8 qr[4];
    { const bf16* Qw = AQ + (size_t)(qrow0 + r32) * 1024 + sh * 64 + hi * 8;
#pragma unroll
      for (int d0 = 0; d0 < 4; ++d0) qr[d0] = *(const bf16x8*)(Qw + d0 * 16); }
    const bf16* ksrc = AK + (size_t)(ROW_PAD0 + lane) * 1024 + sh * 64 + wid * 8;
    const bf16* vsrc = AV + (size_t)(ROW_PAD0 + 32 * (wid & 1) + (lane >> 2)) * 1024 + hh * 128 + (wid >> 1) * 32 + (lane & 3) * 8;
    LAS float* wsf = (LAS float*)(lds + L_WS) + wid * 64;
    const LAS unsigned char* kbase = lds + L_K + hi * 1024 + r32 * 16;
    const LAS unsigned char* vbase = lds + L_V + ((lane >> 4) & 1) * 32 + (lane & 3) * 8 + (4 * hi + ((lane & 15) >> 2)) * 64;
#define FA_DMA(t, buf) do { const size_t go_ = (size_t)(t) * 65536; \
        __builtin_amdgcn_global_load_lds((const unsigned*)(ksrc + go_), (LAS unsigned*)(lds + L_K + (buf) * KSLOT + wid * 1024), 16, 0, 0); \
        __builtin_amdgcn_global_load_lds((const unsigned*)(vsrc + go_), (LAS unsigned*)(lds + L_V + (buf) * VSLOT + wid * 2048), 16, 0, 0); \
        __builtin_amdgcn_global_load_lds((const unsigned*)(vsrc + go_ + 16 * 1024), (LAS unsigned*)(lds + L_V + (buf) * VSLOT + wid * 2048 + 1024), 16, 0, 0); } while (0)
    f32x16 o[4];
#pragma unroll
    for (int d0 = 0; d0 < 4; ++d0)
#pragma unroll
        for (int r = 0; r < 16; ++r) o[d0][r] = 0.f;
    float m = -1e30f, l = 0.f;
    FA_DMA(0, 0);
    asm volatile("s_waitcnt vmcnt(0) lgkmcnt(0)\n\ts_barrier" ::: "memory");
    for (int t = 0; t < NT; ++t) {
        const int buf = t & 1;
        if (t + 1 < NT) FA_DMA(t + 1, buf ^ 1);
        if (t <= cq) {
            const LAS unsigned char* kp = kbase + buf * KSLOT;
            f32x16 p0, p1;
#pragma unroll
            for (int r = 0; r < 16; ++r) { p0[r] = 0.f; p1[r] = 0.f; }
#pragma unroll
            for (int d0 = 0; d0 < 4; ++d0) {
                const bf16x8 k0 = *(const LAS bf16x8*)(kp + d0 * 2048), k1 = *(const LAS bf16x8*)(kp + d0 * 2048 + 512);
                p0 = __builtin_amdgcn_mfma_f32_32x32x16_bf16(k0, qr[d0], p0, 0, 0, 0);
                p1 = __builtin_amdgcn_mfma_f32_32x32x16_bf16(k1, qr[d0], p1, 0, 0, 0); }
            if (t == 0) {
#pragma unroll
                for (int r = 0; r < 16; ++r) p0[r] = -INFINITY;
#pragma unroll
                for (int r = 0; r < 8; ++r) p1[r] = -INFINITY; }
            float rm = fmaxf(p0[0], p1[0]);
#pragma unroll
            for (int r = 1; r < 16; ++r) rm = fmaxf(rm, fmaxf(p0[r], p1[r]));
            { auto rr = __builtin_amdgcn_permlane32_swap(__float_as_uint(rm), __float_as_uint(rm), false, false); rm = fmaxf(__uint_as_float(rr[0]), __uint_as_float(rr[1])); }
            if (__any(rm > m)) {
                const float mn = fmaxf(m, rm), alpha = exp2f(m - mn); l *= alpha; m = mn;
                if (hi == 0) wsf[r32] = alpha;
#pragma unroll
                for (int r = 0; r < 16; ++r) { const float a = wsf[crow(r, hi)];
#pragma unroll
                    for (int d0 = 0; d0 < 4; ++d0) o[d0][r] *= a; }
            }
            float ls = 0.f;
#pragma unroll
            for (int r = 0; r < 16; ++r) { p0[r] = exp2f(p0[r] - m); p1[r] = exp2f(p1[r] - m); ls += p0[r] + p1[r]; }
            l += ls;
            v4u pw[4];
#pragma unroll
            for (int i = 0; i < 4; ++i) { pw[0][i] = cvtpk(p0[2 * i], p0[2 * i + 1]); pw[1][i] = cvtpk(p0[8 + 2 * i], p0[8 + 2 * i + 1]); pw[2][i] = cvtpk(p1[2 * i], p1[2 * i + 1]); pw[3][i] = cvtpk(p1[8 + 2 * i], p1[8 + 2 * i + 1]); }
            const LAS unsigned char* vp = vbase + buf * VSLOT;
#pragma unroll
            for (int d0 = 0; d0 < 4; ++d0)
#pragma unroll
                for (int ks = 0; ks < 4; ++ks) {
                    const s16x4 lo = vtr(vp + d0 * 4096 + ks * 1024), hi4 = vtr(vp + d0 * 4096 + ks * 1024 + 512);
                    const bf16x8 vf = (bf16x8){lo[0], lo[1], lo[2], lo[3], hi4[0], hi4[1], hi4[2], hi4[3]};
                    o[d0] = __builtin_amdgcn_mfma_f32_32x32x16_bf16(__builtin_bit_cast(bf16x8, pw[ks]), vf, o[d0], 0, 0, 0); }
        }
        asm volatile("s_waitcnt vmcnt(0) lgkmcnt(0)\n\ts_barrier" ::: "memory");
    }
    { auto rr = __builtin_amdgcn_permlane32_swap(__float_as_uint(l), __float_as_uint(l), false, false); l = __uint_as_float(rr[0]) + __uint_as_float(rr[1]); }
    if (hi == 0) wsf[32 + r32] = l;
    bf16* Ow = OS + (size_t)qrow0 * 2048 + sh * 128 + r32;
#pragma unroll
    for (int r = 0; r < 16; ++r) { const float rl = 1.0f / wsf[32 + crow(r, hi)]; bf16* op = Ow + (size_t)crow(r, hi) * 2048;
#pragma unroll
        for (int d0 = 0; d0 < 4; ++d0) op[d0 * 32] = (bf16)f2bf(o[d0][r] * rl); }
    asm volatile("s_waitcnt lgkmcnt(0)\n\ts_barrier" ::: "memory");
#undef FA_DMA
}
}
__global__ void __launch_bounds__(NTHREADS, 2) mega_fwd(Args args) {
    extern __shared__ __attribute__((aligned(16))) unsigned char lds_raw[];
    LAS unsigned char* lds = (LAS unsigned char*)lds_raw;
    volatile LAS unsigned* MISC = (volatile LAS unsigned*)(lds + MISC_OFF);
    const int tid = threadIdx.x, lane = tid & 63, wave = __builtin_amdgcn_readfirstlane(tid >> 6);
    const int G = gridDim.x, bx = blockIdx.x;
    const int vcu = (G % 8 == 0) ? (bx % 8) * (G / 8) + bx / 8 : bx;
    unsigned char* ws = args.ws;
    gu32* ctl = (gu32*)(ws + WS_CTL);
    for (int u = tid; u < (LDS_BYTES - LDSCTL_OFF) / 4; u += NTHREADS) ((LAS unsigned*)(lds + LDSCTL_OFF))[u] = 0u;
    __syncthreads();
    XcdBarrier bar = xcd_barrier_post((unsigned*)(ctl + CW_BAR), MISC + 8);
#define GRID_BAR() xcd_barrier(bar)

    float* ROPE = (float*)(ws + WS_ROPE); float* BIAS = (float*)(ws + WS_BIAS); float* GW = (float*)(ws + WS_GW); float* METAH = (float*)(ws + WS_METAH);
    float* GATES = (float*)(ws + WS_GATES);
    bf16* WUP = (bf16*)(ws + WS_WUP); bf16* WDN = (bf16*)(ws + WS_WDN); bf16* WIN = (bf16*)(ws + WS_WIN); bf16* WMB = (bf16*)(ws + WS_WMB); bf16* WAB = (bf16*)(ws + WS_WAB); bf16* WOUT = (bf16*)(ws + WS_WOUT);
    bf16* XA = (bf16*)(ws + WS_XA); bf16* HID = (bf16*)(ws + WS_HID); float* Y = (float*)(ws + WS_Y); bf16* Z = (bf16*)(ws + WS_Z); bf16* YG = (bf16*)(ws + WS_YG);
    bf16* HMG = (bf16*)(ws + WS_HMG); bf16* HA = (bf16*)(ws + WS_HA); float* HM = (float*)(ws + WS_HM);
    bf16* ZQK = Z; bf16* ZMV = Z + ZPIECE; bf16* ZMO = Z + 2 * ZPIECE; bf16* ZAQ = Z + 3 * ZPIECE; bf16* ZAK = Z + 4 * ZPIECE; bf16* ZAV = Z + 5 * ZPIECE;
    bf16* ZGM = Z + 6 * ZPIECE; bf16* ZGA = ZGM + (size_t)MP * 2048;
    const int gw = vcu * NWAVES + wave, NGW = G * NWAVES;
    LAS float* scr = (LAS float*)(lds + wave * 16384);

#if PH_MASK & (1 << 0)
    {
        convert_ffn(args.in[I_F1G], args.in[I_F1U], args.in[I_F1D], args.in[I_F1PRE], WUP, WDN, scr, gw, NGW, lane);
        constexpr int N_IN = (DM / 64) * (NIN / 32), N_MB = (1024 / 64) * (DM / 32), N_WO = (DM / 64) * (DM / 32);
        for (int it = gw; it < N_IN + 2 * N_MB + N_WO; it += NGW) {
            int r = it;
            if (r < N_IN) { const int nblk = NIN / 32, kb = r / nblk, nb = r % nblk, row0 = 32 * nb; const int col0 = row0 < 3072 ? row0 : row0 + 8;
                tr_item(args.in[I_WIN], NIN_SRC, col0, 64 * kb, WIN, DM, row0, args.in[I_MIXPRE], 1.0f, scr, lane); continue; } r -= N_IN;
            if (r < N_MB) { const int nblk = DM / 32, kb = r / nblk, nb = r % nblk; tr_item(args.in[I_MWB], DM, 32 * nb, 64 * kb, WMB, 1024, 32 * nb, args.in[I_MNORM], 1.0f, scr, lane); continue; } r -= N_MB;
            if (r < N_MB) { const int nblk = DM / 32, kb = r / nblk, nb = r % nblk; tr_item(args.in[I_AWB], DM, 32 * nb, 64 * kb, WAB, 1024, 32 * nb, args.in[I_ANORM], 0.8f, scr, lane); continue; } r -= N_MB;
            { const int nblk = DM / 32, kb = r / nblk, nb = r % nblk; tr_item(args.in[I_WOUT], DM, 32 * nb, 64 * kb, WOUT, DM, 32 * nb, nullptr, 1.0f, scr, lane); }
        }
        const int gt = vcu * NTHREADS + tid, NGT = G * NTHREADS;
        for (int i = gt; i < NIN; i += NGT) BIAS[i] = args.in[I_BIN][i < 3072 ? i : i + 8];
        for (int i = gt; i < 8 * DM; i += NGT) { const int c = i / DM, k = i % DM; GW[i] = args.in[I_WIN][(size_t)k * NIN_SRC + 3072 + c] * args.in[I_MIXPRE][k]; }
        for (int i = gt; i < (SEQ + NMETA) * 8; i += NGT) { const int pos = i >> 3, k = i & 7;
            const float invf = k == 0 ? 1.0f : k == 1 ? 0.19392274474868576f : k == 2 ? 0.03760603093086393f : k == 3 ? 0.007292664737217109f : k == 4 ? 0.001414213562373095f : k == 5 ? 0.0002742481756762073f : k == 6 ? 5.318295896944988e-05f : 1.031338537721246e-05f;
            const float ang = (float)pos * invf; const double a = (double)ang;
            const double q = rint(a * 0.15915494309189535); const double rr = a - q * 6.283185307179586476925;
            double s, c; sincos_small(rr, s, c);
            ROPE[(size_t)pos * 16 + k] = (float)c; ROPE[(size_t)pos * 16 + 8 + k] = (float)s; }
        for (int R = gw; R < MP; R += NGW) {
            bf16* xo = XA + (size_t)R * DM;
            if (R < ROW_META0) { GAS v2u* o = (GAS v2u*)xo + lane; v2u z; z.x = 0u; z.y = 0u;
#pragma unroll
                for (int j = 0; j < 8; ++j) o[64 * j] = z; }
            else { const float* hp = (R >= ROW_X0) ? args.in[I_X] + (size_t)(R - ROW_X0) * DM : args.in[I_META] + (size_t)(R - ROW_META0) * DM;
                f32x4 v[8]; load_row(hp, lane, v); const float r1 = 1.0f / sqrtf(row_ssq(v) * (1.0f / DM) + EPS); store_row_bf16(xo, lane, v, r1); }
        }
    }
#endif
    GRID_BAR();

#if PH_MASK & (1 << 1)
    { pg8::Gemm g{XA, WUP, MP, NUP, DM}; pg8::StaticOrder S; S.init(MP, NUP, G, bx); pg8::EpiSwiglu E{HID, DFF};
      pg8::gemm_phase<pg8::EpiSwiglu, pg8::StaticOrder, true, true>(lds, g, S, E); }
#endif
    GRID_BAR();
#if PH_MASK & (1 << 2)
    { pg8::Gemm g{HID, WDN, MP, DM, DFF}; pg8::StaticOrder S; S.init(MP, DM, G, bx); pg8::EpiF32 E{Y, DM};
      pg8::gemm_phase<pg8::EpiF32, pg8::StaticOrder, true, true>(lds, g, S, E); }
#endif
    GRID_BAR();
#if PH_MASK & (1 << 3)
    {
        for (int R = ROW_PAD0 + gw; R < MP; R += NGW) {
            if (R < ROW_META0) { if (lane < 8) GATES[(size_t)R * 8 + lane] = (lane < 4) ? -INFINITY : 0.f; continue; }
            const float* hp = (R >= ROW_X0) ? args.in[I_X] + (size_t)(R - ROW_X0) * DM : args.in[I_META] + (size_t)(R - ROW_META0) * DM;
            float* ho = (R >= ROW_X0) ? args.out + (size_t)(R - ROW_X0) * DM : METAH + (size_t)(R - ROW_META0) * DM;
            f32x4 y[8], h[8], g[8]; load_row(Y + (size_t)R * DM, lane, y); load_row(hp, lane, h); load_row(args.in[I_F1POST], lane, g);
            const float rs = 0.5f / sqrtf(row_ssq(y) * (1.0f / DM) + EPS);
#pragma unroll
            for (int j = 0; j < 8; ++j) h[j] = h[j] + (y[j] * rs) * g[j];
            { GAS f32x4* o = (GAS f32x4*)ho + lane;
#pragma unroll
              for (int j = 0; j < 8; ++j) o[64 * j] = h[j]; }
            const float r2 = 1.0f / sqrtf(row_ssq(h) * (1.0f / DM) + EPS);
            store_row_bf16(XA + (size_t)R * DM, lane, h, r2);
            float gv = 0.f;
#pragma unroll 1
            for (int c = 0; c < 8; ++c) { const GAS f32x4* wp = (const GAS f32x4*)(GW + (size_t)c * DM) + lane; float s = 0.f;
#pragma unroll
                for (int j = 0; j < 8; ++j) { const f32x4 w = wp[64 * j]; s += (h[j].x * w.x + h[j].y * w.y) + (h[j].z * w.z + h[j].w * w.w); }
                s = wave_sum(s); if (lane == c) gv = s; }
            if (lane < 8) { float v = gv * r2 + args.in[I_BIN][3072 + lane]; if (lane >= 4) v = log_sigmoid(v); GATES[(size_t)R * 8 + lane] = v; }
        }
        convert_ffn(args.in[I_F2G], args.in[I_F2U], args.in[I_F2D], args.in[I_F2PRE], WUP, WDN, scr, gw, NGW, lane);
    }
#endif
    GRID_BAR();
#if PH_MASK & (1 << 4)
    { pg8::Gemm g{XA, WIN, MP, NIN, DM}; pg8::StaticOrder S; S.init(MP, NIN, G, bx); pg8::EpiZ E{Z, BIAS, ROPE};
      pg8::gemm_phase<pg8::EpiZ, pg8::StaticOrder, true, true>(lds, g, S, E); }
#endif
    GRID_BAR();
#if PH_MASK & (1 << 5)
    {
        bf16* OS = XA;
        if (bx < 32) mlstm_naive((LAS float*)lds, bx >> 3, bx & 7, ZQK, ZMV, GATES, args.in[I_CONVW], args.in[I_CONVB], HM, tid);
        __syncthreads();
        for (int u = bx; u < 256; u += G) { const int x = u & 7, j = u >> 3, sh = 2 * x + (j & 1), p = j >> 1;
            fa::attn_unit(lds, sh, p, ZAQ, ZAK, ZAV, OS);
            fa::attn_unit(lds, sh, 31 - p, ZAQ, ZAK, ZAV, OS); }
    }
#endif
    GRID_BAR();
#if PH_MASK & (1 << 6)
    {
        float s1 = 0.f, s2 = 0.f;
        { const float a1 = args.in[I_LQ1][lane] * args.in[I_LK1][lane], a2 = args.in[I_LQ2][lane] * args.in[I_LK2][lane]; s1 = wave_sum(a1); s2 = wave_sum(a2); }
        const float lam = expf(s1) - expf(s2) + 0.2f;
        const bf16* OS = XA;
        for (int R = ROW_X0 + gw; R < MP; R += NGW) {
            const GAS f32x4* hp = (const GAS f32x4*)(HM + (size_t)R * 1024) + lane; const GAS v2u* mp = (const GAS v2u*)(ZMO + (size_t)R * 1024) + lane; GAS v2u* op = (GAS v2u*)(HMG + (size_t)R * 1024) + lane;
#pragma unroll
            for (int j = 0; j < 4; ++j) { const f32x4 v = hp[64 * j]; const float ss = wave_sum((v.x * v.x + v.y * v.y) + (v.z * v.z + v.w * v.w));
                const float rs = 1.0f / sqrtf(ss * (1.0f / 256.0f) + EPS); const v2u mo = mp[64 * j];
                v2u w; w.x = pk2(v.x * rs * pg8::bflo(mo.x), v.y * rs * pg8::bfhi(mo.x)); w.y = pk2(v.z * rs * pg8::bflo(mo.y), v.w * rs * pg8::bfhi(mo.y)); op[64 * j] = w; }
            const GAS unsigned* osr = (const GAS unsigned*)(OS + (size_t)R * 2048) + lane; GAS unsigned* hao = (GAS unsigned*)(HA + (size_t)R * 1024) + lane;
#pragma unroll
            for (int hh = 0; hh < 8; ++hh) { const unsigned w1 = osr[hh * 128], w2 = osr[hh * 128 + 64];
                const float v0 = pg8::bflo(w1) - lam * pg8::bflo(w2), v1 = pg8::bfhi(w1) - lam * pg8::bfhi(w2);
                const float ss = wave_sum(v0 * v0 + v1 * v1); const float rs = 1.0f / sqrtf(ss * (1.0f / 128.0f) + EPS);
                hao[hh * 64] = pk2(v0 * rs, v1 * rs); }
        }
    }
#endif
    GRID_BAR();
#if PH_MASK & (1 << 7)
    { pg8::Gemm g{HMG + (size_t)ROW_X0 * 1024, WMB, SEQ, DM, 1024}; pg8::StaticOrder S; S.init(SEQ, DM, G, bx); pg8::EpiGate E{ZGM + (size_t)ROW_X0 * 2048, YG + (size_t)ROW_X0 * 2048, DM, 0};
      pg8::gemm_phase<pg8::EpiGate, pg8::StaticOrder, true, true>(lds, g, S, E); }
#endif
    GRID_BAR();
#if PH_MASK & (1 << 8)
    { pg8::Gemm g{HA + (size_t)ROW_X0 * 1024, WAB, SEQ, DM, 1024}; pg8::StaticOrder S; S.init(SEQ, DM, G, bx); pg8::EpiGate E{ZGA + (size_t)ROW_X0 * 2048, YG + (size_t)ROW_X0 * 2048, DM, 1};
      pg8::gemm_phase<pg8::EpiGate, pg8::StaticOrder, true, true>(lds, g, S, E); }
#endif
    GRID_BAR();
#if PH_MASK & (1 << 9)
    { pg8::Gemm g{YG + (size_t)ROW_X0 * 2048, WOUT, SEQ, DM, DM}; pg8::StaticOrder S; S.init(SEQ, DM, G, bx); pg8::EpiF32 E{Y + (size_t)ROW_X0 * DM, DM};
      pg8::gemm_phase<pg8::EpiF32, pg8::StaticOrder, true, true>(lds, g, S, E); }
#endif
    GRID_BAR();
#if PH_MASK & (1 << 10)
    {
        for (int R = ROW_X0 + gw; R < MP; R += NGW) {
            float* ho = args.out + (size_t)(R - ROW_X0) * DM;
            f32x4 y[8], h[8], g[8]; load_row(Y + (size_t)R * DM, lane, y); load_row(ho, lane, h); load_row(args.in[I_MIXPOST], lane, g);
            const float rs = 1.0f / sqrtf(row_ssq(y) * (1.0f / DM) + EPS);
#pragma unroll
            for (int j = 0; j < 8; ++j) h[j] = h[j] + (y[j] * rs) * g[j];
            { GAS f32x4* o = (GAS f32x4*)ho + lane;
#pragma unroll
              for (int j = 0; j < 8; ++j) o[64 * j] = h[j]; }
            const float r2 = 1.0f / sqrtf(row_ssq(h) * (1.0f / DM) + EPS);
            store_row_bf16(XA + (size_t)R * DM, lane, h, r2);
        }
    }
#endif
    GRID_BAR();
#if PH_MASK & (1 << 11)
    { pg8::Gemm g{XA + (size_t)ROW_X0 * DM, WUP, SEQ, NUP, DM}; pg8::StaticOrder S; S.init(SEQ, NUP, G, bx); pg8::EpiSwiglu E{HID + (size_t)ROW_X0 * DFF, DFF};
      pg8::gemm_phase<pg8::EpiSwiglu, pg8::StaticOrder, true, true>(lds, g, S, E); }
#endif
    GRID_BAR();
#if PH_MASK & (1 << 12)
    { pg8::Gemm g{HID + (size_t)ROW_X0 * DFF, WDN, SEQ, DM, DFF}; pg8::StaticOrder S; S.init(SEQ, DM, G, bx); pg8::EpiF32 E{Y + (size_t)ROW_X0 * DM, DM};
      pg8::gemm_phase<pg8::EpiF32, pg8::StaticOrder, true, true>(lds, g, S, E); }
#endif
    GRID_BAR();
#if PH_MASK & (1 << 13)
    {
        for (int R = ROW_X0 + gw; R < MP; R += NGW) {
            float* ho = args.out + (size_t)(R - ROW_X0) * DM;
            f32x4 y[8], h[8], g[8]; load_row(Y + (size_t)R * DM, lane, y); load_row(ho, lane, h); load_row(args.in[I_F2POST], lane, g);
            const float rs = 0.5f / sqrtf(row_ssq(y) * (1.0f / DM) + EPS);
            GAS f32x4* o = (GAS f32x4*)ho + lane;
#pragma unroll
            for (int j = 0; j < 8; ++j) o[64 * j] = h[j] + (y[j] * rs) * g[j];
        }
    }
#endif
}

extern "C" void kernel_launch(void* const* d_in, const int* in_sizes, int n_in, void* d_out, int out_size, void* d_ws, size_t ws_size, hipStream_t stream) {
    static int grid = 0;
    if (grid == 0) {
        if (n_in != 27 || in_sizes[0] != SEQ * DM || out_size != SEQ * DM || ws_size < WS_END) { fprintf(stderr, "kernel_launch: unexpected shapes (n_in %d, in0 %d, out %d, ws %zu); nothing launched\n", n_in, n_in > 0 ? in_sizes[0] : -1, out_size, ws_size); grid = -1; return; }
        int dev = 0, cus = 0, per_cu = 0;
        if (hipGetDevice(&dev) != hipSuccess || hipDeviceGetAttribute(&cus, hipDeviceAttributeMultiprocessorCount, dev) != hipSuccess) { grid = -1; return; }
        if (hipFuncSetAttribute((const void*)mega_fwd, hipFuncAttributeMaxDynamicSharedMemorySize, LDS_BYTES) != hipSuccess) { fprintf(stderr, "kernel_launch: hipFuncSetAttribute failed\n"); grid = -1; return; }
        if (hipOccupancyMaxActiveBlocksPerMultiprocessor(&per_cu, (const void*)mega_fwd, NTHREADS, LDS_BYTES) != hipSuccess || per_cu < 1) { fprintf(stderr, "kernel_launch: occupancy query says %d blocks per CU\n", per_cu); (void)hipGetLastError(); grid = -1; return; }
        grid = cus;
    }
    if (grid < 0) return;
    if (hipMemsetAsync((char*)d_ws + WS_CTL, 0, CTL_ZERO_BYTES, stream) != hipSuccess) { fprintf(stderr, "kernel_launch: memset failed\n"); return; }
    Args a{};
    for (int i = 0; i < 27; ++i) a.in[i] = (const float*)d_in[i];
    a.out = (float*)d_out; a.ws = (unsigned char*)d_ws;
    hipLaunchKernelGGL(mega_fwd, dim3(grid), dim3(NTHREADS), LDS_BYTES, stream, a);
}
```

```cpp
#include <hip/hip_runtime.h>
#include <cstdio>
#include <cstdint>

constexpr int DM = 2048, SEQ = 8192, NMETA = 16, DFF = 5632, NUP = 2 * DFF, NIN = 10240, NIN_SRC = 10248;
constexpr int MP = 8448, ROW_X0 = 256, ROW_META0 = 240, ROW_PAD0 = 192, NCHUNK = 129;
constexpr float EPS = 1e-6f;
constexpr float QSCALE = 0.125f * 1.4426950408889634f;

constexpr size_t MiB = 1u << 20;
constexpr size_t WS_CTL = 0, CTL_ZERO_BYTES = 1 * MiB;
constexpr size_t WS_ROPE = 1 * MiB;
constexpr size_t WS_BIAS = 2 * MiB;
constexpr size_t WS_GW = 2 * MiB + 64 * 1024;
constexpr size_t WS_METAH = 2 * MiB + 256 * 1024;
constexpr size_t WS_DN = 1 * MiB + 520 * 1024;
constexpr size_t WS_NPREV = 2 * MiB + 384 * 1024;
constexpr size_t WS_MSC = 2 * MiB + 704 * 1024;
constexpr size_t WS_GATES = 3 * MiB;
constexpr size_t WS_WUP = 4 * MiB;
constexpr size_t WS_WDN = 48 * MiB;
constexpr size_t WS_WIN = 70 * MiB;
constexpr size_t WS_WMB = 110 * MiB;
constexpr size_t WS_WAB = 114 * MiB;
constexpr size_t WS_WOUT = 118 * MiB;
constexpr size_t WS_XA = 126 * MiB;
constexpr size_t WS_U = 159 * MiB;
constexpr size_t WS_HID = WS_U;
constexpr size_t WS_Y = WS_U + 91 * MiB;
constexpr size_t WS_Z = WS_U;
constexpr size_t ZPIECE = (size_t)MP * 1024;
constexpr size_t WS_YG = WS_U;
constexpr size_t WS_HMG = 324 * MiB;
constexpr size_t WS_HA = WS_HMG + (size_t)MP * 1024 * 2;
constexpr size_t WS_HM = 357 * MiB;
constexpr size_t WS_DCT = WS_WUP;
constexpr size_t WS_END = 390 * MiB;
static_assert(WS_WUP + (size_t)NUP * DM * 2 <= WS_WDN && WS_WDN + (size_t)DM * DFF * 2 <= WS_WIN && WS_WIN + (size_t)NIN * DM * 2 <= WS_WMB, "ws map 1");
static_assert(WS_XA + (size_t)MP * DM * 2 <= WS_U && WS_HID + (size_t)MP * DFF * 2 <= WS_Y && WS_Y + (size_t)MP * DM * 4 <= WS_HMG, "ws map 2");
static_assert(WS_Z + (6 * ZPIECE + 2 * (size_t)MP * 2048) * 2 <= WS_HMG && WS_HA + (size_t)MP * 1024 * 2 <= WS_HM && WS_HM + (size_t)MP * 1024 * 4 <= WS_END, "ws map 3");
static_assert(WS_YG + (size_t)MP * 2048 * 2 <= WS_Y, "YG must not overlap Y");
constexpr int CW_BAR = 4096;

namespace pg8 {
#define PG8_LAS __attribute__((address_space(3)))
typedef unsigned short bf16_t;
typedef short bf16x8 __attribute__((ext_vector_type(8)));
typedef float f32x4 __attribute__((ext_vector_type(4)));
typedef unsigned u32x4 __attribute__((ext_vector_type(4)));
constexpr int BM = 256, BK = 64, HALF = 128, HTB = HALF * BK * 2  , STAGE_BYTES = 8 * HTB, NXCD = 8, WGM = 8;

__host__ __device__ __forceinline__ int lds_byte(int r, int c) { const int st = (r >> 4) * 2 + (c >> 5), rr = r & 15, cc = c & 31, ob = rr * 64 + cc * 2; return st * 1024 + (ob ^ (((ob >> 9) & 1) << 5)); }
__host__ __device__ __forceinline__ void stage_rc(int b, int& R, int& C) { const int st = b / 1024, sb = b % 1024, swz = sb ^ (((sb >> 9) & 1) << 5); R = (st >> 1) * 16 + swz / 64; C = (st & 1) * 32 + (swz % 64) / 2; }
__host__ __device__ __forceinline__ int perm32(int rho) { const int n = rho >> 4, i = rho & 15; return 8 * (i >> 2) + 4 * n + (i & 3); }

struct Unit { int pm, pn; };
struct Gemm { const bf16_t* A; const bf16_t* Bt; int M, N, K; };

struct StaticOrder {
    int nM, nN, nwg, G, c;
    __host__ __device__ void init(int M, int N, int G_, int c_) { nM = M / BM; nN = N / BM; nwg = nM * nN; G = G_; c = c_; }
    __host__ __device__ bool next(int i, Unit& u) const {
        const long L = (long)i * G + c; if (L >= nwg) return false;
        int wgid = (int)L; { const int q = nwg / NXCD, r = nwg % NXCD, xcd = wgid % NXCD, off = wgid / NXCD; wgid = (xcd < r ? xcd * (q + 1) : r * (q + 1) + (xcd - r) * q) + off; }
        const int nig = WGM * nN, gid = wgid / nig, fm = gid * WGM, gsz = (nM - fm) < WGM ? (nM - fm) : WGM;
        u.pm = fm + ((wgid % nig) % gsz); u.pn = (wgid % nig) / gsz; return true;
    }
    __device__ __forceinline__ void a_ready(const Unit&) const {}
    __device__ __forceinline__ void done(const Unit&) const {}
};

__device__ __forceinline__ unsigned cvt_pk_bf16(float lo, float hi) { unsigned r; asm volatile("v_cvt_pk_bf16_f32 %0, %1, %2" : "=v"(r) : "v"(lo), "v"(hi)); return r; }
typedef float f32x2 __attribute__((ext_vector_type(2)));
__device__ __forceinline__ float sigm(float x) { return __builtin_amdgcn_rcpf(1.0f + __expf(-x)); }
__device__ __forceinline__ float bflo(unsigned w) { return __uint_as_float(w << 16); }
__device__ __forceinline__ float bfhi(unsigned w) { return __uint_as_float(w & 0xffff0000u); }

struct EpiF32 {
    static constexpr bool PERM = false, AFTER_DRAIN = false;
    float* C; int ldc;
    __device__ __forceinline__ void operator()(const f32x4 (&acc)[2][2][4][2], const Unit& u, int wr, int wc, int fr, int fq) const {
        const int row0 = u.pm * BM + wr * 64 + fr, col0 = u.pn * BM + wc * 32 + 4 * fq;
#pragma unroll
        for (int ai = 0; ai < 2; ++ai)
#pragma unroll
            for (int m = 0; m < 4; ++m) { float* rowp = C + (size_t)(row0 + ai * HALF + m * 16) * ldc + col0;
#pragma unroll
                for (int bj = 0; bj < 2; ++bj)
#pragma unroll
                    for (int n = 0; n < 2; ++n) *(f32x4*)(rowp + bj * HALF + n * 16) = acc[ai][bj][m][n]; }
    }
};

struct EpiSwiglu {
    static constexpr bool PERM = true, AFTER_DRAIN = false;
    bf16_t* O; int ldc;
    __device__ __forceinline__ void operator()(const f32x4 (&acc)[2][2][4][2], const Unit& u, int wr, int wc, int fr, int fq) const {
        const int row0 = u.pm * BM + wr * 64 + fr, col0 = u.pn * HALF + wc * 32 + 8 * fq;
#pragma unroll
        for (int ai = 0; ai < 2; ++ai)
#pragma unroll
            for (int m = 0; m < 4; ++m) { bf16_t* rowp = O + (size_t)(row0 + ai * HALF + m * 16) * ldc + col0;
                const f32x4 g0 = acc[ai][0][m][0], g1 = acc[ai][0][m][1], u0 = acc[ai][1][m][0], u1 = acc[ai][1][m][1];
                float r[8];
#pragma unroll
                for (int i = 0; i < 4; ++i) { r[i] = g0[i] * sigm(g0[i]) * u0[i]; r[4 + i] = g1[i] * sigm(g1[i]) * u1[i]; }
                u32x4 w; w.x = cvt_pk_bf16(r[0], r[1]); w.y = cvt_pk_bf16(r[2], r[3]); w.z = cvt_pk_bf16(r[4], r[5]); w.w = cvt_pk_bf16(r[6], r[7]);
                *(u32x4*)rowp = w; }
    }
};

struct EpiZ {
    static constexpr bool PERM = true, AFTER_DRAIN = false;
    bf16_t* Z; const float* bias; const float* rope;
    __device__ __forceinline__ void operator()(const f32x4 (&acc)[2][2][4][2], const Unit& u, int wr, int wc, int fr, int fq) const {
        const int pn = u.pn, row0 = u.pm * BM + wr * 64 + fr;
        bf16_t* base; int ldc, colt;
        if (pn < 24) { base = Z + (size_t)(pn >> 2) * ZPIECE; ldc = 1024; colt = (pn & 3) * 256; }
        else { const int q = pn - 24; base = Z + 6 * ZPIECE + (size_t)(q >> 3) * ((size_t)MP * 2048); ldc = 2048; colt = (q & 7) * 256; }
        const int mode = ((pn >= 8 && pn < 12) || pn >= 24) ? 1 : ((pn >= 12 && pn < 20) ? 2 : 0);
        const float qs = (pn >= 12 && pn < 16) ? QSCALE : 1.0f;
        const int col0 = colt + wc * 32 + 8 * fq, bcol0 = pn * BM + wc * 32 + 8 * fq;
        f32x4 bv[2][2];
#pragma unroll
        for (int bj = 0; bj < 2; ++bj)
#pragma unroll
            for (int n = 0; n < 2; ++n) bv[bj][n] = *(const f32x4*)(bias + bcol0 + bj * HALF + 4 * n);
        const bool rot = ((wc & 1) == 0) && (fq < 2);
        const float sgn = (fq == 0) ? -1.0f : 1.0f;
#pragma unroll
        for (int ai = 0; ai < 2; ++ai)
#pragma unroll
            for (int m = 0; m < 4; ++m) { const int row = row0 + ai * HALF + m * 16; bf16_t* rowp = base + (size_t)row * ldc + col0;
#pragma unroll
                for (int bj = 0; bj < 2; ++bj) { f32x4 v0 = acc[ai][bj][m][0] + bv[bj][0], v1 = acc[ai][bj][m][1] + bv[bj][1];
                    if (mode == 1) {
#pragma unroll
                        for (int i = 0; i < 4; ++i) { v0[i] = sigm(v0[i]); v1[i] = sigm(v1[i]); }
                    } else if (mode == 2) {
                        f32x4 p0, p1;
#pragma unroll
                        for (int i = 0; i < 4; ++i) { p0[i] = __shfl_xor(v0[i], 16); p1[i] = __shfl_xor(v1[i], 16); }
                        if (rot) { int pos = row - ROW_META0; pos = pos < 0 ? 0 : pos; const float* rp = rope + (size_t)pos * 16;
                            const f32x4 c0 = *(const f32x4*)(rp), c1 = *(const f32x4*)(rp + 4), s0 = *(const f32x4*)(rp + 8), s1 = *(const f32x4*)(rp + 12);
#pragma unroll
                            for (int i = 0; i < 4; ++i) { v0[i] = v0[i] * c0[i] + sgn * p0[i] * s0[i]; v1[i] = v1[i] * c1[i] + sgn * p1[i] * s1[i]; } }
                        v0 = v0 * qs; v1 = v1 * qs;
                    }
                    u32x4 w; w.x = cvt_pk_bf16(v0[0], v0[1]); w.y = cvt_pk_bf16(v0[2], v0[3]); w.z = cvt_pk_bf16(v1[0], v1[1]); w.w = cvt_pk_bf16(v1[2], v1[3]);
                    *(u32x4*)(rowp + bj * HALF) = w; } }
    }
};

struct EpiGate {
    static constexpr bool PERM = true, AFTER_DRAIN = false;
    const bf16_t* G; bf16_t* O; int ldc; int accum;
    __device__ __forceinline__ void operator()(const f32x4 (&acc)[2][2][4][2], const Unit& u, int wr, int wc, int fr, int fq) const {
        const int row0 = u.pm * BM + wr * 64 + fr, col0 = u.pn * BM + wc * 32 + 8 * fq;
#pragma unroll
        for (int ai = 0; ai < 2; ++ai)
#pragma unroll
            for (int m = 0; m < 4; ++m) { const size_t off = (size_t)(row0 + ai * HALF + m * 16) * ldc + col0;
#pragma unroll
                for (int bj = 0; bj < 2; ++bj) { const u32x4 gw = *(const u32x4*)(G + off + bj * HALF);
                    f32x4 v0 = acc[ai][bj][m][0], v1 = acc[ai][bj][m][1];
                    v0[0] *= bflo(gw.x); v0[1] *= bfhi(gw.x); v0[2] *= bflo(gw.y); v0[3] *= bfhi(gw.y);
                    v1[0] *= bflo(gw.z); v1[1] *= bfhi(gw.z); v1[2] *= bflo(gw.w); v1[3] *= bfhi(gw.w);
                    if (accum) { const u32x4 ow = *(const u32x4*)(O + off + bj * HALF);
                        v0[0] += bflo(ow.x); v0[1] += bfhi(ow.x); v0[2] += bflo(ow.y); v0[3] += bfhi(ow.y);
                        v1[0] += bflo(ow.z); v1[1] += bfhi(ow.z); v1[2] += bflo(ow.w); v1[3] += bfhi(ow.w); }
                    u32x4 w; w.x = cvt_pk_bf16(v0[0], v0[1]); w.y = cvt_pk_bf16(v0[2], v0[3]); w.z = cvt_pk_bf16(v1[0], v1[1]); w.w = cvt_pk_bf16(v1[2], v1[3]);
                    *(u32x4*)(O + off + bj * HALF) = w; } }
    }
};

template <class Epi, class Sched, bool ALIGN_EPI = false, bool SP2 = false>
__device__ __forceinline__ void gemm_phase(PG8_LAS unsigned char* lds, const Gemm g, const Sched& S, const Epi& E) {
    int tid_ = threadIdx.x; asm volatile("" : "+v"(tid_));
    const int tid = tid_, wid = __builtin_amdgcn_readfirstlane(tid >> 6), lane = tid & 63, wr = wid >> 2, wc = wid & 3, fr = lane & 15, fq = lane >> 4;
    const int K = g.K, nt = K / BK;
    unsigned voffA[2], voffB[2];
#pragma unroll
    for (int i = 0; i < 2; ++i) { int R, C; stage_rc(tid * 16 + i * 8192, R, C); const int Rb = Epi::PERM ? ((R & ~31) + perm32(R & 31)) : R;
        voffA[i] = (unsigned)(R * K + C) * 2u; voffB[i] = (unsigned)(Rb * K + C) * 2u; }
    const size_t kstep = (size_t)(BK * 2);
    const size_t hstep = (size_t)HALF * K * 2;
    const size_t tstep = 2 * hstep;
    const unsigned ldsw = (unsigned)wid * 1024u;
    const int aoff = lds_byte(wr * 64 + fr, fq * 8), boff = lds_byte(wc * 32 + fr, fq * 8);
#define PG8_SA(b, h) (((b) * 2 + (h)) * HTB)
#define PG8_SB(b, h) ((4 + (b) * 2 + (h)) * HTB)
#define PG8_STAGE(bufoff, gbase, voff) do { _Pragma("unroll") for (int _i = 0; _i < 2; ++_i) \
        __builtin_amdgcn_global_load_lds((const unsigned*)((const char*)(gbase) + (voff)[_i]), (PG8_LAS unsigned*)(lds + (bufoff) + ldsw + _i * 8192), 16, 0, 0); } while (0)
#define PG8_LDA(dst, b, h) do { _Pragma("unroll") for (int m = 0; m < 4; ++m) _Pragma("unroll") for (int k = 0; k < 2; ++k) dst[m][k] = *(const PG8_LAS bf16x8*)(lds + PG8_SA(b, h) + aoff + m * 2048 + k * 1024); } while (0)
#define PG8_LDB(dst, b, h) do { _Pragma("unroll") for (int n = 0; n < 2; ++n) _Pragma("unroll") for (int k = 0; k < 2; ++k) dst[n][k] = *(const PG8_LAS bf16x8*)(lds + PG8_SB(b, h) + boff + n * 2048 + k * 1024); } while (0)
#define PG8_MMA(ai, bj, At, Bt) do { __builtin_amdgcn_s_setprio(1); _Pragma("unroll") for (int m = 0; m < 4; ++m) _Pragma("unroll") for (int n = 0; n < 2; ++n) _Pragma("unroll") for (int k = 0; k < 2; ++k) \
        acc[ai][bj][m][n] = __builtin_amdgcn_mfma_f32_16x16x32_bf16(Bt[n][k], At[m][k], acc[ai][bj][m][n], 0, 0, 0); __builtin_amdgcn_s_setprio(0); } while (0)
#define PG8_WAIT_V(n) asm volatile("s_waitcnt vmcnt(" #n ")" ::: "memory")
#define PG8_WAIT_L(n) asm volatile("s_waitcnt lgkmcnt(" #n ")" ::: "memory")
#define PG8_BAR __builtin_amdgcn_s_barrier()
#define PG8_SCHED __builtin_amdgcn_sched_barrier(0)
    Unit cur, nxt; int ui = 0;
    if (!S.next(0, cur)) return;
    f32x4 acc[2][2][4][2];
#pragma unroll
    for (int a = 0; a < 2; ++a)
#pragma unroll
        for (int b = 0; b < 2; ++b)
#pragma unroll
            for (int m = 0; m < 4; ++m)
#pragma unroll
                for (int n = 0; n < 2; ++n) acc[a][b][m][n] = (f32x4){0.f, 0.f, 0.f, 0.f};
    bf16x8 At[4][2], B0[2][2], B1[2][2];
    const char* cA = (const char*)g.A + (size_t)cur.pm * tstep; const char* cB = (const char*)g.Bt + (size_t)cur.pn * tstep;
    S.a_ready(cur);
    if constexpr (SP2) {
        PG8_STAGE(PG8_SB(0, 0), cB, voffB); PG8_STAGE(PG8_SB(0, 1), cB + hstep, voffB); PG8_STAGE(PG8_SA(0, 0), cA, voffA); PG8_STAGE(PG8_SA(0, 1), cA + hstep, voffA);
        if (wr == 1) PG8_BAR;
        PG8_WAIT_V(2); PG8_BAR;
        PG8_STAGE(PG8_SB(1, 0), cB + kstep, voffB); PG8_STAGE(PG8_SA(1, 0), cA + kstep, voffA); PG8_STAGE(PG8_SB(1, 1), cB + hstep + kstep, voffB);
        PG8_WAIT_V(6); PG8_BAR;
    } else {
        PG8_STAGE(PG8_SB(0, 0), cB, voffB); PG8_STAGE(PG8_SA(0, 0), cA, voffA); PG8_STAGE(PG8_SB(0, 1), cB + hstep, voffB); PG8_STAGE(PG8_SA(0, 1), cA + hstep, voffA);
        if (wr == 1) PG8_BAR;
        PG8_WAIT_V(4); PG8_BAR;
        PG8_STAGE(PG8_SB(1, 0), cB + kstep, voffB); PG8_STAGE(PG8_SA(1, 0), cA + kstep, voffA); PG8_STAGE(PG8_SB(1, 1), cB + hstep + kstep, voffB);
        PG8_WAIT_V(6); PG8_BAR;
    }
    for (;;) {
        const bool has_next = S.next(ui + 1, nxt);
        const char* nA = has_next ? (const char*)g.A + (size_t)nxt.pm * tstep : cA; const char* nB = has_next ? (const char*)g.Bt + (size_t)nxt.pn * tstep : cB;
        for (int t = 0; t < nt; t += 2) {
            const bool last = (t == nt - 2);
            const char* a1 = cA + (size_t)(t + 1) * kstep;
            const char* a2 = last ? nA : cA + (size_t)(t + 2) * kstep; const char* b2 = last ? nB : cB + (size_t)(t + 2) * kstep;
            const char* a3 = a2 + kstep; const char* b3 = b2 + kstep;
            if (last && has_next) S.a_ready(nxt);
            if constexpr (SP2) {
            PG8_LDB(B0, 0, 0); PG8_LDB(B1, 0, 1); PG8_SCHED; PG8_LDA(At, 0, 0); PG8_STAGE(PG8_SA(1, 1), a1 + hstep, voffA);
            PG8_WAIT_V(8); PG8_WAIT_L(0); PG8_BAR; PG8_MMA(0, 0, At, B0); PG8_MMA(0, 1, At, B1); PG8_BAR; PG8_SCHED;
            PG8_LDA(At, 0, 1); PG8_STAGE(PG8_SB(0, 0), b2, voffB); PG8_STAGE(PG8_SB(0, 1), b2 + hstep, voffB); PG8_STAGE(PG8_SA(0, 0), a2, voffA);
            PG8_WAIT_V(8); PG8_WAIT_L(0); PG8_BAR; PG8_MMA(1, 0, At, B0); PG8_MMA(1, 1, At, B1); PG8_BAR; PG8_SCHED;
            PG8_LDB(B0, 1, 0); PG8_LDB(B1, 1, 1); PG8_SCHED; PG8_LDA(At, 1, 0); PG8_STAGE(PG8_SA(0, 1), a2 + hstep, voffA);
            PG8_WAIT_V(8); PG8_WAIT_L(0); PG8_BAR; PG8_MMA(0, 0, At, B0); PG8_MMA(0, 1, At, B1); PG8_BAR; PG8_SCHED;
            PG8_LDA(At, 1, 1); PG8_STAGE(PG8_SB(1, 0), b3, voffB); PG8_STAGE(PG8_SB(1, 1), b3 + hstep, voffB); PG8_STAGE(PG8_SA(1, 0), a3, voffA);
            PG8_WAIT_V(8); PG8_WAIT_L(0); PG8_BAR; PG8_MMA(1, 0, At, B0); PG8_MMA(1, 1, At, B1); PG8_BAR; PG8_SCHED;
            } else {
            PG8_LDB(B0, 0, 0); PG8_SCHED; PG8_LDA(At, 0, 0); PG8_STAGE(PG8_SA(1, 1), a1 + hstep, voffA);
            PG8_WAIT_L(8); PG8_BAR; PG8_WAIT_L(0); PG8_MMA(0, 0, At, B0); PG8_BAR; PG8_SCHED;
            PG8_LDB(B1, 0, 1); PG8_STAGE(PG8_SB(0, 0), b2, voffB);
            PG8_BAR; PG8_WAIT_L(0); PG8_MMA(0, 1, At, B1); PG8_BAR;
            PG8_LDA(At, 0, 1); PG8_STAGE(PG8_SA(0, 0), a2, voffA);
            PG8_BAR; PG8_WAIT_L(0); PG8_MMA(1, 0, At, B0); PG8_BAR; PG8_SCHED;
            PG8_STAGE(PG8_SB(0, 1), b2 + hstep, voffB);
            PG8_WAIT_V(6); PG8_BAR; PG8_MMA(1, 1, At, B1); PG8_BAR;
            PG8_LDB(B0, 1, 0); PG8_SCHED; PG8_LDA(At, 1, 0); PG8_STAGE(PG8_SA(0, 1), a2 + hstep, voffA);
            PG8_WAIT_L(8); PG8_BAR; PG8_WAIT_L(0); PG8_MMA(0, 0, At, B0); PG8_BAR; PG8_SCHED;
            PG8_LDB(B1, 1, 1); PG8_STAGE(PG8_SB(1, 0), b3, voffB);
            PG8_BAR; PG8_WAIT_L(0); PG8_MMA(0, 1, At, B1); PG8_BAR;
            PG8_LDA(At, 1, 1); PG8_STAGE(PG8_SA(1, 0), a3, voffA);
            PG8_BAR; PG8_WAIT_L(0); PG8_MMA(1, 0, At, B0); PG8_BAR; PG8_SCHED;
            PG8_STAGE(PG8_SB(1, 1), b3 + hstep, voffB);
            PG8_WAIT_V(6); PG8_BAR; PG8_MMA(1, 1, At, B1); PG8_BAR;
            }
        }
        if constexpr (ALIGN_EPI) { if (wr == 0) PG8_BAR; }
        if constexpr (!Epi::AFTER_DRAIN) { E(acc, cur, wr, wc, fr, fq); S.done(cur); }
        if (!has_next) break;
#pragma unroll
        for (int a = 0; a < 2; ++a)
#pragma unroll
            for (int b = 0; b < 2; ++b)
#pragma unroll
                for (int m = 0; m < 4; ++m)
#pragma unroll
                    for (int n = 0; n < 2; ++n) acc[a][b][m][n] = (f32x4){0.f, 0.f, 0.f, 0.f};
        cur = nxt; cA = nA; cB = nB; ++ui;
        if constexpr (ALIGN_EPI) { if (wr == 1) PG8_BAR; }
    }
    PG8_WAIT_V(0);
    if constexpr (!ALIGN_EPI) { if (wr == 0) PG8_BAR; }
    PG8_BAR;
    if constexpr (Epi::AFTER_DRAIN) { E.fused(acc, cur, wr, wc, fr, fq, lds, wid, lane); S.done(cur); }
#undef PG8_SA
#undef PG8_SB
#undef PG8_STAGE
#undef PG8_LDA
#undef PG8_LDB
#undef PG8_MMA
#undef PG8_WAIT_V
#undef PG8_WAIT_L
#undef PG8_BAR
#undef PG8_SCHED
}
}
#define GAS __attribute__((address_space(1)))
#define LAS __attribute__((address_space(3)))
typedef unsigned short bf16;
typedef unsigned v4u __attribute__((ext_vector_type(4)));
typedef float f32x4 __attribute__((ext_vector_type(4)));
typedef short bf16x8 __attribute__((ext_vector_type(8)));
typedef GAS unsigned gu32;
typedef GAS unsigned long long gu64;
#define RLX_AGENT __ATOMIC_RELAXED, __HIP_MEMORY_SCOPE_AGENT
#define LDS_WAIT() asm volatile("s_waitcnt lgkmcnt(0)" ::: "memory")
#define VM_WAIT() asm volatile("s_waitcnt vmcnt(0)" ::: "memory")
__device__ __forceinline__ unsigned long long rt() { return __builtin_amdgcn_s_memrealtime(); }
__device__ __forceinline__ unsigned f2bf(float f) { unsigned u = __builtin_bit_cast(unsigned, f); return (u + 0x7fffu + ((u >> 16) & 1u)) >> 16; }
__device__ __forceinline__ unsigned pk2(float lo, float hi) { return f2bf(lo) | (f2bf(hi) << 16); }

#define XB_TMO      128
#define XB_XCNT(j)  (256  + 64 * (j))
#define XB_XSUB(j)  (1280 + 64 * (j))
#define XB_XGEN(j)  (2304 + 64 * (j))
#define XB_TOP      3328
#define XB_TOPGEN   3392
#define XCD_BAR_WORDS 3456
#define XB_SPIN_CAP (1u << 18)

__device__ __forceinline__ unsigned xb_ld(unsigned* p)              { return __hip_atomic_load(p, __ATOMIC_RELAXED, __HIP_MEMORY_SCOPE_AGENT); }
__device__ __forceinline__ unsigned xb_add(unsigned* p, unsigned v) { return __hip_atomic_fetch_add(p, v, __ATOMIC_RELAXED, __HIP_MEMORY_SCOPE_AGENT); }
__device__ __forceinline__ unsigned xb_xcc_id() { return (unsigned)__builtin_amdgcn_s_getreg((3 << 11) | 20) & 0xFu; }
#define XB_SPIN(cond, bar) do { unsigned _sp = 0; while (cond) { __builtin_amdgcn_s_sleep(1); \
    if ((++_sp & 255u) == 0u) { if (xb_ld(&(bar)[XB_TMO])) break; if (_sp > XB_SPIN_CAP) { atomicAdd(&(bar)[XB_TMO], 1u); break; } } } } while (0)

struct XcdBarrier {
    unsigned* bar; unsigned x;
    volatile LAS unsigned* st;
};

__device__ __forceinline__ XcdBarrier xcd_barrier_post(unsigned* bar, volatile LAS unsigned* st) {
    XcdBarrier b; b.bar = bar; b.x = xb_xcc_id(); b.st = st;
    if (threadIdx.x == 0) (void)xb_add(&bar[XB_XCNT(b.x)], 1u);
    return b;
}
__device__ __forceinline__ void xcd_barrier_complete(unsigned* bar, unsigned x, unsigned& nloc, unsigned& nx) {
    const unsigned G = gridDim.x * gridDim.y * gridDim.z;
    unsigned sum, cnt, mine, sp = 0u;
    for (;;) {
        sum = 0u; cnt = 0u; mine = 0u;
#pragma unroll
        for (unsigned j = 0; j < 16; ++j) { const unsigned c = xb_ld(&bar[XB_XCNT(j)]); sum += c; cnt += (c > 0u) ? 1u : 0u; mine = (j == x) ? c : mine; }
        if (sum == G) break;
        __builtin_amdgcn_s_sleep(1);
        if ((++sp & 255u) == 0u) { if (xb_ld(&bar[XB_TMO])) break; if (sp > XB_SPIN_CAP) { atomicAdd(&bar[XB_TMO], 1u); break; } }
    }
    nloc = mine > 0u ? mine : 1u; nx = cnt > 0u ? cnt : 1u;
}

__device__ __forceinline__ void xcd_barrier(const XcdBarrier& b) {
    asm volatile("s_waitcnt vmcnt(0)" ::: "memory");
    __syncthreads();
    if (threadIdx.x == 0) {
        unsigned* bar = b.bar;
        __builtin_amdgcn_s_waitcnt(0);
        unsigned nloc = b.st[0], nx = b.st[1];
        if (nloc == 0u) { xcd_barrier_complete(bar, b.x, nloc, nx); b.st[0] = nloc; b.st[1] = nx; }
        const unsigned old = xb_add(&bar[XB_XSUB(b.x)], 1u);
        const unsigned gen = old / nloc;
        if (old + 1u == (gen + 1u) * nloc) {
            __builtin_amdgcn_fence(__ATOMIC_RELEASE, "agent");
            asm volatile("s_waitcnt vmcnt(0)" ::: "memory");
            const unsigned og = xb_add(&bar[XB_TOP], 1u);
            const unsigned tg = og / nx;
            if (og + 1u == (tg + 1u) * nx) xb_add(&bar[XB_TOPGEN], 1u);
            else XB_SPIN(xb_ld(&bar[XB_TOPGEN]) == tg, bar);
            __builtin_amdgcn_fence(__ATOMIC_ACQUIRE, "agent");
            xb_add(&bar[XB_XGEN(b.x)], 1u);
            asm volatile("s_waitcnt vmcnt(0)" ::: "memory");
        } else {
            XB_SPIN(xb_ld(&bar[XB_XGEN(b.x)]) == gen, bar);
            __builtin_amdgcn_fence(__ATOMIC_ACQUIRE, "agent");
            asm volatile("s_waitcnt vmcnt(0)" ::: "memory");
        }
    }
    __syncthreads();
}
constexpr int NWAVES = 8, NTHREADS = 512;
constexpr int RING_BYTES = 131072, LDSCTL_OFF = RING_BYTES, MISC_OFF = LDSCTL_OFF + 320, LDS_BYTES = 147456;
typedef unsigned v2u __attribute__((ext_vector_type(2)));

#ifndef PH_MASK
#define PH_MASK 0xffff
#endif
struct Args { const float* in[27]; float* out; unsigned char* ws; };
enum { I_X = 0, I_META, I_F1PRE, I_F1POST, I_F1G, I_F1U, I_F1D, I_MIXPRE, I_MIXPOST, I_WIN, I_BIN, I_CONVW, I_CONVB, I_MNORM, I_MWB, I_LQ1, I_LK1, I_LQ2, I_LK2, I_ANORM, I_AWB, I_WOUT, I_F2PRE, I_F2POST, I_F2G, I_F2U, I_F2D };

__device__ __forceinline__ float wave_sum(float v) {
#pragma unroll
    for (int o = 1; o < 64; o <<= 1) v += __shfl_xor(v, o);
    return v;
}
__device__ __forceinline__ float bf2f(bf16 b) { return __uint_as_float(((unsigned)b) << 16); }

__device__ __forceinline__ void tr_item(const float* W, int ldw, int src_col0, int k0, bf16* WT, int K, int dst_row0, const float* sk, float scal, LAS float* scr, int lane) {
#pragma unroll 8
    for (int i = 0; i < 32; ++i) { const int kk = 2 * i + (lane >> 5);
        const float w = W[(size_t)(k0 + kk) * ldw + src_col0 + (lane & 31)];
        const float s = sk ? sk[k0 + kk] * scal : scal;
        scr[kk * 33 + (lane & 31)] = w * s; }
    LDS_WAIT(); asm volatile("" ::: "memory");
    const int c = lane & 7;
#pragma unroll
    for (int j = 0; j < 4; ++j) { const int n = (lane >> 3) + 8 * j; const LAS float* s = scr + (8 * c) * 33 + n;
        v4u o; o.x = pk2(s[0 * 33], s[1 * 33]); o.y = pk2(s[2 * 33], s[3 * 33]); o.z = pk2(s[4 * 33], s[5 * 33]); o.w = pk2(s[6 * 33], s[7 * 33]);
        *(GAS v4u*)(WT + (size_t)(dst_row0 + n) * K + k0 + 8 * c) = o; }
    LDS_WAIT(); asm volatile("" ::: "memory");
}

__device__ __forceinline__ void convert_ffn(const float* wg, const float* wu, const float* wd, const float* preg, bf16* WUP, bf16* WDN, LAS float* scr, int gw, int NGW, int lane) {
    constexpr int N_UP = (DM / 64) * (NUP / 32), N_DN = (DFF / 64) * (DM / 32);
    for (int it = gw; it < N_UP + N_DN; it += NGW) {
        if (it < N_UP) { const int nblk = NUP / 32, kb = it / nblk, nb = it % nblk, row0 = 32 * nb, pn = row0 >> 8, j = row0 & 255;
            const float* src = (j < 128) ? wg : wu; const int col0 = 128 * pn + (j & 127);
            tr_item(src, DFF, col0, 64 * kb, WUP, DM, row0, preg, 1.0f, scr, lane); }
        else { const int r = it - N_UP, nblk = DM / 32, kb = r / nblk, nb = r % nblk;
            tr_item(wd, DM, 32 * nb, 64 * kb, WDN, DFF, 32 * nb, nullptr, 1.0f, scr, lane); }
    }
}

__device__ __forceinline__ void sincos_small(double r, double& s, double& c) {
    const double r2 = r * r; double ts = 1.0, tc = 1.0;
#pragma unroll
    for (int k = 13; k >= 1; --k) { ts = 1.0 - ts * r2 / (double)((2 * k) * (2 * k + 1)); tc = 1.0 - tc * r2 / (double)((2 * k - 1) * (2 * k)); }
    s = r * ts; c = tc;
}

__device__ __forceinline__ void load_row(const float* p, int lane, f32x4 (&v)[8]) {
    const GAS f32x4* r = (const GAS f32x4*)p + lane;
#pragma unroll
    for (int j = 0; j < 8; ++j) v[j] = r[64 * j];
}
__device__ __forceinline__ float row_ssq(const f32x4 (&v)[8]) {
    float s = 0.f;
#pragma unroll
    for (int j = 0; j < 8; ++j) s += (v[j].x * v[j].x + v[j].y * v[j].y) + (v[j].z * v[j].z + v[j].w * v[j].w);
    return wave_sum(s);
}
__device__ __forceinline__ void store_row_bf16(bf16* p, int lane, const f32x4 (&v)[8], float sc) {
    GAS v2u* o = (GAS v2u*)p + lane;
#pragma unroll
    for (int j = 0; j < 8; ++j) { v2u w; w.x = pk2(v[j].x * sc, v[j].y * sc); w.y = pk2(v[j].z * sc, v[j].w * sc); o[64 * j] = w; }
}

__device__ __forceinline__ float log_sigmoid(float x) { return fminf(x, 0.f) - log1pf(__expf(-fabsf(x))); }

namespace fa {
typedef float f32x16 __attribute__((ext_vector_type(16)));
typedef short s16x4 __attribute__((ext_vector_type(4)));
typedef short v4i16_t __attribute__((ext_vector_type(4)));
constexpr int KSLOT = 8192, VSLOT = 16384;
constexpr int L_K = 0, L_V = 2 * KSLOT, L_WS = L_V + 2 * VSLOT, L_END = L_WS + 8 * 256;
__device__ __forceinline__ int crow(int r, int hi) { return (r & 3) + 8 * (r >> 2) + 4 * hi; }
__device__ __forceinline__ s16x4 vtr(const LAS unsigned char* p) { return __builtin_bit_cast(s16x4, __builtin_amdgcn_ds_read_tr16_b64_v4i16((LAS v4i16_t*)p)); }
__device__ __forceinline__ unsigned cvtpk(float lo, float hi) { return pg8::cvt_pk_bf16(lo, hi); }

__device__ __forceinline__ void attn_unit(LAS unsigned char* lds, int sh, int qb, const bf16* AQ, const bf16* AK, const bf16* AV, bf16* OS) {
    int tid_ = threadIdx.x; asm volatile("" : "+v"(tid_));
    const int tid = tid_, lane = tid & 63, r32 = lane & 31, hi = lane >> 5, wid = __builtin_amdgcn_readfirstlane(tid >> 6);
    const int hh = sh >> 1, NT = 4 * qb + 5, cq = 4 * qb + 1 + (wid >> 1);
    const int qrow0 = ROW_X0 + 256 * qb + 32 * wid;
    bf16x8 qr[4];
    { const bf16* Qw = AQ + (size_t)(qrow0 + r32) * 1024 + sh * 64 + hi * 8;
#pragma unroll
      for (int d0 = 0; d0 < 4; ++d0) qr[d0] = *(const bf16x8*)(Qw + d0 * 16); }
    const bf16* ksrc = AK + (size_t)(ROW_PAD0 + lane) * 1024 + sh * 64 + wid * 8;
    const bf16* vsrc = AV + (size_t)(ROW_PAD0 + 32 * (wid & 1) + (lane >> 2)) * 1024 + hh * 128 + (wid >> 1) * 32 + (lane & 3) * 8;
    LAS float* wsf = (LAS float*)(lds + L_WS) + wid * 64;
    const LAS unsigned char* kbase = lds + L_K + hi * 1024 + r32 * 16;
    const LAS unsigned char* vbase = lds + L_V + ((lane >> 4) & 1) * 32 + (lane & 3) * 8 + (4 * hi + ((lane & 15) >> 2)) * 64;
#define FA_DMA(t, buf) do { const size_t go_ = (size_t)(t) * 65536; \
        __builtin_amdgcn_global_load_lds((const unsigned*)(ksrc + go_), (LAS unsigned*)(lds + L_K + (buf) * KSLOT + wid * 1024), 16, 0, 0); \
        __builtin_amdgcn_global_load_lds((const unsigned*)(vsrc + go_), (LAS unsigned*)(lds + L_V + (buf) * VSLOT + wid * 2048), 16, 0, 0); \
        __builtin_amdgcn_global_load_lds((const unsigned*)(vsrc + go_ + 16 * 1024), (LAS unsigned*)(lds + L_V + (buf) * VSLOT + wid * 2048 + 1024), 16, 0, 0); } while (0)
    f32x16 o[4];
#pragma unroll
    for (int d0 = 0; d0 < 4; ++d0)
#pragma unroll
        for (int r = 0; r < 16; ++r) o[d0][r] = 0.f;
    float m = -1e30f, l = 0.f;
    FA_DMA(0, 0);
    asm volatile("s_waitcnt vmcnt(0) lgkmcnt(0)\n\ts_barrier" ::: "memory");
    for (int t = 0; t < NT; ++t) {
        const int buf = t & 1;
        if (t + 1 < NT) FA_DMA(t + 1, buf ^ 1);
        if (t <= cq) {
            const LAS unsigned char* kp = kbase + buf * KSLOT;
            f32x16 p0, p1;
#pragma unroll
            for (int r = 0; r < 16; ++r) { p0[r] = 0.f; p1[r] = 0.f; }
#pragma unroll
            for (int d0 = 0; d0 < 4; ++d0) {
                const bf16x8 k0 = *(const LAS bf16x8*)(kp + d0 * 2048), k1 = *(const LAS bf16x8*)(kp + d0 * 2048 + 512);
                p0 = __builtin_amdgcn_mfma_f32_32x32x16_bf16(k0, qr[d0], p0, 0, 0, 0);
                p1 = __builtin_amdgcn_mfma_f32_32x32x16_bf16(k1, qr[d0], p1, 0, 0, 0); }
            if (t == 0) {
#pragma unroll
                for (int r = 0; r < 16; ++r) p0[r] = -INFINITY;
#pragma unroll
                for (int r = 0; r < 8; ++r) p1[r] = -INFINITY; }
            float rm = fmaxf(p0[0], p1[0]);
#pragma unroll
            for (int r = 1; r < 16; ++r) rm = fmaxf(rm, fmaxf(p0[r], p1[r]));
            { auto rr = __builtin_amdgcn_permlane32_swap(__float_as_uint(rm), __float_as_uint(rm), false, false); rm = fmaxf(__uint_as_float(rr[0]), __uint_as_float(rr[1])); }
            if (__any(rm > m)) {
                const float mn = fmaxf(m, rm), alpha = exp2f(m - mn); l *= alpha; m = mn;
                if (hi == 0) wsf[r32] = alpha;
#pragma unroll
                for (int r = 0; r < 16; ++r) { const float a = wsf[crow(r, hi)];
#pragma unroll
                    for (int d0 = 0; d0 < 4; ++d0) o[d0][r] *= a; }
            }
            float ls = 0.f;
#pragma unroll
            for (int r = 0; r < 16; ++r) { p0[r] = exp2f(p0[r] - m); p1[r] = exp2f(p1[r] - m); ls += p0[r] + p1[r]; }
            l += ls;
            v4u pw[4];
#pragma unroll
            for (int i = 0; i < 4; ++i) { pw[0][i] = cvtpk(p0[2 * i], p0[2 * i + 1]); pw[1][i] = cvtpk(p0[8 + 2 * i], p0[8 + 2 * i + 1]); pw[2][i] = cvtpk(p1[2 * i], p1[2 * i + 1]); pw[3][i] = cvtpk(p1[8 + 2 * i], p1[8 + 2 * i + 1]); }
            const LAS unsigned char* vp = vbase + buf * VSLOT;
#pragma unroll
            for (int d0 = 0; d0 < 4; ++d0)
#pragma unroll
                for (int ks = 0; ks < 4; ++ks) {
                    const s16x4 lo = vtr(vp + d0 * 4096 + ks * 1024), hi4 = vtr(vp + d0 * 4096 + ks * 1024 + 512);
                    const bf16x8 vf = (bf16x8){lo[0], lo[1], lo[2], lo[3], hi4[0], hi4[1], hi4[2], hi4[3]};
                    o[d0] = __builtin_amdgcn_mfma_f32_32x32x16_bf16(__builtin_bit_cast(bf16x8, pw[ks]), vf, o[d0], 0, 0, 0); }
        }
        asm volatile("s_waitcnt vmcnt(0) lgkmcnt(0)\n\ts_barrier" ::: "memory");
    }
    { auto rr = __builtin_amdgcn_permlane32_swap(__float_as_uint(l), __float_as_uint(l), false, false); l = __uint_as_float(rr[0]) + __uint_as_float(rr[1]); }
    if (hi == 0) wsf[32 + r32] = l;
    bf16* Ow = OS + (size_t)qrow0 * 2048 + sh * 128 + r32;
#pragma unroll
    for (int r = 0; r < 16; ++r) { const float rl = 1.0f / wsf[32 + crow(r, hi)]; bf16* op = Ow + (size_t)crow(r, hi) * 2048;
#pragma unroll
        for (int d0 = 0; d0 < 4; ++d0) op[d0 * 32] = (bf16)f2bf(o[d0][r] * rl); }
    asm volatile("s_waitcnt lgkmcnt(0)\n\ts_barrier" ::: "memory");
#undef FA_DMA
}
}
namespace ml {
typedef float f32x16 __attribute__((ext_vector_type(16)));
typedef short s16x4 __attribute__((ext_vector_type(4)));
constexpr int L_QI = 0, L_KI = 16384, L_VI = 32768, L_SM = 69632, HL_LD = 260;
constexpr int S_WJ = 0, S_US = 64, S_TS = 128, S_WINT = 192, S_EMR = 256, S_RS = 320, S_DINV = 384, S_QN = 448;
__device__ __forceinline__ float wave_scan_add(float v, int lane) {
#pragma unroll
    for (int o = 1; o < 64; o <<= 1) { const float t = __shfl_up(v, o); if (lane >= o) v += t; }
    return v;
}
__device__ __forceinline__ float wave_scan_max(float v, int lane) {
#pragma unroll
    for (int o = 1; o < 64; o <<= 1) { const float t = __shfl_up(v, o); if (lane >= o) v = fmaxf(v, t); }
    return v;
}
__device__ __forceinline__ float wave_max(float v) {
#pragma unroll
    for (int o = 1; o < 64; o <<= 1) v = fmaxf(v, __shfl_xor(v, o));
    return v;
}
__device__ __forceinline__ void conv16(const bf16* QK, const float* cw, const float* cb, int R, int cc0, float (&out)[16]) {
    float a[16];
#pragma unroll
    for (int q = 0; q < 4; ++q) { const f32x4 b = *(const f32x4*)(cb + cc0 + 4 * q); a[4 * q] = b.x; a[4 * q + 1] = b.y; a[4 * q + 2] = b.z; a[4 * q + 3] = b.w; }
#pragma unroll
    for (int jj = 0; jj < 4; ++jj) { const int Rr = R - 3 + jj;
        if (Rr >= ROW_META0) { const v4u x0 = *(const v4u*)(QK + (size_t)Rr * 1024 + cc0), x1 = *(const v4u*)(QK + (size_t)Rr * 1024 + cc0 + 8);
            const unsigned xw[8] = {x0.x, x0.y, x0.z, x0.w, x1.x, x1.y, x1.z, x1.w};
#pragma unroll
            for (int q = 0; q < 4; ++q) { const f32x4 w = *(const f32x4*)(cw + jj * 1024 + cc0 + 4 * q);
                a[4 * q] += w.x * pg8::bflo(xw[2 * q]); a[4 * q + 1] += w.y * pg8::bfhi(xw[2 * q]); a[4 * q + 2] += w.z * pg8::bflo(xw[2 * q + 1]); a[4 * q + 3] += w.w * pg8::bfhi(xw[2 * q + 1]); } } }
#pragma unroll
    for (int i = 0; i < 16; ++i) out[i] = a[i] * pg8::sigm(a[i]);
}
__device__ __forceinline__ s16x4 vtr(const LAS unsigned char* p) { return __builtin_bit_cast(s16x4, __builtin_amdgcn_ds_read_tr16_b64_v4i16((LAS fa::v4i16_t*)p)); }
#define ML_FRAG(base, off) ({ const s16x4 lo_ = ml::vtr((base) + (off)), hi_ = ml::vtr((base) + (off) + 512); (bf16x8){lo_[0], lo_[1], lo_[2], lo_[3], hi_[0], hi_[1], hi_[2], hi_[3]}; })

__device__ __forceinline__ void v_dma(LAS unsigned char* lds, const bf16* MV, int R0, int h, int wid, int lane) {
#pragma unroll
    for (int i = 0; i < 4; ++i)
        __builtin_amdgcn_global_load_lds((const unsigned*)(MV + (size_t)(R0 + 16 * i + (lane >> 2)) * 1024 + h * 256 + wid * 32 + (lane & 3) * 8), (LAS unsigned*)(lds + L_VI + (4 * wid + i) * 1024), 16, 0, 0);
}

__device__ __forceinline__ void stepA(LAS unsigned char* lds, int c, int h, const bf16* QK, const bf16* MV, const float* GATES, const float* cw, const float* cb, float* DCT, float* DN, float* MSC) {
    int tid_ = threadIdx.x; asm volatile("" : "+v"(tid_));
    const int tid = tid_, lane = tid & 63, r32 = lane & 31, hi = lane >> 5, wid = __builtin_amdgcn_readfirstlane(tid >> 6);
    const int R0 = ROW_PAD0 + 64 * c; LAS float* sm = (LAS float*)(lds + L_SM);
    if (wid == 0) { const int R = R0 + lane; const float li = GATES[(size_t)R * 8 + h], lf = GATES[(size_t)R * 8 + 4 + h];
        const float b = wave_scan_add(lf, lane), g = __shfl(b, 63), a = g - b + li, mloc = wave_max(a);
        sm[S_WJ + lane] = __expf(a - mloc);
        if (lane == 0) { MSC[(c * 4 + h) * 4 + 0] = g; MSC[(c * 4 + h) * 4 + 1] = mloc; } }
    v_dma(lds, MV, R0, h, wid, lane);
    __syncthreads();
    { const int j = tid >> 3, part = tid & 7, R = R0 + j; float kv[16];
      if (R >= ROW_META0) { conv16(QK, cw, cb, R, 512 + h * 128 + part * 16, kv); const float s = 0.08838834764831845f * sm[S_WJ + j];
#pragma unroll
          for (int i = 0; i < 16; ++i) kv[i] *= s; }
      else {
#pragma unroll
          for (int i = 0; i < 16; ++i) kv[i] = 0.f; }
      v4u w0, w1; w0.x = pk2(kv[0], kv[1]); w0.y = pk2(kv[2], kv[3]); w0.z = pk2(kv[4], kv[5]); w0.w = pk2(kv[6], kv[7]); w1.x = pk2(kv[8], kv[9]); w1.y = pk2(kv[10], kv[11]); w1.z = pk2(kv[12], kv[13]); w1.w = pk2(kv[14], kv[15]);
      LAS unsigned char* kp = lds + L_KI + (part >> 1) * 4096 + j * 64 + (part & 1) * 32;
      *(LAS v4u*)kp = w0; *(LAS v4u*)(kp + 16) = w1; }
    asm volatile("s_waitcnt vmcnt(0) lgkmcnt(0)" ::: "memory");
    __syncthreads();
    { const LAS unsigned char* tb = lds + ((lane >> 4) & 1) * 32 + (lane & 3) * 8 + (4 * hi + ((lane & 15) >> 2)) * 64;
      bf16x8 af[4];
#pragma unroll
      for (int s = 0; s < 4; ++s) af[s] = ML_FRAG(tb + L_VI + wid * 4096, s * 1024);
      float* outp = DCT + ((size_t)(c * 4 + h) * 256 + wid * 32) * 128 + r32;
#pragma unroll
      for (int db = 0; db < 4; ++db) { f32x16 acc;
#pragma unroll
          for (int r = 0; r < 16; ++r) acc[r] = 0.f;
#pragma unroll
          for (int s = 0; s < 4; ++s) { const bf16x8 bfr = ML_FRAG(tb + L_KI + db * 4096, s * 1024); acc = __builtin_amdgcn_mfma_f32_32x32x16_bf16(af[s], bfr, acc, 0, 0, 0); }
#pragma unroll
          for (int r = 0; r < 16; ++r) outp[(size_t)fa::crow(r, hi) * 128 + db * 32] = acc[r]; } }
    if (tid < 128) { const int d = tid; const LAS unsigned char* kp = lds + L_KI + (d >> 5) * 4096 + (d & 31) * 2; float s = 0.f;
#pragma unroll 8
        for (int j = 0; j < 64; ++j) s += bf2f(*(const LAS bf16*)(kp + j * 64));
        DN[(size_t)(c * 4 + h) * 128 + d] = s; }
    __syncthreads();
}

__device__ __forceinline__ void stepB(int gtid, int ngt, const float* DCT, const float* DN, float* MSC, bf16* CT, float* NPREV) {
    for (int idx = gtid; idx < 4 * 32768; idx += ngt) { const int h = idx >> 15, ed = idx & 32767; const bool isn = ed < 128;
        float C = 0.f, n = 0.f, m = 0.f;
        for (int c0 = 0; c0 < 128; c0 += 8) { float dc[8], dn[8], gg[8], ml_[8];
#pragma unroll
            for (int u = 0; u < 8; ++u) { const int c = c0 + u; dc[u] = DCT[(size_t)(c * 4 + h) * 32768 + ed]; dn[u] = isn ? DN[(size_t)(c * 4 + h) * 128 + ed] : 0.f; gg[u] = MSC[(c * 4 + h) * 4]; ml_[u] = MSC[(c * 4 + h) * 4 + 1]; }
#pragma unroll
            for (int u = 0; u < 8; ++u) { const int c = c0 + u; const float mn = fmaxf(gg[u] + m, ml_[u]), dec = __expf(gg[u] + m - mn), sc = __expf(ml_[u] - mn);
                C = dec * C + sc * dc[u]; n = dec * n + sc * dn[u]; m = mn;
                CT[(size_t)((c + 1) * 4 + h) * 32768 + ed] = (bf16)f2bf(C);
                if (isn) NPREV[(size_t)((c + 1) * 4 + h) * 128 + ed] = n;
                if (ed == 0) MSC[((c + 1) * 4 + h) * 4 + 2] = m; } }
    }
}

__device__ __forceinline__ void stepC(LAS unsigned char* lds, int c, int h, const bf16* QK, const bf16* MV, const bf16* MO, const float* GATES, const float* cw, const float* cb, const bf16* CT, const float* NPREV, const float* MSC, bf16* HMG) {
    int tid_ = threadIdx.x; asm volatile("" : "+v"(tid_));
    const int tid = tid_, lane = tid & 63, r32 = lane & 31, hi = lane >> 5, wid = __builtin_amdgcn_readfirstlane(tid >> 6);
    const int R0 = ROW_PAD0 + 64 * c; LAS float* sm = (LAS float*)(lds + L_SM);
    if (wid == 0) { const int R = R0 + lane; const float li = GATES[(size_t)R * 8 + h], lf = GATES[(size_t)R * 8 + 4 + h], mprev = MSC[(c * 4 + h) * 4 + 2];
        const float b = wave_scan_add(lf, lane), u = li - b, pm = wave_scan_max(u, lane), mrow = b + fmaxf(mprev, pm);
        sm[S_US + lane] = u; sm[S_TS + lane] = b - mrow; sm[S_WINT + lane] = __expf(b + mprev - mrow); sm[S_EMR + lane] = __expf(-mrow); }
    v_dma(lds, MV, R0, h, wid, lane);
    { const int j = tid >> 3, part = tid & 7, R = R0 + j; float qv[16], kv[16];
      conv16(QK, cw, cb, R, h * 128 + part * 16, qv); conv16(QK, cw, cb, R, 512 + h * 128 + part * 16, kv);
      const float* np = NPREV + (size_t)(c * 4 + h) * 128 + part * 16; float qn = 0.f;
#pragma unroll
      for (int q = 0; q < 4; ++q) { const f32x4 nv = *(const f32x4*)(np + 4 * q); qn += (qv[4 * q] * nv.x + qv[4 * q + 1] * nv.y) + (qv[4 * q + 2] * nv.z + qv[4 * q + 3] * nv.w); }
      sm[S_QN + part * 64 + j] = qn;
#pragma unroll
      for (int i = 0; i < 16; ++i) kv[i] *= 0.08838834764831845f;
      v4u w0, w1; w0.x = pk2(qv[0], qv[1]); w0.y = pk2(qv[2], qv[3]); w0.z = pk2(qv[4], qv[5]); w0.w = pk2(qv[6], qv[7]); w1.x = pk2(qv[8], qv[9]); w1.y = pk2(qv[10], qv[11]); w1.z = pk2(qv[12], qv[13]); w1.w = pk2(qv[14], qv[15]);
      *(LAS v4u*)(lds + L_QI + (2 * part) * 1024 + j * 16) = w0; *(LAS v4u*)(lds + L_QI + (2 * part + 1) * 1024 + j * 16) = w1;
      w0.x = pk2(kv[0], kv[1]); w0.y = pk2(kv[2], kv[3]); w0.z = pk2(kv[4], kv[5]); w0.w = pk2(kv[6], kv[7]); w1.x = pk2(kv[8], kv[9]); w1.y = pk2(kv[10], kv[11]); w1.z = pk2(kv[12], kv[13]); w1.w = pk2(kv[14], kv[15]);
      *(LAS v4u*)(lds + L_KI + (2 * part) * 1024 + j * 16) = w0; *(LAS v4u*)(lds + L_KI + (2 * part + 1) * 1024 + j * 16) = w1; }
    asm volatile("s_waitcnt vmcnt(0) lgkmcnt(0)" ::: "memory");
    __syncthreads();
    const int ib = wid & 1, ep = wid >> 1;
    f32x16 acc[2];
    {
        bf16x8 qf[8];
#pragma unroll
        for (int s = 0; s < 8; ++s) qf[s] = *(const LAS bf16x8*)(lds + L_QI + (2 * s + hi) * 1024 + (32 * ib + r32) * 16);
#pragma unroll
        for (int eb = 0; eb < 2; ++eb) {
#pragma unroll
            for (int r = 0; r < 16; ++r) acc[eb][r] = 0.f;
            const bf16* cp = CT + ((size_t)(c * 4 + h) * 256 + (2 * ep + eb) * 32 + r32) * 128 + 8 * hi;
#pragma unroll
            for (int s = 0; s < 8; ++s) { const bf16x8 cf = *(const bf16x8*)(cp + 16 * s); acc[eb] = __builtin_amdgcn_mfma_f32_32x32x16_bf16(qf[s], cf, acc[eb], 0, 0, 0); } }
#pragma unroll
        for (int r = 0; r < 16; ++r) { const float wv = sm[S_WINT + 32 * ib + fa::crow(r, hi)]; acc[0][r] *= wv; acc[1][r] *= wv; }
        f32x16 p0, p1;
#pragma unroll
        for (int r = 0; r < 16; ++r) { p0[r] = 0.f; p1[r] = 0.f; }
#pragma unroll
        for (int s = 0; s < 8; ++s) { const bf16x8 k0 = *(const LAS bf16x8*)(lds + L_KI + (2 * s + hi) * 1024 + r32 * 16); p0 = __builtin_amdgcn_mfma_f32_32x32x16_bf16(k0, qf[s], p0, 0, 0, 0); }
        if (ib == 1) {
#pragma unroll
            for (int s = 0; s < 8; ++s) { const bf16x8 k1 = *(const LAS bf16x8*)(lds + L_KI + (2 * s + hi) * 1024 + (32 + r32) * 16); p1 = __builtin_amdgcn_mfma_f32_32x32x16_bf16(k1, qf[s], p1, 0, 0, 0); } }
        const int i = 32 * ib + r32; const float ti = sm[S_TS + i]; float rs = 0.f;
#pragma unroll
        for (int r = 0; r < 16; ++r) { const int j = fa::crow(r, hi);
            p0[r] = (j <= i) ? p0[r] * __expf(ti + sm[S_US + j]) : 0.f;
            p1[r] = (ib == 1 && j + 32 <= i) ? p1[r] * __expf(ti + sm[S_US + j + 32]) : 0.f;
            rs += p0[r] + p1[r]; }
        { auto rr = __builtin_amdgcn_permlane32_swap(__float_as_uint(rs), __float_as_uint(rs), false, false); rs = __uint_as_float(rr[0]) + __uint_as_float(rr[1]); }
        if (ep == 0 && hi == 0) sm[S_RS + i] = rs;
        v4u pw[4];
#pragma unroll
        for (int q = 0; q < 4; ++q) { pw[0][q] = pg8::cvt_pk_bf16(p0[2 * q], p0[2 * q + 1]); pw[1][q] = pg8::cvt_pk_bf16(p0[8 + 2 * q], p0[8 + 2 * q + 1]); pw[2][q] = pg8::cvt_pk_bf16(p1[2 * q], p1[2 * q + 1]); pw[3][q] = pg8::cvt_pk_bf16(p1[8 + 2 * q], p1[8 + 2 * q + 1]); }
        const LAS unsigned char* tb = lds + L_VI + ((lane >> 4) & 1) * 32 + (lane & 3) * 8 + (4 * hi + ((lane & 15) >> 2)) * 64;
#pragma unroll
        for (int eb = 0; eb < 2; ++eb) {
#pragma unroll
            for (int ks = 0; ks < 2; ++ks) { const bf16x8 vf = ML_FRAG(tb + (2 * ep + eb) * 4096, ks * 1024); acc[eb] = __builtin_amdgcn_mfma_f32_32x32x16_bf16(__builtin_bit_cast(bf16x8, pw[ks]), vf, acc[eb], 0, 0, 0); }
            if (ib == 1) {
#pragma unroll
                for (int ks = 2; ks < 4; ++ks) { const bf16x8 vf = ML_FRAG(tb + (2 * ep + eb) * 4096, ks * 1024); acc[eb] = __builtin_amdgcn_mfma_f32_32x32x16_bf16(__builtin_bit_cast(bf16x8, pw[ks]), vf, acc[eb], 0, 0, 0); } } }
    }
    __syncthreads();
    if (tid < 64) { float qn = 0.f;
#pragma unroll
        for (int p = 0; p < 8; ++p) qn += sm[S_QN + p * 64 + tid];
        const float den = sm[S_WINT + tid] * qn + sm[S_RS + tid]; sm[S_DINV + tid] = 1.0f / fmaxf(fabsf(den), sm[S_EMR + tid]); }
    __syncthreads();
    { LAS float* HL = (LAS float*)lds;
#pragma unroll
      for (int r = 0; r < 16; ++r) { const int i = 32 * ib + fa::crow(r, hi); const float dv = sm[S_DINV + i];
          HL[i * HL_LD + (2 * ep) * 32 + r32] = acc[0][r] * dv; HL[i * HL_LD + (2 * ep + 1) * 32 + r32] = acc[1][r] * dv; } }
    __syncthreads();
    { const LAS float* HL = (const LAS float*)lds; const int i = tid >> 3, part = tid & 7; f32x4 v[8]; float ss = 0.f;
#pragma unroll
      for (int k = 0; k < 8; ++k) { v[k] = *(const LAS f32x4*)(HL + i * HL_LD + 32 * k + 4 * part); ss += (v[k].x * v[k].x + v[k].y * v[k].y) + (v[k].z * v[k].z + v[k].w * v[k].w); }
      ss += __shfl_xor(ss, 1); ss += __shfl_xor(ss, 2); ss += __shfl_xor(ss, 4);
      const float rs = 1.0f / sqrtf(ss * (1.0f / 256.0f) + EPS);
      const size_t go = (size_t)(R0 + i) * 1024 + h * 256 + 4 * part;
#pragma unroll
      for (int k = 0; k < 8; ++k) { const v2u mo = *(const v2u*)(MO + go + 32 * k);
          v2u w; w.x = pk2(v[k].x * rs * pg8::bflo(mo.x), v[k].y * rs * pg8::bfhi(mo.x)); w.y = pk2(v[k].z * rs * pg8::bflo(mo.y), v[k].w * rs * pg8::bfhi(mo.y));
          *(v2u*)(HMG + go + 32 * k) = w; } }
    __syncthreads();
}
}
__global__ void __launch_bounds__(NTHREADS, 2) mega_fwd(Args args) {
    extern __shared__ __attribute__((aligned(16))) unsigned char lds_raw[];
    LAS unsigned char* lds = (LAS unsigned char*)lds_raw;
    volatile LAS unsigned* MISC = (volatile LAS unsigned*)(lds + MISC_OFF);
    const int tid = threadIdx.x, lane = tid & 63, wave = __builtin_amdgcn_readfirstlane(tid >> 6);
    const int G = gridDim.x, bx = blockIdx.x;
    const int vcu = (G % 8 == 0) ? (bx % 8) * (G / 8) + bx / 8 : bx;
    unsigned char* ws = args.ws;
    gu32* ctl = (gu32*)(ws + WS_CTL);
    for (int u = tid; u < (LDS_BYTES - LDSCTL_OFF) / 4; u += NTHREADS) ((LAS unsigned*)(lds + LDSCTL_OFF))[u] = 0u;
    __syncthreads();
    XcdBarrier bar = xcd_barrier_post((unsigned*)(ctl + CW_BAR), MISC + 8);
#define GRID_BAR() xcd_barrier(bar)

    float* ROPE = (float*)(ws + WS_ROPE); float* BIAS = (float*)(ws + WS_BIAS); float* GW = (float*)(ws + WS_GW); float* METAH = (float*)(ws + WS_METAH);
    float* GATES = (float*)(ws + WS_GATES);
    bf16* WUP = (bf16*)(ws + WS_WUP); bf16* WDN = (bf16*)(ws + WS_WDN); bf16* WIN = (bf16*)(ws + WS_WIN); bf16* WMB = (bf16*)(ws + WS_WMB); bf16* WAB = (bf16*)(ws + WS_WAB); bf16* WOUT = (bf16*)(ws + WS_WOUT);
    bf16* XA = (bf16*)(ws + WS_XA); bf16* HID = (bf16*)(ws + WS_HID); float* Y = (float*)(ws + WS_Y); bf16* Z = (bf16*)(ws + WS_Z); bf16* YG = (bf16*)(ws + WS_YG);
    bf16* HMG = (bf16*)(ws + WS_HMG); bf16* HA = (bf16*)(ws + WS_HA); bf16* CT = (bf16*)(ws + WS_HM); float* DCT = (float*)(ws + WS_DCT); float* DNB = (float*)(ws + WS_DN); float* NPREV = (float*)(ws + WS_NPREV); float* MSC = (float*)(ws + WS_MSC);
    bf16* ZQK = Z; bf16* ZMV = Z + ZPIECE; bf16* ZMO = Z + 2 * ZPIECE; bf16* ZAQ = Z + 3 * ZPIECE; bf16* ZAK = Z + 4 * ZPIECE; bf16* ZAV = Z + 5 * ZPIECE;
    bf16* ZGM = Z + 6 * ZPIECE; bf16* ZGA = ZGM + (size_t)MP * 2048;
    const int gw = vcu * NWAVES + wave, NGW = G * NWAVES;
    LAS float* scr = (LAS float*)(lds + wave * 16384);

#if PH_MASK & (1 << 0)
    {
        convert_ffn(args.in[I_F1G], args.in[I_F1U], args.in[I_F1D], args.in[I_F1PRE], WUP, WDN, scr, gw, NGW, lane);
        constexpr int N_IN = (DM / 64) * (NIN / 32), N_MB = (1024 / 64) * (DM / 32), N_WO = (DM / 64) * (DM / 32);
        for (int it = gw; it < N_IN + 2 * N_MB + N_WO; it += NGW) {
            int r = it;
            if (r < N_IN) { const int nblk = NIN / 32, kb = r / nblk, nb = r % nblk, row0 = 32 * nb; const int col0 = row0 < 3072 ? row0 : row0 + 8;
                tr_item(args.in[I_WIN], NIN_SRC, col0, 64 * kb, WIN, DM, row0, args.in[I_MIXPRE], 1.0f, scr, lane); continue; } r -= N_IN;
            if (r < N_MB) { const int nblk = DM / 32, kb = r / nblk, nb = r % nblk; tr_item(args.in[I_MWB], DM, 32 * nb, 64 * kb, WMB, 1024, 32 * nb, args.in[I_MNORM], 1.0f, scr, lane); continue; } r -= N_MB;
            if (r < N_MB) { const int nblk = DM / 32, kb = r / nblk, nb = r % nblk; tr_item(args.in[I_AWB], DM, 32 * nb, 64 * kb, WAB, 1024, 32 * nb, args.in[I_ANORM], 0.8f, scr, lane); continue; } r -= N_MB;
            { const int nblk = DM / 32, kb = r / nblk, nb = r % nblk; tr_item(args.in[I_WOUT], DM, 32 * nb, 64 * kb, WOUT, DM, 32 * nb, nullptr, 1.0f, scr, lane); }
        }
        const int gt = vcu * NTHREADS + tid, NGT = G * NTHREADS;
        for (int i = gt; i < NIN; i += NGT) BIAS[i] = args.in[I_BIN][i < 3072 ? i : i + 8];
        for (int i = gt; i < 8 * DM; i += NGT) { const int c = i / DM, k = i % DM; GW[i] = args.in[I_WIN][(size_t)k * NIN_SRC + 3072 + c] * args.in[I_MIXPRE][k]; }
        for (int i = gt; i < (SEQ + NMETA) * 8; i += NGT) { const int pos = i >> 3, k = i & 7;
            const float invf = k == 0 ? 1.0f : k == 1 ? 0.19392274474868576f : k == 2 ? 0.03760603093086393f : k == 3 ? 0.007292664737217109f : k == 4 ? 0.001414213562373095f : k == 5 ? 0.0002742481756762073f : k == 6 ? 5.318295896944988e-05f : 1.031338537721246e-05f;
            const float ang = (float)pos * invf; const double a = (double)ang;
            const double q = rint(a * 0.15915494309189535); const double rr = a - q * 6.283185307179586476925;
            double s, c; sincos_small(rr, s, c);
            ROPE[(size_t)pos * 16 + k] = (float)c; ROPE[(size_t)pos * 16 + 8 + k] = (float)s; }
        for (int R = gw; R < MP; R += NGW) {
            bf16* xo = XA + (size_t)R * DM;
            if (R < ROW_META0) { GAS v2u* o = (GAS v2u*)xo + lane; v2u z; z.x = 0u; z.y = 0u;
#pragma unroll
                for (int j = 0; j < 8; ++j) o[64 * j] = z; }
            else { const float* hp = (R >= ROW_X0) ? args.in[I_X] + (size_t)(R - ROW_X0) * DM : args.in[I_META] + (size_t)(R - ROW_META0) * DM;
                f32x4 v[8]; load_row(hp, lane, v); const float r1 = 1.0f / sqrtf(row_ssq(v) * (1.0f / DM) + EPS); store_row_bf16(xo, lane, v, r1); }
        }
    }
#endif
    GRID_BAR();

#if PH_MASK & (1 << 1)
    { pg8::Gemm g{XA, WUP, MP, NUP, DM}; pg8::StaticOrder S; S.init(MP, NUP, G, bx); pg8::EpiSwiglu E{HID, DFF};
      pg8::gemm_phase<pg8::EpiSwiglu, pg8::StaticOrder, true, true>(lds, g, S, E); }
#endif
    GRID_BAR();
#if PH_MASK & (1 << 2)
    { pg8::Gemm g{HID, WDN, MP, DM, DFF}; pg8::StaticOrder S; S.init(MP, DM, G, bx); pg8::EpiF32 E{Y, DM};
      pg8::gemm_phase<pg8::EpiF32, pg8::StaticOrder, true, true>(lds, g, S, E); }
#endif
    GRID_BAR();
#if PH_MASK & (1 << 3)
    {
        for (int R = ROW_PAD0 + gw; R < MP; R += NGW) {
            if (R < ROW_META0) { if (lane < 8) GATES[(size_t)R * 8 + lane] = (lane < 4) ? -INFINITY : 0.f; continue; }
            const float* hp = (R >= ROW_X0) ? args.in[I_X] + (size_t)(R - ROW_X0) * DM : args.in[I_META] + (size_t)(R - ROW_META0) * DM;
            float* ho = (R >= ROW_X0) ? args.out + (size_t)(R - ROW_X0) * DM : METAH + (size_t)(R - ROW_META0) * DM;
            f32x4 y[8], h[8], g[8]; load_row(Y + (size_t)R * DM, lane, y); load_row(hp, lane, h); load_row(args.in[I_F1POST], lane, g);
            const float rs = 0.5f / sqrtf(row_ssq(y) * (1.0f / DM) + EPS);
#pragma unroll
            for (int j = 0; j < 8; ++j) h[j] = h[j] + (y[j] * rs) * g[j];
            { GAS f32x4* o = (GAS f32x4*)ho + lane;
#pragma unroll
              for (int j = 0; j < 8; ++j) o[64 * j] = h[j]; }
            const float r2 = 1.0f / sqrtf(row_ssq(h) * (1.0f / DM) + EPS);
            store_row_bf16(XA + (size_t)R * DM, lane, h, r2);
            float gv = 0.f;
#pragma unroll 1
            for (int c = 0; c < 8; ++c) { const GAS f32x4* wp = (const GAS f32x4*)(GW + (size_t)c * DM) + lane; float s = 0.f;
#pragma unroll
                for (int j = 0; j < 8; ++j) { const f32x4 w = wp[64 * j]; s += (h[j].x * w.x + h[j].y * w.y) + (h[j].z * w.z + h[j].w * w.w); }
                s = wave_sum(s); if (lane == c) gv = s; }
            if (lane < 8) { float v = gv * r2 + args.in[I_BIN][3072 + lane]; if (lane >= 4) v = log_sigmoid(v); GATES[(size_t)R * 8 + lane] = v; }
        }
    }
#endif
    GRID_BAR();
#if PH_MASK & (1 << 4)
    { pg8::Gemm g{XA, WIN, MP, NIN, DM}; pg8::StaticOrder S; S.init(MP, NIN, G, bx); pg8::EpiZ E{Z, BIAS, ROPE};
      pg8::gemm_phase<pg8::EpiZ, pg8::StaticOrder, true, true>(lds, g, S, E); }
#endif
    GRID_BAR();
#if PH_MASK & (1 << 5)
    {
        for (int it = bx; it < 512; it += G) ml::stepA(lds, it >> 2, it & 3, ZQK, ZMV, GATES, args.in[I_CONVW], args.in[I_CONVB], DCT, DNB, MSC);
    }
    GRID_BAR();
    {
        ml::stepB(vcu * NTHREADS + tid, G * NTHREADS, DCT, DNB, MSC, CT, NPREV);
        bf16* OS = XA;
        for (int u = bx; u < 256; u += G) { const int x = u & 7, j = u >> 3, sh = 2 * x + (j & 1), p = j >> 1;
            fa::attn_unit(lds, sh, p, ZAQ, ZAK, ZAV, OS);
            fa::attn_unit(lds, sh, 31 - p, ZAQ, ZAK, ZAV, OS); }
    }
#endif
    GRID_BAR();
#if PH_MASK & (1 << 6)
    {
        for (int it = bx; it < 512; it += G) ml::stepC(lds, 1 + (it >> 2), it & 3, ZQK, ZMV, ZMO, GATES, args.in[I_CONVW], args.in[I_CONVB], CT, NPREV, MSC, HMG);
        float s1 = 0.f, s2 = 0.f;
        { const float a1 = args.in[I_LQ1][lane] * args.in[I_LK1][lane], a2 = args.in[I_LQ2][lane] * args.in[I_LK2][lane]; s1 = wave_sum(a1); s2 = wave_sum(a2); }
        const float lam = expf(s1) - expf(s2) + 0.2f;
        const bf16* OS = XA;
        for (int R = ROW_X0 + gw; R < MP; R += NGW) {
            const GAS unsigned* osr = (const GAS unsigned*)(OS + (size_t)R * 2048) + lane; GAS unsigned* hao = (GAS unsigned*)(HA + (size_t)R * 1024) + lane;
#pragma unroll
            for (int hh = 0; hh < 8; ++hh) { const unsigned w1 = osr[hh * 128], w2 = osr[hh * 128 + 64];
                const float v0 = pg8::bflo(w1) - lam * pg8::bflo(w2), v1 = pg8::bfhi(w1) - lam * pg8::bfhi(w2);
                const float ss = wave_sum(v0 * v0 + v1 * v1); const float rs = 1.0f / sqrtf(ss * (1.0f / 128.0f) + EPS);
                hao[hh * 64] = pk2(v0 * rs, v1 * rs); }
        }
    }
#endif
    GRID_BAR();
#if PH_MASK & (1 << 7)
    { pg8::Gemm g{HMG + (size_t)ROW_X0 * 1024, WMB, SEQ, DM, 1024}; pg8::StaticOrder S; S.init(SEQ, DM, G, bx); pg8::EpiGate E{ZGM + (size_t)ROW_X0 * 2048, YG + (size_t)ROW_X0 * 2048, DM, 0};
      pg8::gemm_phase<pg8::EpiGate, pg8::StaticOrder, true, true>(lds, g, S, E); }
#endif
    GRID_BAR();
#if PH_MASK & (1 << 8)
    { pg8::Gemm g{HA + (size_t)ROW_X0 * 1024, WAB, SEQ, DM, 1024}; pg8::StaticOrder S; S.init(SEQ, DM, G, bx); pg8::EpiGate E{ZGA + (size_t)ROW_X0 * 2048, YG + (size_t)ROW_X0 * 2048, DM, 1};
      pg8::gemm_phase<pg8::EpiGate, pg8::StaticOrder, true, true>(lds, g, S, E); }
#endif
    GRID_BAR();
#if PH_MASK & (1 << 9)
    { pg8::Gemm g{YG + (size_t)ROW_X0 * 2048, WOUT, SEQ, DM, DM}; pg8::StaticOrder S; S.init(SEQ, DM, G, bx); pg8::EpiF32 E{Y + (size_t)ROW_X0 * DM, DM};
      pg8::gemm_phase<pg8::EpiF32, pg8::StaticOrder, true, true>(lds, g, S, E); }
#endif
    GRID_BAR();
#if PH_MASK & (1 << 10)
    {
        for (int R = ROW_X0 + gw; R < MP; R += NGW) {
            float* ho = args.out + (size_t)(R - ROW_X0) * DM;
            f32x4 y[8], h[8], g[8]; load_row(Y + (size_t)R * DM, lane, y); load_row(ho, lane, h); load_row(args.in[I_MIXPOST], lane, g);
            const float rs = 1.0f / sqrtf(row_ssq(y) * (1.0f / DM) + EPS);
#pragma unroll
            for (int j = 0; j < 8; ++j) h[j] = h[j] + (y[j] * rs) * g[j];
            { GAS f32x4* o = (GAS f32x4*)ho + lane;
#pragma unroll
              for (int j = 0; j < 8; ++j) o[64 * j] = h[j]; }
            const float r2 = 1.0f / sqrtf(row_ssq(h) * (1.0f / DM) + EPS);
            store_row_bf16(XA + (size_t)R * DM, lane, h, r2);
        }
        convert_ffn(args.in[I_F2G], args.in[I_F2U], args.in[I_F2D], args.in[I_F2PRE], WUP, WDN, scr, gw, NGW, lane);
    }
#endif
    GRID_BAR();
#if PH_MASK & (1 << 11)
    { pg8::Gemm g{XA + (size_t)ROW_X0 * DM, WUP, SEQ, NUP, DM}; pg8::StaticOrder S; S.init(SEQ, NUP, G, bx); pg8::EpiSwiglu E{HID + (size_t)ROW_X0 * DFF, DFF};
      pg8::gemm_phase<pg8::EpiSwiglu, pg8::StaticOrder, true, true>(lds, g, S, E); }
#endif
    GRID_BAR();
#if PH_MASK & (1 << 12)
    { pg8::Gemm g{HID + (size_t)ROW_X0 * DFF, WDN, SEQ, DM, DFF}; pg8::StaticOrder S; S.init(SEQ, DM, G, bx); pg8::EpiF32 E{Y + (size_t)ROW_X0 * DM, DM};
      pg8::gemm_phase<pg8::EpiF32, pg8::StaticOrder, true, true>(lds, g, S, E); }
#endif
    GRID_BAR();
#if PH_MASK & (1 << 13)
    {
        for (int R = ROW_X0 + gw; R < MP; R += NGW) {
            float* ho = args.out + (size_t)(R - ROW_X0) * DM;
            f32x4 y[8], h[8], g[8]; load_row(Y + (size_t)R * DM, lane, y); load_row(ho, lane, h); load_row(args.in[I_F2POST], lane, g);
            const float rs = 0.5f / sqrtf(row_ssq(y) * (1.0f / DM) + EPS);
            GAS f32x4* o = (GAS f32x4*)ho + lane;
#pragma unroll
            for (int j = 0; j < 8; ++j) o[64 * j] = h[j] + (y[j] * rs) * g[j];
        }
    }
#endif
}

extern "C" void kernel_launch(void* const* d_in, const int* in_sizes, int n_in, void* d_out, int out_size, void* d_ws, size_t ws_size, hipStream_t stream) {
    static int grid = 0;
    if (grid == 0) {
        if (n_in != 27 || in_sizes[0] != SEQ * DM || out_size != SEQ * DM || ws_size < WS_END) { fprintf(stderr, "kernel_launch: unexpected shapes (n_in %d, in0 %d, out %d, ws %zu); nothing launched\n", n_in, n_in > 0 ? in_sizes[0] : -1, out_size, ws_size); grid = -1; return; }
        int dev = 0, cus = 0, per_cu = 0;
        if (hipGetDevice(&dev) != hipSuccess || hipDeviceGetAttribute(&cus, hipDeviceAttributeMultiprocessorCount, dev) != hipSuccess) { grid = -1; return; }
        if (hipFuncSetAttribute((const void*)mega_fwd, hipFuncAttributeMaxDynamicSharedMemorySize, LDS_BYTES) != hipSuccess) { fprintf(stderr, "kernel_launch: hipFuncSetAttribute failed\n"); grid = -1; return; }
        if (hipOccupancyMaxActiveBlocksPerMultiprocessor(&per_cu, (const void*)mega_fwd, NTHREADS, LDS_BYTES) != hipSuccess || per_cu < 1) { fprintf(stderr, "kernel_launch: occupancy query says %d blocks per CU\n", per_cu); (void)hipGetLastError(); grid = -1; return; }
        grid = cus;
    }
    if (grid < 0) return;
    if (hipMemsetAsync((char*)d_ws + WS_CTL, 0, CTL_ZERO_BYTES, stream) != hipSuccess) { fprintf(stderr, "kernel_launch: memset failed\n"); return; }
    Args a{};
    for (int i = 0; i < 27; ++i) a.in[i] = (const float*)d_in[i];
    a.out = (float*)d_out; a.ws = (unsigned char*)d_ws;
    hipLaunchKernelGGL(mega_fwd, dim3(grid), dim3(NTHREADS), LDS_BYTES, stream, a);
}
```

```cpp
#include <hip/hip_runtime.h>
#include <cstdio>
#include <cstdint>

constexpr int DM = 2048, SEQ = 8192, NMETA = 16, DFF = 5632, NUP = 2 * DFF, NIN = 10240, NIN_SRC = 10248;
constexpr int MP = 8448, ROW_X0 = 256, ROW_META0 = 240, ROW_PAD0 = 192, NCHUNK = 129;
constexpr float EPS = 1e-6f;
constexpr float QSCALE = 0.125f * 1.4426950408889634f;

constexpr size_t MiB = 1u << 20;
constexpr size_t WS_CTL = 0, CTL_ZERO_BYTES = 1 * MiB;
constexpr size_t WS_ROPE = 1 * MiB;
constexpr size_t WS_BIAS = 2 * MiB;
constexpr size_t WS_GW = 2 * MiB + 64 * 1024;
constexpr size_t WS_METAH = 2 * MiB + 256 * 1024;
constexpr size_t WS_DN = 1 * MiB + 520 * 1024;
constexpr size_t WS_NPREV = 2 * MiB + 384 * 1024;
constexpr size_t WS_MSC = 2 * MiB + 704 * 1024;
constexpr size_t WS_GATES = 3 * MiB;
constexpr size_t WS_WUP = 4 * MiB;
constexpr size_t WS_WDN = 48 * MiB;
constexpr size_t WS_WIN = 70 * MiB;
constexpr size_t WS_WMB = 110 * MiB;
constexpr size_t WS_WAB = 114 * MiB;
constexpr size_t WS_WOUT = 118 * MiB;
constexpr size_t WS_XA = 126 * MiB;
constexpr size_t WS_U = 159 * MiB;
constexpr size_t WS_HID = WS_U;
constexpr size_t WS_Y = WS_U + 91 * MiB;
constexpr size_t WS_Z = WS_U;
constexpr size_t ZPIECE = (size_t)MP * 1024;
constexpr size_t WS_YG = WS_U;
constexpr size_t WS_HMG = 324 * MiB;
constexpr size_t WS_HA = WS_HMG + (size_t)MP * 1024 * 2;
constexpr size_t WS_HM = 357 * MiB;
constexpr size_t WS_DCT = WS_WUP;
constexpr size_t WS_END = 390 * MiB;
static_assert(WS_WUP + (size_t)NUP * DM * 2 <= WS_WDN && WS_WDN + (size_t)DM * DFF * 2 <= WS_WIN && WS_WIN + (size_t)NIN * DM * 2 <= WS_WMB, "ws map 1");
static_assert(WS_XA + (size_t)MP * DM * 2 <= WS_U && WS_HID + (size_t)MP * DFF * 2 <= WS_Y && WS_Y + (size_t)MP * DM * 4 <= WS_HMG, "ws map 2");
static_assert(WS_Z + (6 * ZPIECE + 2 * (size_t)MP * 2048) * 2 <= WS_HMG && WS_HA + (size_t)MP * 1024 * 2 <= WS_HM && WS_HM + (size_t)MP * 1024 * 4 <= WS_END, "ws map 3");
static_assert(WS_YG + (size_t)MP * 2048 * 2 <= WS_Y, "YG must not overlap Y");
constexpr int CW_BAR = 4096;

namespace pg8 {
#define PG8_LAS __attribute__((address_space(3)))
typedef unsigned short bf16_t;
typedef short bf16x8 __attribute__((ext_vector_type(8)));
typedef float f32x4 __attribute__((ext_vector_type(4)));
typedef unsigned u32x4 __attribute__((ext_vector_type(4)));
constexpr int BM = 256, BK = 64, HALF = 128, HTB = HALF * BK * 2  , STAGE_BYTES = 8 * HTB, NXCD = 8, WGM = 8;

__host__ __device__ __forceinline__ int lds_byte(int r, int c) { const int st = (r >> 4) * 2 + (c >> 5), rr = r & 15, cc = c & 31, ob = rr * 64 + cc * 2; return st * 1024 + (ob ^ (((ob >> 9) & 1) << 5)); }
__host__ __device__ __forceinline__ void stage_rc(int b, int& R, int& C) { const int st = b / 1024, sb = b % 1024, swz = sb ^ (((sb >> 9) & 1) << 5); R = (st >> 1) * 16 + swz / 64; C = (st & 1) * 32 + (swz % 64) / 2; }
__host__ __device__ __forceinline__ int perm32(int rho) { const int n = rho >> 4, i = rho & 15; return 8 * (i >> 2) + 4 * n + (i & 3); }

struct Unit { int pm, pn; };
struct Gemm { const bf16_t* A; const bf16_t* Bt; int M, N, K; };

struct StaticOrder {
    int nM, nN, nwg, G, c;
    __host__ __device__ void init(int M, int N, int G_, int c_) { nM = M / BM; nN = N / BM; nwg = nM * nN; G = G_; c = c_; }
    __host__ __device__ bool next(int i, Unit& u) const {
        const long L = (long)i * G + c; if (L >= nwg) return false;
        int wgid = (int)L; { const int q = nwg / NXCD, r = nwg % NXCD, xcd = wgid % NXCD, off = wgid / NXCD; wgid = (xcd < r ? xcd * (q + 1) : r * (q + 1) + (xcd - r) * q) + off; }
        const int nig = WGM * nN, gid = wgid / nig, fm = gid * WGM, gsz = (nM - fm) < WGM ? (nM - fm) : WGM;
        u.pm = fm + ((wgid % nig) % gsz); u.pn = (wgid % nig) / gsz; return true;
    }
    __device__ __forceinline__ void a_ready(const Unit&) const {}
    __device__ __forceinline__ void done(const Unit&) const {}
};

__device__ __forceinline__ unsigned cvt_pk_bf16(float lo, float hi) { unsigned r; asm volatile("v_cvt_pk_bf16_f32 %0, %1, %2" : "=v"(r) : "v"(lo), "v"(hi)); return r; }
typedef float f32x2 __attribute__((ext_vector_type(2)));
__device__ __forceinline__ float sigm(float x) { return __builtin_amdgcn_rcpf(1.0f + __expf(-x)); }
__device__ __forceinline__ float bflo(unsigned w) { return __uint_as_float(w << 16); }
__device__ __forceinline__ float bfhi(unsigned w) { return __uint_as_float(w & 0xffff0000u); }

struct EpiF32 {
    static constexpr bool PERM = false, AFTER_DRAIN = false;
    float* C; int ldc;
    __device__ __forceinline__ void operator()(const f32x4 (&acc)[2][2][4][2], const Unit& u, int wr, int wc, int fr, int fq) const {
        const int row0 = u.pm * BM + wr * 64 + fr, col0 = u.pn * BM + wc * 32 + 4 * fq;
#pragma unroll
        for (int ai = 0; ai < 2; ++ai)
#pragma unroll
            for (int m = 0; m < 4; ++m) { float* rowp = C + (size_t)(row0 + ai * HALF + m * 16) * ldc + col0;
#pragma unroll
                for (int bj = 0; bj < 2; ++bj)
#pragma unroll
                    for (int n = 0; n < 2; ++n) *(f32x4*)(rowp + bj * HALF + n * 16) = acc[ai][bj][m][n]; }
    }
};

struct EpiSwiglu {
    static constexpr bool PERM = true, AFTER_DRAIN = false;
    bf16_t* O; int ldc;
    __device__ __forceinline__ void operator()(const f32x4 (&acc)[2][2][4][2], const Unit& u, int wr, int wc, int fr, int fq) const {
        const int row0 = u.pm * BM + wr * 64 + fr, col0 = u.pn * HALF + wc * 32 + 8 * fq;
#pragma unroll
        for (int ai = 0; ai < 2; ++ai)
#pragma unroll
            for (int m = 0; m < 4; ++m) { bf16_t* rowp = O + (size_t)(row0 + ai * HALF + m * 16) * ldc + col0;
                const f32x4 g0 = acc[ai][0][m][0], g1 = acc[ai][0][m][1], u0 = acc[ai][1][m][0], u1 = acc[ai][1][m][1];
                float r[8];
#pragma unroll
                for (int i = 0; i < 4; ++i) { r[i] = g0[i] * sigm(g0[i]) * u0[i]; r[4 + i] = g1[i] * sigm(g1[i]) * u1[i]; }
                u32x4 w; w.x = cvt_pk_bf16(r[0], r[1]); w.y = cvt_pk_bf16(r[2], r[3]); w.z = cvt_pk_bf16(r[4], r[5]); w.w = cvt_pk_bf16(r[6], r[7]);
                *(u32x4*)rowp = w; }
    }
};

struct EpiZ {
    static constexpr bool PERM = true, AFTER_DRAIN = false;
    bf16_t* Z; const float* bias; const float* rope;
    __device__ __forceinline__ void operator()(const f32x4 (&acc)[2][2][4][2], const Unit& u, int wr, int wc, int fr, int fq) const {
        const int pn = u.pn, row0 = u.pm * BM + wr * 64 + fr;
        bf16_t* base; int ldc, colt;
        if (pn < 24) { base = Z + (size_t)(pn >> 2) * ZPIECE; ldc = 1024; colt = (pn & 3) * 256; }
        else { const int q = pn - 24; base = Z + 6 * ZPIECE + (size_t)(q >> 3) * ((size_t)MP * 2048); ldc = 2048; colt = (q & 7) * 256; }
        const int mode = ((pn >= 8 && pn < 12) || pn >= 24) ? 1 : ((pn >= 12 && pn < 20) ? 2 : 0);
        const float qs = (pn >= 12 && pn < 16) ? QSCALE : 1.0f;
        const int col0 = colt + wc * 32 + 8 * fq, bcol0 = pn * BM + wc * 32 + 8 * fq;
        f32x4 bv[2][2];
#pragma unroll
        for (int bj = 0; bj < 2; ++bj)
#pragma unroll
            for (int n = 0; n < 2; ++n) bv[bj][n] = *(const f32x4*)(bias + bcol0 + bj * HALF + 4 * n);
        const bool rot = ((wc & 1) == 0) && (fq < 2);
        const float sgn = (fq == 0) ? -1.0f : 1.0f;
#pragma unroll
        for (int ai = 0; ai < 2; ++ai)
#pragma unroll
            for (int m = 0; m < 4; ++m) { const int row = row0 + ai * HALF + m * 16; bf16_t* rowp = base + (size_t)row * ldc + col0;
#pragma unroll
                for (int bj = 0; bj < 2; ++bj) { f32x4 v0 = acc[ai][bj][m][0] + bv[bj][0], v1 = acc[ai][bj][m][1] + bv[bj][1];
                    if (mode == 1) {
#pragma unroll
                        for (int i = 0; i < 4; ++i) { v0[i] = sigm(v0[i]); v1[i] = sigm(v1[i]); }
                    } else if (mode == 2) {
                        f32x4 p0, p1;
#pragma unroll
                        for (int i = 0; i < 4; ++i) { p0[i] = __shfl_xor(v0[i], 16); p1[i] = __shfl_xor(v1[i], 16); }
                        if (rot) { int pos = row - ROW_META0; pos = pos < 0 ? 0 : pos; const float* rp = rope + (size_t)pos * 16;
                            const f32x4 c0 = *(const f32x4*)(rp), c1 = *(const f32x4*)(rp + 4), s0 = *(const f32x4*)(rp + 8), s1 = *(const f32x4*)(rp + 12);
#pragma unroll
                            for (int i = 0; i < 4; ++i) { v0[i] = v0[i] * c0[i] + sgn * p0[i] * s0[i]; v1[i] = v1[i] * c1[i] + sgn * p1[i] * s1[i]; } }
                        v0 = v0 * qs; v1 = v1 * qs;
                    }
                    u32x4 w; w.x = cvt_pk_bf16(v0[0], v0[1]); w.y = cvt_pk_bf16(v0[2], v0[3]); w.z = cvt_pk_bf16(v1[0], v1[1]); w.w = cvt_pk_bf16(v1[2], v1[3]);
                    *(u32x4*)(rowp + bj * HALF) = w; } }
    }
};

struct EpiGate {
    static constexpr bool PERM = true, AFTER_DRAIN = false;
    const bf16_t* G; bf16_t* O; int ldc; int accum;
    __device__ __forceinline__ void operator()(const f32x4 (&acc)[2][2][4][2], const Unit& u, int wr, int wc, int fr, int fq) const {
        const int row0 = u.pm * BM + wr * 64 + fr, col0 = u.pn * BM + wc * 32 + 8 * fq;
#pragma unroll
        for (int ai = 0; ai < 2; ++ai)
#pragma unroll
            for (int m = 0; m < 4; ++m) { const size_t off = (size_t)(row0 + ai * HALF + m * 16) * ldc + col0;
#pragma unroll
                for (int bj = 0; bj < 2; ++bj) { const u32x4 gw = *(const u32x4*)(G + off + bj * HALF);
                    f32x4 v0 = acc[ai][bj][m][0], v1 = acc[ai][bj][m][1];
                    v0[0] *= bflo(gw.x); v0[1] *= bfhi(gw.x); v0[2] *= bflo(gw.y); v0[3] *= bfhi(gw.y);
                    v1[0] *= bflo(gw.z); v1[1] *= bfhi(gw.z); v1[2] *= bflo(gw.w); v1[3] *= bfhi(gw.w);
                    if (accum) { const u32x4 ow = *(const u32x4*)(O + off + bj * HALF);
                        v0[0] += bflo(ow.x); v0[1] += bfhi(ow.x); v0[2] += bflo(ow.y); v0[3] += bfhi(ow.y);
                        v1[0] += bflo(ow.z); v1[1] += bfhi(ow.z); v1[2] += bflo(ow.w); v1[3] += bfhi(ow.w); }
                    u32x4 w; w.x = cvt_pk_bf16(v0[0], v0[1]); w.y = cvt_pk_bf16(v0[2], v0[3]); w.z = cvt_pk_bf16(v1[0], v1[1]); w.w = cvt_pk_bf16(v1[2], v1[3]);
                    *(u32x4*)(O + off + bj * HALF) = w; } }
    }
};

template <class Epi, class Sched, bool ALIGN_EPI = false, bool SP2 = false>
__device__ __forceinline__ void gemm_phase(PG8_LAS unsigned char* lds, const Gemm g, const Sched& S, const Epi& E) {
    int tid_ = threadIdx.x; asm volatile("" : "+v"(tid_));
    const int tid = tid_, wid = __builtin_amdgcn_readfirstlane(tid >> 6), lane = tid & 63, wr = wid >> 2, wc = wid & 3, fr = lane & 15, fq = lane >> 4;
    const int K = g.K, nt = K / BK;
    unsigned voffA[2], voffB[2];
#pragma unroll
    for (int i = 0; i < 2; ++i) { int R, C; stage_rc(tid * 16 + i * 8192, R, C); const int Rb = Epi::PERM ? ((R & ~31) + perm32(R & 31)) : R;
        voffA[i] = (unsigned)(R * K + C) * 2u; voffB[i] = (unsigned)(Rb * K + C) * 2u; }
    const size_t kstep = (size_t)(BK * 2);
    const size_t hstep = (size_t)HALF * K * 2;
    const size_t tstep = 2 * hstep;
    const unsigned ldsw = (unsigned)wid * 1024u;
    const int aoff = lds_byte(wr * 64 + fr, fq * 8), boff = lds_byte(wc * 32 + fr, fq * 8);
#define PG8_SA(b, h) (((b) * 2 + (h)) * HTB)
#define PG8_SB(b, h) ((4 + (b) * 2 + (h)) * HTB)
#define PG8_STAGE(bufoff, gbase, voff) do { _Pragma("unroll") for (int _i = 0; _i < 2; ++_i) \
        __builtin_amdgcn_global_load_lds((const unsigned*)((const char*)(gbase) + (voff)[_i]), (PG8_LAS unsigned*)(lds + (bufoff) + ldsw + _i * 8192), 16, 0, 0); } while (0)
#define PG8_LDA(dst, b, h) do { _Pragma("unroll") for (int m = 0; m < 4; ++m) _Pragma("unroll") for (int k = 0; k < 2; ++k) dst[m][k] = *(const PG8_LAS bf16x8*)(lds + PG8_SA(b, h) + aoff + m * 2048 + k * 1024); } while (0)
#define PG8_LDB(dst, b, h) do { _Pragma("unroll") for (int n = 0; n < 2; ++n) _Pragma("unroll") for (int k = 0; k < 2; ++k) dst[n][k] = *(const PG8_LAS bf16x8*)(lds + PG8_SB(b, h) + boff + n * 2048 + k * 1024); } while (0)
#define PG8_MMA(ai, bj, At, Bt) do { __builtin_amdgcn_s_setprio(1); _Pragma("unroll") for (int m = 0; m < 4; ++m) _Pragma("unroll") for (int n = 0; n < 2; ++n) _Pragma("unroll") for (int k = 0; k < 2; ++k) \
        acc[ai][bj][m][n] = __builtin_amdgcn_mfma_f32_16x16x32_bf16(Bt[n][k], At[m][k], acc[ai][bj][m][n], 0, 0, 0); __builtin_amdgcn_s_setprio(0); } while (0)
#define PG8_WAIT_V(n) asm volatile("s_waitcnt vmcnt(" #n ")" ::: "memory")
#define PG8_WAIT_L(n) asm volatile("s_waitcnt lgkmcnt(" #n ")" ::: "memory")
#define PG8_BAR __builtin_amdgcn_s_barrier()
#define PG8_SCHED __builtin_amdgcn_sched_barrier(0)
    Unit cur, nxt; int ui = 0;
    if (!S.next(0, cur)) return;
    f32x4 acc[2][2][4][2];
#pragma unroll
    for (int a = 0; a < 2; ++a)
#pragma unroll
        for (int b = 0; b < 2; ++b)
#pragma unroll
            for (int m = 0; m < 4; ++m)
#pragma unroll
                for (int n = 0; n < 2; ++n) acc[a][b][m][n] = (f32x4){0.f, 0.f, 0.f, 0.f};
    bf16x8 At[4][2], B0[2][2], B1[2][2];
    const char* cA = (const char*)g.A + (size_t)cur.pm * tstep; const char* cB = (const char*)g.Bt + (size_t)cur.pn * tstep;
    S.a_ready(cur);
    if constexpr (SP2) {
        PG8_STAGE(PG8_SB(0, 0), cB, voffB); PG8_STAGE(PG8_SB(0, 1), cB + hstep, voffB); PG8_STAGE(PG8_SA(0, 0), cA, voffA); PG8_STAGE(PG8_SA(0, 1), cA + hstep, voffA);
        if (wr == 1) PG8_BAR;
        PG8_WAIT_V(2); PG8_BAR;
        PG8_STAGE(PG8_SB(1, 0), cB + kstep, voffB); PG8_STAGE(PG8_SA(1, 0), cA + kstep, voffA); PG8_STAGE(PG8_SB(1, 1), cB + hstep + kstep, voffB);
        PG8_WAIT_V(6); PG8_BAR;
    } else {
        PG8_STAGE(PG8_SB(0, 0), cB, voffB); PG8_STAGE(PG8_SA(0, 0), cA, voffA); PG8_STAGE(PG8_SB(0, 1), cB + hstep, voffB); PG8_STAGE(PG8_SA(0, 1), cA + hstep, voffA);
        if (wr == 1) PG8_BAR;
        PG8_WAIT_V(4); PG8_BAR;
        PG8_STAGE(PG8_SB(1, 0), cB + kstep, voffB); PG8_STAGE(PG8_SA(1, 0), cA + kstep, voffA); PG8_STAGE(PG8_SB(1, 1), cB + hstep + kstep, voffB);
        PG8_WAIT_V(6); PG8_BAR;
    }
    for (;;) {
        const bool has_next = S.next(ui + 1, nxt);
        const char* nA = has_next ? (const char*)g.A + (size_t)nxt.pm * tstep : cA; const char* nB = has_next ? (const char*)g.Bt + (size_t)nxt.pn * tstep : cB;
        for (int t = 0; t < nt; t += 2) {
            const bool last = (t == nt - 2);
            const char* a1 = cA + (size_t)(t + 1) * kstep;
            const char* a2 = last ? nA : cA + (size_t)(t + 2) * kstep; const char* b2 = last ? nB : cB + (size_t)(t + 2) * kstep;
            const char* a3 = a2 + kstep; const char* b3 = b2 + kstep;
            if (last && has_next) S.a_ready(nxt);
            if constexpr (SP2) {
            PG8_LDB(B0, 0, 0); PG8_LDB(B1, 0, 1); PG8_SCHED; PG8_LDA(At, 0, 0); PG8_STAGE(PG8_SA(1, 1), a1 + hstep, voffA);
            PG8_WAIT_V(8); PG8_WAIT_L(0); PG8_BAR; PG8_MMA(0, 0, At, B0); PG8_MMA(0, 1, At, B1); PG8_BAR; PG8_SCHED;
            PG8_LDA(At, 0, 1); PG8_STAGE(PG8_SB(0, 0), b2, voffB); PG8_STAGE(PG8_SB(0, 1), b2 + hstep, voffB); PG8_STAGE(PG8_SA(0, 0), a2, voffA);
            PG8_WAIT_V(8); PG8_WAIT_L(0); PG8_BAR; PG8_MMA(1, 0, At, B0); PG8_MMA(1, 1, At, B1); PG8_BAR; PG8_SCHED;
            PG8_LDB(B0, 1, 0); PG8_LDB(B1, 1, 1); PG8_SCHED; PG8_LDA(At, 1, 0); PG8_STAGE(PG8_SA(0, 1), a2 + hstep, voffA);
            PG8_WAIT_V(8); PG8_WAIT_L(0); PG8_BAR; PG8_MMA(0, 0, At, B0); PG8_MMA(0, 1, At, B1); PG8_BAR; PG8_SCHED;
            PG8_LDA(At, 1, 1); PG8_STAGE(PG8_SB(1, 0), b3, voffB); PG8_STAGE(PG8_SB(1, 1), b3 + hstep, voffB); PG8_STAGE(PG8_SA(1, 0), a3, voffA);
            PG8_WAIT_V(8); PG8_WAIT_L(0); PG8_BAR; PG8_MMA(1, 0, At, B0); PG8_MMA(1, 1, At, B1); PG8_BAR; PG8_SCHED;
            } else {
            PG8_LDB(B0, 0, 0); PG8_SCHED; PG8_LDA(At, 0, 0); PG8_STAGE(PG8_SA(1, 1), a1 + hstep, voffA);
            PG8_WAIT_L(8); PG8_BAR; PG8_WAIT_L(0); PG8_MMA(0, 0, At, B0); PG8_BAR; PG8_SCHED;
            PG8_LDB(B1, 0, 1); PG8_STAGE(PG8_SB(0, 0), b2, voffB);
            PG8_BAR; PG8_WAIT_L(0); PG8_MMA(0, 1, At, B1); PG8_BAR;
            PG8_LDA(At, 0, 1); PG8_STAGE(PG8_SA(0, 0), a2, voffA);
            PG8_BAR; PG8_WAIT_L(0); PG8_MMA(1, 0, At, B0); PG8_BAR; PG8_SCHED;
            PG8_STAGE(PG8_SB(0, 1), b2 + hstep, voffB);
            PG8_WAIT_V(6); PG8_BAR; PG8_MMA(1, 1, At, B1); PG8_BAR;
            PG8_LDB(B0, 1, 0); PG8_SCHED; PG8_LDA(At, 1, 0); PG8_STAGE(PG8_SA(0, 1), a2 + hstep, voffA);
            PG8_WAIT_L(8); PG8_BAR; PG8_WAIT_L(0); PG8_MMA(0, 0, At, B0); PG8_BAR; PG8_SCHED;
            PG8_LDB(B1, 1, 1); PG8_STAGE(PG8_SB(1, 0), b3, voffB);
            PG8_BAR; PG8_WAIT_L(0); PG8_MMA(0, 1, At, B1); PG8_BAR;
            PG8_LDA(At, 1, 1); PG8_STAGE(PG8_SA(1, 0), a3, voffA);
            PG8_BAR; PG8_WAIT_L(0); PG8_MMA(1, 0, At, B0); PG8_BAR; PG8_SCHED;
            PG8_STAGE(PG8_SB(1, 1), b3 + hstep, voffB);
            PG8_WAIT_V(6); PG8_BAR; PG8_MMA(1, 1, At, B1); PG8_BAR;
            }
        }
        if constexpr (ALIGN_EPI) { if (wr == 0) PG8_BAR; }
        if constexpr (!Epi::AFTER_DRAIN) { E(acc, cur, wr, wc, fr, fq); S.done(cur); }
        if (!has_next) break;
#pragma unroll
        for (int a = 0; a < 2; ++a)
#pragma unroll
            for (int b = 0; b < 2; ++b)
#pragma unroll
                for (int m = 0; m < 4; ++m)
#pragma unroll
                    for (int n = 0; n < 2; ++n) acc[a][b][m][n] = (f32x4){0.f, 0.f, 0.f, 0.f};
        cur = nxt; cA = nA; cB = nB; ++ui;
        if constexpr (ALIGN_EPI) { if (wr == 1) PG8_BAR; }
    }
    PG8_WAIT_V(0);
    if constexpr (!ALIGN_EPI) { if (wr == 0) PG8_BAR; }
    PG8_BAR;
    if constexpr (Epi::AFTER_DRAIN) { E.fused(acc, cur, wr, wc, fr, fq, lds, wid, lane); S.done(cur); }
#undef PG8_SA
#undef PG8_SB
#undef PG8_STAGE
#undef PG8_LDA
#undef PG8_LDB
#undef PG8_MMA
#undef PG8_WAIT_V
#undef PG8_WAIT_L
#undef PG8_BAR
#undef PG8_SCHED
}
}
#define GAS __attribute__((address_space(1)))
#define LAS __attribute__((address_space(3)))
typedef unsigned short bf16;
typedef unsigned v4u __attribute__((ext_vector_type(4)));
typedef float f32x4 __attribute__((ext_vector_type(4)));
typedef short bf16x8 __attribute__((ext_vector_type(8)));
typedef GAS unsigned gu32;
typedef GAS unsigned long long gu64;
#define RLX_AGENT __ATOMIC_RELAXED, __HIP_MEMORY_SCOPE_AGENT
#define LDS_WAIT() asm volatile("s_waitcnt lgkmcnt(0)" ::: "memory")
#define VM_WAIT() asm volatile("s_waitcnt vmcnt(0)" ::: "memory")
__device__ __forceinline__ unsigned long long rt() { return __builtin_amdgcn_s_memrealtime(); }
__device__ __forceinline__ unsigned f2bf(float f) { unsigned u = __builtin_bit_cast(unsigned, f); return (u + 0x7fffu + ((u >> 16) & 1u)) >> 16; }
__device__ __forceinline__ unsigned pk2(float lo, float hi) { return f2bf(lo) | (f2bf(hi) << 16); }

#define XB_TMO      128
#define XB_XCNT(j)  (256  + 64 * (j))
#define XB_XSUB(j)  (1280 + 64 * (j))
#define XB_XGEN(j)  (2304 + 64 * (j))
#define XB_TOP      3328
#define XB_TOPGEN   3392
#define XCD_BAR_WORDS 3456
#define XB_SPIN_CAP (1u << 18)

__device__ __forceinline__ unsigned xb_ld(unsigned* p)              { return __hip_atomic_load(p, __ATOMIC_RELAXED, __HIP_MEMORY_SCOPE_AGENT); }
__device__ __forceinline__ unsigned xb_add(unsigned* p, unsigned v) { return __hip_atomic_fetch_add(p, v, __ATOMIC_RELAXED, __HIP_MEMORY_SCOPE_AGENT); }
__device__ __forceinline__ unsigned xb_xcc_id() { return (unsigned)__builtin_amdgcn_s_getreg((3 << 11) | 20) & 0xFu; }
#define XB_SPIN(cond, bar) do { unsigned _sp = 0; while (cond) { __builtin_amdgcn_s_sleep(1); \
    if ((++_sp & 255u) == 0u) { if (xb_ld(&(bar)[XB_TMO])) break; if (_sp > XB_SPIN_CAP) { atomicAdd(&(bar)[XB_TMO], 1u); break; } } } } while (0)

struct XcdBarrier {
    unsigned* bar; unsigned x;
    volatile LAS unsigned* st;
};

__device__ __forceinline__ XcdBarrier xcd_barrier_post(unsigned* bar, volatile LAS unsigned* st) {
    XcdBarrier b; b.bar = bar; b.x = xb_xcc_id(); b.st = st;
    if (threadIdx.x == 0) (void)xb_add(&bar[XB_XCNT(b.x)], 1u);
    return b;
}
__device__ __forceinline__ void xcd_barrier_complete(unsigned* bar, unsigned x, unsigned& nloc, unsigned& nx) {
    const unsigned G = gridDim.x * gridDim.y * gridDim.z;
    unsigned sum, cnt, mine, sp = 0u;
    for (;;) {
        sum = 0u; cnt = 0u; mine = 0u;
#pragma unroll
        for (unsigned j = 0; j < 16; ++j) { const unsigned c = xb_ld(&bar[XB_XCNT(j)]); sum += c; cnt += (c > 0u) ? 1u : 0u; mine = (j == x) ? c : mine; }
        if (sum == G) break;
        __builtin_amdgcn_s_sleep(1);
        if ((++sp & 255u) == 0u) { if (xb_ld(&bar[XB_TMO])) break; if (sp > XB_SPIN_CAP) { atomicAdd(&bar[XB_TMO], 1u); break; } }
    }
    nloc = mine > 0u ? mine : 1u; nx = cnt > 0u ? cnt : 1u;
}

__device__ __forceinline__ void xcd_barrier(const XcdBarrier& b) {
    asm volatile("s_waitcnt vmcnt(0)" ::: "memory");
    __syncthreads();
    if (threadIdx.x == 0) {
        unsigned* bar = b.bar;
        __builtin_amdgcn_s_waitcnt(0);
        unsigned nloc = b.st[0], nx = b.st[1];
        if (nloc == 0u) { xcd_barrier_complete(bar, b.x, nloc, nx); b.st[0] = nloc; b.st[1] = nx; }
        const unsigned old = xb_add(&bar[XB_XSUB(b.x)], 1u);
        const unsigned gen = old / nloc;
        if (old + 1u == (gen + 1u) * nloc) {
            __builtin_amdgcn_fence(__ATOMIC_RELEASE, "agent");
            asm volatile("s_waitcnt vmcnt(0)" ::: "memory");
            const unsigned og = xb_add(&bar[XB_TOP], 1u);
            const unsigned tg = og / nx;
            if (og + 1u == (tg + 1u) * nx) xb_add(&bar[XB_TOPGEN], 1u);
            else XB_SPIN(xb_ld(&bar[XB_TOPGEN]) == tg, bar);
            __builtin_amdgcn_fence(__ATOMIC_ACQUIRE, "agent");
            xb_add(&bar[XB_XGEN(b.x)], 1u);
            asm volatile("s_waitcnt vmcnt(0)" ::: "memory");
        } else {
            XB_SPIN(xb_ld(&bar[XB_XGEN(b.x)]) == gen, bar);
            __builtin_amdgcn_fence(__ATOMIC_ACQUIRE, "agent");
            asm volatile("s_waitcnt vmcnt(0)" ::: "memory");
        }
    }
    __syncthreads();
}
constexpr int NWAVES = 8, NTHREADS = 512;
constexpr int RING_BYTES = 131072, LDSCTL_OFF = RING_BYTES, MISC_OFF = LDSCTL_OFF + 320, LDS_BYTES = 147456;
typedef unsigned v2u __attribute__((ext_vector_type(2)));

#ifndef PH_MASK
#define PH_MASK 0xffff
#endif
struct Args { const float* in[27]; float* out; unsigned char* ws; };
enum { I_X = 0, I_META, I_F1PRE, I_F1POST, I_F1G, I_F1U, I_F1D, I_MIXPRE, I_MIXPOST, I_WIN, I_BIN, I_CONVW, I_CONVB, I_MNORM, I_MWB, I_LQ1, I_LK1, I_LQ2, I_LK2, I_ANORM, I_AWB, I_WOUT, I_F2PRE, I_F2POST, I_F2G, I_F2U, I_F2D };

__device__ __forceinline__ float wave_sum(float v) {
#pragma unroll
    for (int o = 1; o < 64; o <<= 1) v += __shfl_xor(v, o);
    return v;
}
__device__ __forceinline__ float bf2f(bf16 b) { return __uint_as_float(((unsigned)b) << 16); }

__device__ __forceinline__ void tr_item(const float* W, int ldw, int src_col0, int k0, bf16* WT, int K, int dst_row0, const float* sk, float scal, LAS float* scr, int lane) {
#pragma unroll 8
    for (int i = 0; i < 32; ++i) { const int kk = 2 * i + (lane >> 5);
        const float w = W[(size_t)(k0 + kk) * ldw + src_col0 + (lane & 31)];
        const float s = sk ? sk[k0 + kk] * scal : scal;
        scr[kk * 33 + (lane & 31)] = w * s; }
    LDS_WAIT(); asm volatile("" ::: "memory");
    const int c = lane & 7;
#pragma unroll
    for (int j = 0; j < 4; ++j) { const int n = (lane >> 3) + 8 * j; const LAS float* s = scr + (8 * c) * 33 + n;
        v4u o; o.x = pk2(s[0 * 33], s[1 * 33]); o.y = pk2(s[2 * 33], s[3 * 33]); o.z = pk2(s[4 * 33], s[5 * 33]); o.w = pk2(s[6 * 33], s[7 * 33]);
        *(GAS v4u*)(WT + (size_t)(dst_row0 + n) * K + k0 + 8 * c) = o; }
    LDS_WAIT(); asm volatile("" ::: "memory");
}

__device__ __forceinline__ void convert_ffn(const float* wg, const float* wu, const float* wd, const float* preg, bf16* WUP, bf16* WDN, LAS float* scr, int gw, int NGW, int lane) {
    constexpr int N_UP = (DM / 64) * (NUP / 32), N_DN = (DFF / 64) * (DM / 32);
    for (int it = gw; it < N_UP + N_DN; it += NGW) {
        if (it < N_UP) { const int nblk = NUP / 32, kb = it / nblk, nb = it % nblk, row0 = 32 * nb, pn = row0 >> 8, j = row0 & 255;
            const float* src = (j < 128) ? wg : wu; const int col0 = 128 * pn + (j & 127);
            tr_item(src, DFF, col0, 64 * kb, WUP, DM, row0, preg, 1.0f, scr, lane); }
        else { const int r = it - N_UP, nblk = DM / 32, kb = r / nblk, nb = r % nblk;
            tr_item(wd, DM, 32 * nb, 64 * kb, WDN, DFF, 32 * nb, nullptr, 1.0f, scr, lane); }
    }
}

__device__ __forceinline__ void sincos_small(double r, double& s, double& c) {
    const double r2 = r * r; double ts = 1.0, tc = 1.0;
#pragma unroll
    for (int k = 13; k >= 1; --k) { ts = 1.0 - ts * r2 / (double)((2 * k) * (2 * k + 1)); tc = 1.0 - tc * r2 / (double)((2 * k - 1) * (2 * k)); }
    s = r * ts; c = tc;
}

__device__ __forceinline__ void load_row(const float* p, int lane, f32x4 (&v)[8]) {
    const GAS f32x4* r = (const GAS f32x4*)p + lane;
#pragma unroll
    for (int j = 0; j < 8; ++j) v[j] = r[64 * j];
}
__device__ __forceinline__ float row_ssq(const f32x4 (&v)[8]) {
    float s = 0.f;
#pragma unroll
    for (int j = 0; j < 8; ++j) s += (v[j].x * v[j].x + v[j].y * v[j].y) + (v[j].z * v[j].z + v[j].w * v[j].w);
    return wave_sum(s);
}
__device__ __forceinline__ void store_row_bf16(bf16* p, int lane, const f32x4 (&v)[8], float sc) {
    GAS v2u* o = (GAS v2u*)p + lane;
#pragma unroll
    for (int j = 0; j < 8; ++j) { v2u w; w.x = pk2(v[j].x * sc, v[j].y * sc); w.y = pk2(v[j].z * sc, v[j].w * sc); o[64 * j] = w; }
}

__device__ __forceinline__ float log_sigmoid(float x) { return fminf(x, 0.f) - log1pf(__expf(-fabsf(x))); }

namespace fa {
typedef float f32x16 __attribute__((ext_vector_type(16)));
typedef short s16x4 __attribute__((ext_vector_type(4)));
typedef short v4i16_t __attribute__((ext_vector_type(4)));
constexpr int NSLOT = 4, KSLOT = 8192, VSLOT = 16384;
constexpr int L_K = 0, L_V = NSLOT * KSLOT, L_WS = L_V + NSLOT * VSLOT, L_END = L_WS + 8 * 256;
constexpr float THR = 8.0f;
__device__ __forceinline__ int crow(int r, int hi) { return (r & 3) + 8 * (r >> 2) + 4 * hi; }
__device__ __forceinline__ s16x4 vtr(const LAS unsigned char* p) { return __builtin_bit_cast(s16x4, __builtin_amdgcn_ds_read_tr16_b64_v4i16((LAS v4i16_t*)p)); }
__device__ __forceinline__ unsigned cvtpk(float lo, float hi) { typedef float f2 __attribute__((ext_vector_type(2))); typedef __bf16 b2 __attribute__((ext_vector_type(2))); f2 v = {lo, hi}; b2 b = __builtin_convertvector(v, b2); return __builtin_bit_cast(unsigned, b); }
#define FA_MX3(a, b, c) __builtin_fmaxf(__builtin_fmaxf((a), (b)), (c))
#define FA_BAR() asm volatile("s_barrier" ::: "memory")

__device__ __forceinline__ void attn_unit(LAS unsigned char* lds, int sh, int qb, const bf16* AQ, const bf16* AK, const bf16* AV, bf16* OS) {
    int tid_ = threadIdx.x; asm volatile("" : "+v"(tid_));
    const int tid = tid_, lane = tid & 63, r32 = lane & 31, hi = lane >> 5, wid = __builtin_amdgcn_readfirstlane(tid >> 6);
    const int hh = sh >> 1, NT = 4 * qb + 5;
    const int rb = 2 * (wid & 3) + (wid >> 2);
    const int cqw = 4 * qb + 1 + (rb >> 1);
    const int qrow0 = ROW_X0 + 256 * qb + 32 * rb;
    bf16x8 qr[4];
    { const bf16* Qw = AQ + (size_t)(qrow0 + r32) * 1024 + sh * 64 + hi * 8;
#pragma unroll
      for (int d0 = 0; d0 < 4; ++d0) qr[d0] = *(const bf16x8*)(Qw + d0 * 16); }
    const bf16* ksrc = AK + (size_t)(ROW_PAD0 + lane) * 1024 + sh * 64 + wid * 8;
    const bf16* vsrc = AV + (size_t)(ROW_PAD0 + 32 * (wid & 1) + (lane >> 2)) * 1024 + hh * 128 + (wid >> 1) * 32 + (lane & 3) * 8;
    LAS float* wsf = (LAS float*)(lds + L_WS) + wid * 64;
    const LAS unsigned char* kbase = lds + L_K + hi * 1024 + r32 * 16;
    const LAS unsigned char* vbase = lds + L_V + ((lane >> 4) & 1) * 32 + (lane & 3) * 8 + (4 * hi + ((lane & 15) >> 2)) * 64;
#define FA_DMA(t) do { const size_t go_ = (size_t)(t) * 65536; const int sl_ = (t) & (NSLOT - 1); \
        __builtin_amdgcn_global_load_lds((const unsigned*)(ksrc + go_), (LAS unsigned*)(lds + L_K + sl_ * KSLOT + wid * 1024), 16, 0, 0); \
        __builtin_amdgcn_global_load_lds((const unsigned*)(vsrc + go_), (LAS unsigned*)(lds + L_V + sl_ * VSLOT + wid * 2048), 16, 0, 0); \
        __builtin_amdgcn_global_load_lds((const unsigned*)(vsrc + go_ + 16 * 1024), (LAS unsigned*)(lds + L_V + sl_ * VSLOT + wid * 2048 + 1024), 16, 0, 0); } while (0)
    f32x16 o[4];
#pragma unroll
    for (int d0 = 0; d0 < 4; ++d0)
#pragma unroll
        for (int r = 0; r < 16; ++r) o[d0][r] = 0.f;
    f32x16 negm;
#pragma unroll
    for (int r = 0; r < 16; ++r) negm[r] = 0.f;
    float m = 0.f, l = 0.f;
    asm volatile("s_waitcnt vmcnt(0)" ::: "memory");
    FA_DMA(0); FA_DMA(1);
    asm volatile("s_waitcnt vmcnt(3)" ::: "memory");
    if (wid >= 4) FA_BAR();
    FA_BAR();
    for (int t = 0; t < NT; ++t) {
        const int sl = t & (NSLOT - 1);
        if (t + 2 < NT) FA_DMA(t + 2);
        v4u pw[4];
        if (t <= cqw) {
            const LAS unsigned char* kp = kbase + sl * KSLOT;
            f32x16 p0, p1;
            { const bf16x8 k0 = *(const LAS bf16x8*)(kp), k1 = *(const LAS bf16x8*)(kp + 512);
              p0 = __builtin_amdgcn_mfma_f32_32x32x16_bf16(k0, qr[0], negm, 0, 0, 0);
              p1 = __builtin_amdgcn_mfma_f32_32x32x16_bf16(k1, qr[0], negm, 0, 0, 0); }
#pragma unroll
            for (int d0 = 1; d0 < 4; ++d0) {
                const bf16x8 k0 = *(const LAS bf16x8*)(kp + d0 * 2048), k1 = *(const LAS bf16x8*)(kp + d0 * 2048 + 512);
                p0 = __builtin_amdgcn_mfma_f32_32x32x16_bf16(k0, qr[d0], p0, 0, 0, 0);
                p1 = __builtin_amdgcn_mfma_f32_32x32x16_bf16(k1, qr[d0], p1, 0, 0, 0); }
            if (t == 0) {
#pragma unroll
                for (int r = 0; r < 16; ++r) p0[r] = -INFINITY;
#pragma unroll
                for (int r = 0; r < 8; ++r) p1[r] = -INFINITY;
                float rm = FA_MX3(p1[8], p1[9], p1[10]); rm = FA_MX3(rm, p1[11], p1[12]); rm = FA_MX3(rm, p1[13], p1[14]); rm = __builtin_fmaxf(rm, p1[15]);
                { auto rr = __builtin_amdgcn_permlane32_swap(__float_as_uint(rm), __float_as_uint(rm), false, false); rm = __builtin_fmaxf(__uint_as_float(rr[0]), __uint_as_float(rr[1])); }
                m = rm;
#pragma unroll
                for (int r = 8; r < 16; ++r) p1[r] -= rm;
#pragma unroll
                for (int r = 0; r < 16; ++r) negm[r] = -m;
            } else {
                float a = FA_MX3(p0[0], p0[1], p1[0]), b = FA_MX3(p0[2], p0[3], p1[1]); a = FA_MX3(a, p1[2], p1[3]);
#pragma unroll
                for (int r = 4; r < 16; r += 4) { a = FA_MX3(a, p0[r], p0[r + 1]); b = FA_MX3(b, p0[r + 2], p0[r + 3]); a = FA_MX3(a, p1[r], p1[r + 1]); b = FA_MX3(b, p1[r + 2], p1[r + 3]); }
                float rm = __builtin_fmaxf(a, b);
                { auto rr = __builtin_amdgcn_permlane32_swap(__float_as_uint(rm), __float_as_uint(rm), false, false); rm = __builtin_fmaxf(__uint_as_float(rr[0]), __uint_as_float(rr[1])); }
                if (__builtin_expect(__any(rm > THR), 0)) {
                    const float dl = __builtin_fmaxf(rm, 0.f); m += dl;
#pragma unroll
                    for (int r = 0; r < 16; ++r) { p0[r] -= dl; p1[r] -= dl; negm[r] = -m; }
                    const float f = __builtin_amdgcn_exp2f(-dl); l *= f;
                    if (hi == 0) wsf[r32] = f;
#pragma unroll
                    for (int r = 0; r < 16; ++r) { const float a2 = wsf[crow(r, hi)];
#pragma unroll
                        for (int d0 = 0; d0 < 4; ++d0) o[d0][r] *= a2; }
                }
            }
            float ls0 = 0.f, ls1 = 0.f;
#pragma unroll
            for (int r = 0; r < 16; ++r) { p0[r] = __builtin_amdgcn_exp2f(p0[r]); p1[r] = __builtin_amdgcn_exp2f(p1[r]); ls0 += p0[r]; ls1 += p1[r]; }
            l += ls0 + ls1;
#pragma unroll
            for (int i = 0; i < 4; ++i) { pw[0][i] = cvtpk(p0[2 * i], p0[2 * i + 1]); pw[1][i] = cvtpk(p0[8 + 2 * i], p0[8 + 2 * i + 1]); pw[2][i] = cvtpk(p1[2 * i], p1[2 * i + 1]); pw[3][i] = cvtpk(p1[8 + 2 * i], p1[8 + 2 * i + 1]); }
        }
        if (t + 2 < NT) asm volatile("s_waitcnt vmcnt(3) lgkmcnt(0)" ::: "memory"); else asm volatile("s_waitcnt vmcnt(0) lgkmcnt(0)" ::: "memory");
        FA_BAR();
        if (t <= cqw) {
            const LAS unsigned char* vp = vbase + sl * VSLOT;
#pragma unroll
            for (int d0 = 0; d0 < 4; ++d0)
#pragma unroll
                for (int ks = 0; ks < 4; ++ks) {
                    const s16x4 lo = vtr(vp + d0 * 4096 + ks * 1024), hi4 = vtr(vp + d0 * 4096 + ks * 1024 + 512);
                    const bf16x8 vf = (bf16x8){lo[0], lo[1], lo[2], lo[3], hi4[0], hi4[1], hi4[2], hi4[3]};
                    o[d0] = __builtin_amdgcn_mfma_f32_32x32x16_bf16(__builtin_bit_cast(bf16x8, pw[ks]), vf, o[d0], 0, 0, 0); }
        }
        asm volatile("s_waitcnt lgkmcnt(0)" ::: "memory");
        FA_BAR();
    }
    if (wid < 4) FA_BAR();
    { auto rr = __builtin_amdgcn_permlane32_swap(__float_as_uint(l), __float_as_uint(l), false, false); l = __uint_as_float(rr[0]) + __uint_as_float(rr[1]); }
    if (hi == 0) wsf[32 + r32] = l;
    bf16* Ow = OS + (size_t)qrow0 * 2048 + sh * 128 + r32;
#pragma unroll
    for (int r = 0; r < 16; ++r) { const float rl = __builtin_amdgcn_rcpf(wsf[32 + crow(r, hi)]); bf16* op = Ow + (size_t)crow(r, hi) * 2048;
#pragma unroll
        for (int d0 = 0; d0 < 4; ++d0) op[d0 * 32] = (bf16)f2bf(o[d0][r] * rl); }
    asm volatile("s_waitcnt lgkmcnt(0)" ::: "memory");
    FA_BAR();
#undef FA_DMA
}
}
namespace ml {
typedef float f32x16 __attribute__((ext_vector_type(16)));
typedef short s16x4 __attribute__((ext_vector_type(4)));
constexpr int L_QI = 0, L_KI = 16384, L_VI = 32768, L_SM = 69632, HL_LD = 260;
constexpr int S_WJ = 0, S_US = 64, S_TS = 128, S_WINT = 192, S_EMR = 256, S_RS = 320, S_DINV = 384, S_QN = 448;
__device__ __forceinline__ float wave_scan_add(float v, int lane) {
#pragma unroll
    for (int o = 1; o < 64; o <<= 1) { const float t = __shfl_up(v, o); if (lane >= o) v += t; }
    return v;
}
__device__ __forceinline__ float wave_scan_max(float v, int lane) {
#pragma unroll
    for (int o = 1; o < 64; o <<= 1) { const float t = __shfl_up(v, o); if (lane >= o) v = fmaxf(v, t); }
    return v;
}
__device__ __forceinline__ float wave_max(float v) {
#pragma unroll
    for (int o = 1; o < 64; o <<= 1) v = fmaxf(v, __shfl_xor(v, o));
    return v;
}
__device__ __forceinline__ void conv16(const bf16* QK, const float* cw, const float* cb, int R, int cc0, float (&out)[16]) {
    float a[16];
#pragma unroll
    for (int q = 0; q < 4; ++q) { const f32x4 b = *(const f32x4*)(cb + cc0 + 4 * q); a[4 * q] = b.x; a[4 * q + 1] = b.y; a[4 * q + 2] = b.z; a[4 * q + 3] = b.w; }
#pragma unroll
    for (int jj = 0; jj < 4; ++jj) { const int Rr = R - 3 + jj;
        if (Rr >= ROW_META0) { const v4u x0 = *(const v4u*)(QK + (size_t)Rr * 1024 + cc0), x1 = *(const v4u*)(QK + (size_t)Rr * 1024 + cc0 + 8);
            const unsigned xw[8] = {x0.x, x0.y, x0.z, x0.w, x1.x, x1.y, x1.z, x1.w};
#pragma unroll
            for (int q = 0; q < 4; ++q) { const f32x4 w = *(const f32x4*)(cw + jj * 1024 + cc0 + 4 * q);
                a[4 * q] += w.x * pg8::bflo(xw[2 * q]); a[4 * q + 1] += w.y * pg8::bfhi(xw[2 * q]); a[4 * q + 2] += w.z * pg8::bflo(xw[2 * q + 1]); a[4 * q + 3] += w.w * pg8::bfhi(xw[2 * q + 1]); } } }
#pragma unroll
    for (int i = 0; i < 16; ++i) out[i] = a[i] * pg8::sigm(a[i]);
}
__device__ __forceinline__ s16x4 vtr(const LAS unsigned char* p) { return __builtin_bit_cast(s16x4, __builtin_amdgcn_ds_read_tr16_b64_v4i16((LAS fa::v4i16_t*)p)); }
#define ML_FRAG(base, off) ({ const s16x4 lo_ = ml::vtr((base) + (off)), hi_ = ml::vtr((base) + (off) + 512); (bf16x8){lo_[0], lo_[1], lo_[2], lo_[3], hi_[0], hi_[1], hi_[2], hi_[3]}; })

__device__ __forceinline__ void v_dma(LAS unsigned char* lds, const bf16* MV, int R0, int h, int wid, int lane) {
#pragma unroll
    for (int i = 0; i < 4; ++i)
        __builtin_amdgcn_global_load_lds((const unsigned*)(MV + (size_t)(R0 + 16 * i + (lane >> 2)) * 1024 + h * 256 + wid * 32 + (lane & 3) * 8), (LAS unsigned*)(lds + L_VI + (4 * wid + i) * 1024), 16, 0, 0);
}

__device__ __forceinline__ void stepA(LAS unsigned char* lds, int c, int h, const bf16* QK, const bf16* MV, const float* GATES, const float* cw, const float* cb, float* DCT, float* DN, float* MSC) {
    int tid_ = threadIdx.x; asm volatile("" : "+v"(tid_));
    const int tid = tid_, lane = tid & 63, r32 = lane & 31, hi = lane >> 5, wid = __builtin_amdgcn_readfirstlane(tid >> 6);
    const int R0 = ROW_PAD0 + 64 * c; LAS float* sm = (LAS float*)(lds + L_SM);
    if (wid == 0) { const int R = R0 + lane; const float li = GATES[(size_t)R * 8 + h], lf = GATES[(size_t)R * 8 + 4 + h];
        const float b = wave_scan_add(lf, lane), g = __shfl(b, 63), a = g - b + li, mloc = wave_max(a);
        sm[S_WJ + lane] = __expf(a - mloc);
        if (lane == 0) { MSC[(c * 4 + h) * 4 + 0] = g; MSC[(c * 4 + h) * 4 + 1] = mloc; } }
    v_dma(lds, MV, R0, h, wid, lane);
    __syncthreads();
    { const int j = tid >> 3, part = tid & 7, R = R0 + j; float kv[16];
      if (R >= ROW_META0) { conv16(QK, cw, cb, R, 512 + h * 128 + part * 16, kv); const float s = 0.08838834764831845f * sm[S_WJ + j];
#pragma unroll
          for (int i = 0; i < 16; ++i) kv[i] *= s; }
      else {
#pragma unroll
          for (int i = 0; i < 16; ++i) kv[i] = 0.f; }
      v4u w0, w1; w0.x = pk2(kv[0], kv[1]); w0.y = pk2(kv[2], kv[3]); w0.z = pk2(kv[4], kv[5]); w0.w = pk2(kv[6], kv[7]); w1.x = pk2(kv[8], kv[9]); w1.y = pk2(kv[10], kv[11]); w1.z = pk2(kv[12], kv[13]); w1.w = pk2(kv[14], kv[15]);
      LAS unsigned char* kp = lds + L_KI + (part >> 1) * 4096 + j * 64 + (part & 1) * 32;
      *(LAS v4u*)kp = w0; *(LAS v4u*)(kp + 16) = w1; }
    asm volatile("s_waitcnt vmcnt(0) lgkmcnt(0)" ::: "memory");
    __syncthreads();
    { const LAS unsigned char* tb = lds + ((lane >> 4) & 1) * 32 + (lane & 3) * 8 + (4 * hi + ((lane & 15) >> 2)) * 64;
      bf16x8 af[4];
#pragma unroll
      for (int s = 0; s < 4; ++s) af[s] = ML_FRAG(tb + L_VI + wid * 4096, s * 1024);
      float* outp = DCT + ((size_t)(c * 4 + h) * 256 + wid * 32) * 128 + r32;
#pragma unroll
      for (int db = 0; db < 4; ++db) { f32x16 acc;
#pragma unroll
          for (int r = 0; r < 16; ++r) acc[r] = 0.f;
#pragma unroll
          for (int s = 0; s < 4; ++s) { const bf16x8 bfr = ML_FRAG(tb + L_KI + db * 4096, s * 1024); acc = __builtin_amdgcn_mfma_f32_32x32x16_bf16(af[s], bfr, acc, 0, 0, 0); }
#pragma unroll
          for (int r = 0; r < 16; ++r) outp[(size_t)fa::crow(r, hi) * 128 + db * 32] = acc[r]; } }
    if (tid < 128) { const int d = tid; const LAS unsigned char* kp = lds + L_KI + (d >> 5) * 4096 + (d & 31) * 2; float s = 0.f;
#pragma unroll 8
        for (int j = 0; j < 64; ++j) s += bf2f(*(const LAS bf16*)(kp + j * 64));
        DN[(size_t)(c * 4 + h) * 128 + d] = s; }
    __syncthreads();
}

__device__ __forceinline__ void stepB(int gtid, int ngt, const float* DCT, const float* DN, float* MSC, bf16* CT, float* NPREV) {
    for (int idx = gtid; idx < 4 * 32768; idx += ngt) { const int h = idx >> 15, ed = idx & 32767; const bool isn = ed < 128;
        float C = 0.f, n = 0.f, m = 0.f;
        for (int c0 = 0; c0 < 128; c0 += 8) { float dc[8], dn[8], gg[8], ml_[8];
#pragma unroll
            for (int u = 0; u < 8; ++u) { const int c = c0 + u; dc[u] = DCT[(size_t)(c * 4 + h) * 32768 + ed]; dn[u] = isn ? DN[(size_t)(c * 4 + h) * 128 + ed] : 0.f; gg[u] = MSC[(c * 4 + h) * 4]; ml_[u] = MSC[(c * 4 + h) * 4 + 1]; }
#pragma unroll
            for (int u = 0; u < 8; ++u) { const int c = c0 + u; const float mn = fmaxf(gg[u] + m, ml_[u]), dec = __expf(gg[u] + m - mn), sc = __expf(ml_[u] - mn);
                C = dec * C + sc * dc[u]; n = dec * n + sc * dn[u]; m = mn;
                CT[(size_t)((c + 1) * 4 + h) * 32768 + ed] = (bf16)f2bf(C);
                if (isn) NPREV[(size_t)((c + 1) * 4 + h) * 128 + ed] = n;
                if (ed == 0) MSC[((c + 1) * 4 + h) * 4 + 2] = m; } }
    }
}

__device__ __forceinline__ void stepC(LAS unsigned char* lds, int c, int h, const bf16* QK, const bf16* MV, const bf16* MO, const float* GATES, const float* cw, const float* cb, const bf16* CT, const float* NPREV, const float* MSC, bf16* HMG) {
    int tid_ = threadIdx.x; asm volatile("" : "+v"(tid_));
    const int tid = tid_, lane = tid & 63, r32 = lane & 31, hi = lane >> 5, wid = __builtin_amdgcn_readfirstlane(tid >> 6);
    const int R0 = ROW_PAD0 + 64 * c; LAS float* sm = (LAS float*)(lds + L_SM);
    if (wid == 0) { const int R = R0 + lane; const float li = GATES[(size_t)R * 8 + h], lf = GATES[(size_t)R * 8 + 4 + h], mprev = MSC[(c * 4 + h) * 4 + 2];
        const float b = wave_scan_add(lf, lane), u = li - b, pm = wave_scan_max(u, lane), mrow = b + fmaxf(mprev, pm);
        sm[S_US + lane] = u; sm[S_TS + lane] = b - mrow; sm[S_WINT + lane] = __expf(b + mprev - mrow); sm[S_EMR + lane] = __expf(-mrow); }
    v_dma(lds, MV, R0, h, wid, lane);
    { const int j = tid >> 3, part = tid & 7, R = R0 + j; float qv[16], kv[16];
      conv16(QK, cw, cb, R, h * 128 + part * 16, qv); conv16(QK, cw, cb, R, 512 + h * 128 + part * 16, kv);
      const float* np = NPREV + (size_t)(c * 4 + h) * 128 + part * 16; float qn = 0.f;
#pragma unroll
      for (int q = 0; q < 4; ++q) { const f32x4 nv = *(const f32x4*)(np + 4 * q); qn += (qv[4 * q] * nv.x + qv[4 * q + 1] * nv.y) + (qv[4 * q + 2] * nv.z + qv[4 * q + 3] * nv.w); }
      sm[S_QN + part * 64 + j] = qn;
#pragma unroll
      for (int i = 0; i < 16; ++i) kv[i] *= 0.08838834764831845f;
      v4u w0, w1; w0.x = pk2(qv[0], qv[1]); w0.y = pk2(qv[2], qv[3]); w0.z = pk2(qv[4], qv[5]); w0.w = pk2(qv[6], qv[7]); w1.x = pk2(qv[8], qv[9]); w1.y = pk2(qv[10], qv[11]); w1.z = pk2(qv[12], qv[13]); w1.w = pk2(qv[14], qv[15]);
      *(LAS v4u*)(lds + L_QI + (2 * part) * 1024 + j * 16) = w0; *(LAS v4u*)(lds + L_QI + (2 * part + 1) * 1024 + j * 16) = w1;
      w0.x = pk2(kv[0], kv[1]); w0.y = pk2(kv[2], kv[3]); w0.z = pk2(kv[4], kv[5]); w0.w = pk2(kv[6], kv[7]); w1.x = pk2(kv[8], kv[9]); w1.y = pk2(kv[10], kv[11]); w1.z = pk2(kv[12], kv[13]); w1.w = pk2(kv[14], kv[15]);
      *(LAS v4u*)(lds + L_KI + (2 * part) * 1024 + j * 16) = w0; *(LAS v4u*)(lds + L_KI + (2 * part + 1) * 1024 + j * 16) = w1; }
    asm volatile("s_waitcnt vmcnt(0) lgkmcnt(0)" ::: "memory");
    __syncthreads();
    const int ib = wid & 1, ep = wid >> 1;
    f32x16 acc[2];
    {
        bf16x8 qf[8];
#pragma unroll
        for (int s = 0; s < 8; ++s) qf[s] = *(const LAS bf16x8*)(lds + L_QI + (2 * s + hi) * 1024 + (32 * ib + r32) * 16);
#pragma unroll
        for (int eb = 0; eb < 2; ++eb) {
#pragma unroll
            for (int r = 0; r < 16; ++r) acc[eb][r] = 0.f;
            const bf16* cp = CT + ((size_t)(c * 4 + h) * 256 + (2 * ep + eb) * 32 + r32) * 128 + 8 * hi;
#pragma unroll
            for (int s = 0; s < 8; ++s) { const bf16x8 cf = *(const bf16x8*)(cp + 16 * s); acc[eb] = __builtin_amdgcn_mfma_f32_32x32x16_bf16(qf[s], cf, acc[eb], 0, 0, 0); } }
#pragma unroll
        for (int r = 0; r < 16; ++r) { const float wv = sm[S_WINT + 32 * ib + fa::crow(r, hi)]; acc[0][r] *= wv; acc[1][r] *= wv; }
        f32x16 p0, p1;
#pragma unroll
        for (int r = 0; r < 16; ++r) { p0[r] = 0.f; p1[r] = 0.f; }
#pragma unroll
        for (int s = 0; s < 8; ++s) { const bf16x8 k0 = *(const LAS bf16x8*)(lds + L_KI + (2 * s + hi) * 1024 + r32 * 16); p0 = __builtin_amdgcn_mfma_f32_32x32x16_bf16(k0, qf[s], p0, 0, 0, 0); }
        if (ib == 1) {
#pragma unroll
            for (int s = 0; s < 8; ++s) { const bf16x8 k1 = *(const LAS bf16x8*)(lds + L_KI + (2 * s + hi) * 1024 + (32 + r32) * 16); p1 = __builtin_amdgcn_mfma_f32_32x32x16_bf16(k1, qf[s], p1, 0, 0, 0); } }
        const int i = 32 * ib + r32; const float ti = sm[S_TS + i]; float rs = 0.f;
#pragma unroll
        for (int r = 0; r < 16; ++r) { const int j = fa::crow(r, hi);
            p0[r] = (j <= i) ? p0[r] * __expf(ti + sm[S_US + j]) : 0.f;
            p1[r] = (ib == 1 && j + 32 <= i) ? p1[r] * __expf(ti + sm[S_US + j + 32]) : 0.f;
            rs += p0[r] + p1[r]; }
        { auto rr = __builtin_amdgcn_permlane32_swap(__float_as_uint(rs), __float_as_uint(rs), false, false); rs = __uint_as_float(rr[0]) + __uint_as_float(rr[1]); }
        if (ep == 0 && hi == 0) sm[S_RS + i] = rs;
        v4u pw[4];
#pragma unroll
        for (int q = 0; q < 4; ++q) { pw[0][q] = pg8::cvt_pk_bf16(p0[2 * q], p0[2 * q + 1]); pw[1][q] = pg8::cvt_pk_bf16(p0[8 + 2 * q], p0[8 + 2 * q + 1]); pw[2][q] = pg8::cvt_pk_bf16(p1[2 * q], p1[2 * q + 1]); pw[3][q] = pg8::cvt_pk_bf16(p1[8 + 2 * q], p1[8 + 2 * q + 1]); }
        const LAS unsigned char* tb = lds + L_VI + ((lane >> 4) & 1) * 32 + (lane & 3) * 8 + (4 * hi + ((lane & 15) >> 2)) * 64;
#pragma unroll
        for (int eb = 0; eb < 2; ++eb) {
#pragma unroll
            for (int ks = 0; ks < 2; ++ks) { const bf16x8 vf = ML_FRAG(tb + (2 * ep + eb) * 4096, ks * 1024); acc[eb] = __builtin_amdgcn_mfma_f32_32x32x16_bf16(__builtin_bit_cast(bf16x8, pw[ks]), vf, acc[eb], 0, 0, 0); }
            if (ib == 1) {
#pragma unroll
                for (int ks = 2; ks < 4; ++ks) { const bf16x8 vf = ML_FRAG(tb + (2 * ep + eb) * 4096, ks * 1024); acc[eb] = __builtin_amdgcn_mfma_f32_32x32x16_bf16(__builtin_bit_cast(bf16x8, pw[ks]), vf, acc[eb], 0, 0, 0); } } }
    }
    __syncthreads();
    if (tid < 64) { float qn = 0.f;
#pragma unroll
        for (int p = 0; p < 8; ++p) qn += sm[S_QN + p * 64 + tid];
        const float den = sm[S_WINT + tid] * qn + sm[S_RS + tid]; sm[S_DINV + tid] = 1.0f / fmaxf(fabsf(den), sm[S_EMR + tid]); }
    __syncthreads();
    { LAS float* HL = (LAS float*)lds;
#pragma unroll
      for (int r = 0; r < 16; ++r) { const int i = 32 * ib + fa::crow(r, hi); const float dv = sm[S_DINV + i];
          HL[i * HL_LD + (2 * ep) * 32 + r32] = acc[0][r] * dv; HL[i * HL_LD + (2 * ep + 1) * 32 + r32] = acc[1][r] * dv; } }
    __syncthreads();
    { const LAS float* HL = (const LAS float*)lds; const int i = tid >> 3, part = tid & 7; f32x4 v[8]; float ss = 0.f;
#pragma unroll
      for (int k = 0; k < 8; ++k) { v[k] = *(const LAS f32x4*)(HL + i * HL_LD + 32 * k + 4 * part); ss += (v[k].x * v[k].x + v[k].y * v[k].y) + (v[k].z * v[k].z + v[k].w * v[k].w); }
      ss += __shfl_xor(ss, 1); ss += __shfl_xor(ss, 2); ss += __shfl_xor(ss, 4);
      const float rs = 1.0f / sqrtf(ss * (1.0f / 256.0f) + EPS);
      const size_t go = (size_t)(R0 + i) * 1024 + h * 256 + 4 * part;
#pragma unroll
      for (int k = 0; k < 8; ++k) { const v2u mo = *(const v2u*)(MO + go + 32 * k);
          v2u w; w.x = pk2(v[k].x * rs * pg8::bflo(mo.x), v[k].y * rs * pg8::bfhi(mo.x)); w.y = pk2(v[k].z * rs * pg8::bflo(mo.y), v[k].w * rs * pg8::bfhi(mo.y));
          *(v2u*)(HMG + go + 32 * k) = w; } }
    __syncthreads();
}
}
__global__ void __launch_bounds__(NTHREADS, 2) mega_fwd(Args args) {
    extern __shared__ __attribute__((aligned(16))) unsigned char lds_raw[];
    LAS unsigned char* lds = (LAS unsigned char*)lds_raw;
    volatile LAS unsigned* MISC = (volatile LAS unsigned*)(lds + MISC_OFF);
    const int tid = threadIdx.x, lane = tid & 63, wave = __builtin_amdgcn_readfirstlane(tid >> 6);
    const int G = gridDim.x, bx = blockIdx.x;
    const int vcu = (G % 8 == 0) ? (bx % 8) * (G / 8) + bx / 8 : bx;
    unsigned char* ws = args.ws;
    gu32* ctl = (gu32*)(ws + WS_CTL);
    for (int u = tid; u < (LDS_BYTES - LDSCTL_OFF) / 4; u += NTHREADS) ((LAS unsigned*)(lds + LDSCTL_OFF))[u] = 0u;
    __syncthreads();
    XcdBarrier bar = xcd_barrier_post((unsigned*)(ctl + CW_BAR), MISC + 8);
#define GRID_BAR() xcd_barrier(bar)

    float* ROPE = (float*)(ws + WS_ROPE); float* BIAS = (float*)(ws + WS_BIAS); float* GW = (float*)(ws + WS_GW); float* METAH = (float*)(ws + WS_METAH);
    float* GATES = (float*)(ws + WS_GATES);
    bf16* WUP = (bf16*)(ws + WS_WUP); bf16* WDN = (bf16*)(ws + WS_WDN); bf16* WIN = (bf16*)(ws + WS_WIN); bf16* WMB = (bf16*)(ws + WS_WMB); bf16* WAB = (bf16*)(ws + WS_WAB); bf16* WOUT = (bf16*)(ws + WS_WOUT);
    bf16* XA = (bf16*)(ws + WS_XA); bf16* HID = (bf16*)(ws + WS_HID); float* Y = (float*)(ws + WS_Y); bf16* Z = (bf16*)(ws + WS_Z); bf16* YG = (bf16*)(ws + WS_YG);
    bf16* HMG = (bf16*)(ws + WS_HMG); bf16* HA = (bf16*)(ws + WS_HA); bf16* CT = (bf16*)(ws + WS_HM); float* DCT = (float*)(ws + WS_DCT); float* DNB = (float*)(ws + WS_DN); float* NPREV = (float*)(ws + WS_NPREV); float* MSC = (float*)(ws + WS_MSC);
    bf16* ZQK = Z; bf16* ZMV = Z + ZPIECE; bf16* ZMO = Z + 2 * ZPIECE; bf16* ZAQ = Z + 3 * ZPIECE; bf16* ZAK = Z + 4 * ZPIECE; bf16* ZAV = Z + 5 * ZPIECE;
    bf16* ZGM = Z + 6 * ZPIECE; bf16* ZGA = ZGM + (size_t)MP * 2048;
    const int gw = vcu * NWAVES + wave, NGW = G * NWAVES;
    LAS float* scr = (LAS float*)(lds + wave * 16384);

#if PH_MASK & (1 << 0)
    {
        convert_ffn(args.in[I_F1G], args.in[I_F1U], args.in[I_F1D], args.in[I_F1PRE], WUP, WDN, scr, gw, NGW, lane);
        constexpr int N_IN = (DM / 64) * (NIN / 32), N_MB = (1024 / 64) * (DM / 32), N_WO = (DM / 64) * (DM / 32);
        for (int it = gw; it < N_IN + 2 * N_MB + N_WO; it += NGW) {
            int r = it;
            if (r < N_IN) { const int nblk = NIN / 32, kb = r / nblk, nb = r % nblk, row0 = 32 * nb; const int col0 = row0 < 3072 ? row0 : row0 + 8;
                tr_item(args.in[I_WIN], NIN_SRC, col0, 64 * kb, WIN, DM, row0, args.in[I_MIXPRE], 1.0f, scr, lane); continue; } r -= N_IN;
            if (r < N_MB) { const int nblk = DM / 32, kb = r / nblk, nb = r % nblk; tr_item(args.in[I_MWB], DM, 32 * nb, 64 * kb, WMB, 1024, 32 * nb, args.in[I_MNORM], 1.0f, scr, lane); continue; } r -= N_MB;
            if (r < N_MB) { const int nblk = DM / 32, kb = r / nblk, nb = r % nblk; tr_item(args.in[I_AWB], DM, 32 * nb, 64 * kb, WAB, 1024, 32 * nb, args.in[I_ANORM], 0.8f, scr, lane); continue; } r -= N_MB;
            { const int nblk = DM / 32, kb = r / nblk, nb = r % nblk; tr_item(args.in[I_WOUT], DM, 32 * nb, 64 * kb, WOUT, DM, 32 * nb, nullptr, 1.0f, scr, lane); }
        }
        const int gt = vcu * NTHREADS + tid, NGT = G * NTHREADS;
        for (int i = gt; i < NIN; i += NGT) BIAS[i] = args.in[I_BIN][i < 3072 ? i : i + 8];
        for (int i = gt; i < 8 * DM; i += NGT) { const int c = i / DM, k = i % DM; GW[i] = args.in[I_WIN][(size_t)k * NIN_SRC + 3072 + c] * args.in[I_MIXPRE][k]; }
        for (int i = gt; i < (SEQ + NMETA) * 8; i += NGT) { const int pos = i >> 3, k = i & 7;
            const float invf = k == 0 ? 1.0f : k == 1 ? 0.19392274474868576f : k == 2 ? 0.03760603093086393f : k == 3 ? 0.007292664737217109f : k == 4 ? 0.001414213562373095f : k == 5 ? 0.0002742481756762073f : k == 6 ? 5.318295896944988e-05f : 1.031338537721246e-05f;
            const float ang = (float)pos * invf; const double a = (double)ang;
            const double q = rint(a * 0.15915494309189535); const double rr = a - q * 6.283185307179586476925;
            double s, c; sincos_small(rr, s, c);
            ROPE[(size_t)pos * 16 + k] = (float)c; ROPE[(size_t)pos * 16 + 8 + k] = (float)s; }
        for (int R = gw; R < MP; R += NGW) {
            bf16* xo = XA + (size_t)R * DM;
            if (R < ROW_META0) { GAS v2u* o = (GAS v2u*)xo + lane; v2u z; z.x = 0u; z.y = 0u;
#pragma unroll
                for (int j = 0; j < 8; ++j) o[64 * j] = z; }
            else { const float* hp = (R >= ROW_X0) ? args.in[I_X] + (size_t)(R - ROW_X0) * DM : args.in[I_META] + (size_t)(R - ROW_META0) * DM;
                f32x4 v[8]; load_row(hp, lane, v); const float r1 = 1.0f / sqrtf(row_ssq(v) * (1.0f / DM) + EPS); store_row_bf16(xo, lane, v, r1); }
        }
    }
#endif
    GRID_BAR();

#if PH_MASK & (1 << 1)
    { pg8::Gemm g{XA, WUP, MP, NUP, DM}; pg8::StaticOrder S; S.init(MP, NUP, G, bx); pg8::EpiSwiglu E{HID, DFF};
      pg8::gemm_phase<pg8::EpiSwiglu, pg8::StaticOrder, true, true>(lds, g, S, E); }
#endif
    GRID_BAR();
#if PH_MASK & (1 << 2)
    { pg8::Gemm g{HID, WDN, MP, DM, DFF}; pg8::StaticOrder S; S.init(MP, DM, G, bx); pg8::EpiF32 E{Y, DM};
      pg8::gemm_phase<pg8::EpiF32, pg8::StaticOrder, true, true>(lds, g, S, E); }
#endif
    GRID_BAR();
#if PH_MASK & (1 << 3)
    {
        for (int R = ROW_PAD0 + gw; R < MP; R += NGW) {
            if (R < ROW_META0) { if (lane < 8) GATES[(size_t)R * 8 + lane] = (lane < 4) ? -INFINITY : 0.f; continue; }
            const float* hp = (R >= ROW_X0) ? args.in[I_X] + (size_t)(R - ROW_X0) * DM : args.in[I_META] + (size_t)(R - ROW_META0) * DM;
            float* ho = (R >= ROW_X0) ? args.out + (size_t)(R - ROW_X0) * DM : METAH + (size_t)(R - ROW_META0) * DM;
            f32x4 y[8], h[8], g[8]; load_row(Y + (size_t)R * DM, lane, y); load_row(hp, lane, h); load_row(args.in[I_F1POST], lane, g);
            const float rs = 0.5f / sqrtf(row_ssq(y) * (1.0f / DM) + EPS);
#pragma unroll
            for (int j = 0; j < 8; ++j) h[j] = h[j] + (y[j] * rs) * g[j];
            { GAS f32x4* o = (GAS f32x4*)ho + lane;
#pragma unroll
              for (int j = 0; j < 8; ++j) o[64 * j] = h[j]; }
            const float r2 = 1.0f / sqrtf(row_ssq(h) * (1.0f / DM) + EPS);
            store_row_bf16(XA + (size_t)R * DM, lane, h, r2);
            float gv = 0.f;
#pragma unroll 1
            for (int c = 0; c < 8; ++c) { const GAS f32x4* wp = (const GAS f32x4*)(GW + (size_t)c * DM) + lane; float s = 0.f;
#pragma unroll
                for (int j = 0; j < 8; ++j) { const f32x4 w = wp[64 * j]; s += (h[j].x * w.x + h[j].y * w.y) + (h[j].z * w.z + h[j].w * w.w); }
                s = wave_sum(s); if (lane == c) gv = s; }
            if (lane < 8) { float v = gv * r2 + args.in[I_BIN][3072 + lane]; if (lane >= 4) v = log_sigmoid(v); GATES[(size_t)R * 8 + lane] = v; }
        }
    }
#endif
    GRID_BAR();
#if PH_MASK & (1 << 4)
    { pg8::Gemm g{XA, WIN, MP, NIN, DM}; pg8::StaticOrder S; S.init(MP, NIN, G, bx); pg8::EpiZ E{Z, BIAS, ROPE};
      pg8::gemm_phase<pg8::EpiZ, pg8::StaticOrder, true, true>(lds, g, S, E); }
#endif
    GRID_BAR();
#if PH_MASK & (1 << 5)
    {
        for (int it = bx; it < 512; it += G) ml::stepA(lds, it >> 2, it & 3, ZQK, ZMV, GATES, args.in[I_CONVW], args.in[I_CONVB], DCT, DNB, MSC);
    }
    GRID_BAR();
    {
        ml::stepB(vcu * NTHREADS + tid, G * NTHREADS, DCT, DNB, MSC, CT, NPREV);
        bf16* OS = XA;
        for (int u = bx; u < 256; u += G) { const int x = u & 7, j = u >> 3, sh = 2 * x + (j & 1), p = j >> 1;
            fa::attn_unit(lds, sh, p, ZAQ, ZAK, ZAV, OS);
            fa::attn_unit(lds, sh, 31 - p, ZAQ, ZAK, ZAV, OS); }
    }
#endif
    GRID_BAR();
#if PH_MASK & (1 << 6)
    {
        for (int it = bx; it < 512; it += G) ml::stepC(lds, 1 + (it >> 2), it & 3, ZQK, ZMV, ZMO, GATES, args.in[I_CONVW], args.in[I_CONVB], CT, NPREV, MSC, HMG);
        float s1 = 0.f, s2 = 0.f;
        { const float a1 = args.in[I_LQ1][lane] * args.in[I_LK1][lane], a2 = args.in[I_LQ2][lane] * args.in[I_LK2][lane]; s1 = wave_sum(a1); s2 = wave_sum(a2); }
        const float lam = expf(s1) - expf(s2) + 0.2f;
        const bf16* OS = XA;
        for (int R = ROW_X0 + gw; R < MP; R += NGW) {
            const GAS unsigned* osr = (const GAS unsigned*)(OS + (size_t)R * 2048) + lane; GAS unsigned* hao = (GAS unsigned*)(HA + (size_t)R * 1024) + lane;
#pragma unroll
            for (int hh = 0; hh < 8; ++hh) { const unsigned w1 = osr[hh * 128], w2 = osr[hh * 128 + 64];
                const float v0 = pg8::bflo(w1) - lam * pg8::bflo(w2), v1 = pg8::bfhi(w1) - lam * pg8::bfhi(w2);
                const float ss = wave_sum(v0 * v0 + v1 * v1); const float rs = 1.0f / sqrtf(ss * (1.0f / 128.0f) + EPS);
                hao[hh * 64] = pk2(v0 * rs, v1 * rs); }
        }
    }
#endif
    GRID_BAR();
#if PH_MASK & (1 << 7)
    { pg8::Gemm g{HMG + (size_t)ROW_X0 * 1024, WMB, SEQ, DM, 1024}; pg8::StaticOrder S; S.init(SEQ, DM, G, bx); pg8::EpiGate E{ZGM + (size_t)ROW_X0 * 2048, YG + (size_t)ROW_X0 * 2048, DM, 0};
      pg8::gemm_phase<pg8::EpiGate, pg8::StaticOrder, true, true>(lds, g, S, E); }
#endif
    GRID_BAR();
#if PH_MASK & (1 << 8)
    { pg8::Gemm g{HA + (size_t)ROW_X0 * 1024, WAB, SEQ, DM, 1024}; pg8::StaticOrder S; S.init(SEQ, DM, G, bx); pg8::EpiGate E{ZGA + (size_t)ROW_X0 * 2048, YG + (size_t)ROW_X0 * 2048, DM, 1};
      pg8::gemm_phase<pg8::EpiGate, pg8::StaticOrder, true, true>(lds, g, S, E); }
#endif
    GRID_BAR();
#if PH_MASK & (1 << 9)
    { pg8::Gemm g{YG + (size_t)ROW_X0 * 2048, WOUT, SEQ, DM, DM}; pg8::StaticOrder S; S.init(SEQ, DM, G, bx); pg8::EpiF32 E{Y + (size_t)ROW_X0 * DM, DM};
      pg8::gemm_phase<pg8::EpiF32, pg8::StaticOrder, true, true>(lds, g, S, E); }
#endif
    GRID_BAR();
#if PH_MASK & (1 << 10)
    {
        for (int R = ROW_X0 + gw; R < MP; R += NGW) {
            float* ho = args.out + (size_t)(R - ROW_X0) * DM;
            f32x4 y[8], h[8], g[8]; load_row(Y + (size_t)R * DM, lane, y); load_row(ho, lane, h); load_row(args.in[I_MIXPOST], lane, g);
            const float rs = 1.0f / sqrtf(row_ssq(y) * (1.0f / DM) + EPS);
#pragma unroll
            for (int j = 0; j < 8; ++j) h[j] = h[j] + (y[j] * rs) * g[j];
            { GAS f32x4* o = (GAS f32x4*)ho + lane;
#pragma unroll
              for (int j = 0; j < 8; ++j) o[64 * j] = h[j]; }
            const float r2 = 1.0f / sqrtf(row_ssq(h) * (1.0f / DM) + EPS);
            store_row_bf16(XA + (size_t)R * DM, lane, h, r2);
        }
        convert_ffn(args.in[I_F2G], args.in[I_F2U], args.in[I_F2D], args.in[I_F2PRE], WUP, WDN, scr, gw, NGW, lane);
    }
#endif
    GRID_BAR();
#if PH_MASK & (1 << 11)
    { pg8::Gemm g{XA + (size_t)ROW_X0 * DM, WUP, SEQ, NUP, DM}; pg8::StaticOrder S; S.init(SEQ, NUP, G, bx); pg8::EpiSwiglu E{HID + (size_t)ROW_X0 * DFF, DFF};
      pg8::gemm_phase<pg8::EpiSwiglu, pg8::StaticOrder, true, true>(lds, g, S, E); }
#endif
    GRID_BAR();
#if PH_MASK & (1 << 12)
    { pg8::Gemm g{HID + (size_t)ROW_X0 * DFF, WDN, SEQ, DM, DFF}; pg8::StaticOrder S; S.init(SEQ, DM, G, bx); pg8::EpiF32 E{Y + (size_t)ROW_X0 * DM, DM};
      pg8::gemm_phase<pg8::EpiF32, pg8::StaticOrder, true, true>(lds, g, S, E); }
#endif
    GRID_BAR();
#if PH_MASK & (1 << 13)
    {
        for (int R = ROW_X0 + gw; R < MP; R += NGW) {
            float* ho = args.out + (size_t)(R - ROW_X0) * DM;
            f32x4 y[8], h[8], g[8]; load_row(Y + (size_t)R * DM, lane, y); load_row(ho, lane, h); load_row(args.in[I_F2POST], lane, g);
            const float rs = 0.5f / sqrtf(row_ssq(y) * (1.0f / DM) + EPS);
            GAS f32x4* o = (GAS f32x4*)ho + lane;
#pragma unroll
            for (int j = 0; j < 8; ++j) o[64 * j] = h[j] + (y[j] * rs) * g[j];
        }
    }
#endif
}

extern "C" void kernel_launch(void* const* d_in, const int* in_sizes, int n_in, void* d_out, int out_size, void* d_ws, size_t ws_size, hipStream_t stream) {
    static int grid = 0;
    if (grid == 0) {
        if (n_in != 27 || in_sizes[0] != SEQ * DM || out_size != SEQ * DM || ws_size < WS_END) { fprintf(stderr, "kernel_launch: unexpected shapes (n_in %d, in0 %d, out %d, ws %zu); nothing launched\n", n_in, n_in > 0 ? in_sizes[0] : -1, out_size, ws_size); grid = -1; return; }
        int dev = 0, cus = 0, per_cu = 0;
        if (hipGetDevice(&dev) != hipSuccess || hipDeviceGetAttribute(&cus, hipDeviceAttributeMultiprocessorCount, dev) != hipSuccess) { grid = -1; return; }
        if (hipFuncSetAttribute((const void*)mega_fwd, hipFuncAttributeMaxDynamicSharedMemorySize, LDS_BYTES) != hipSuccess) { fprintf(stderr, "kernel_launch: hipFuncSetAttribute failed\n"); grid = -1; return; }
        if (hipOccupancyMaxActiveBlocksPerMultiprocessor(&per_cu, (const void*)mega_fwd, NTHREADS, LDS_BYTES) != hipSuccess || per_cu < 1) { fprintf(stderr, "kernel_launch: occupancy query says %d blocks per CU\n", per_cu); (void)hipGetLastError(); grid = -1; return; }
        grid = cus;
    }
    if (grid < 0) return;
    if (hipMemsetAsync((char*)d_ws + WS_CTL, 0, CTL_ZERO_BYTES, stream) != hipSuccess) { fprintf(stderr, "kernel_launch: memset failed\n"); return; }
    Args a{};
    for (int i = 0; i < 27; ++i) a.in[i] = (const float*)d_in[i];
    a.out = (float*)d_out; a.ws = (unsigned char*)d_ws;
    hipLaunchKernelGGL(mega_fwd, dim3(grid), dim3(NTHREADS), LDS_BYTES, stream, a);
}
```

```cpp
#include <hip/hip_runtime.h>
#include <cstdio>
#include <cstdint>

constexpr int DM = 2048, SEQ = 8192, NMETA = 16, DFF = 5632, NUP = 2 * DFF, NIN = 10240, NIN_SRC = 10248;
constexpr int MP = 8448, ROW_X0 = 256, ROW_META0 = 240, ROW_PAD0 = 192, NCHUNK = 129;
constexpr float EPS = 1e-6f;
constexpr float QSCALE = 0.125f * 1.4426950408889634f;

constexpr size_t MiB = 1u << 20;
constexpr size_t WS_CTL = 0, CTL_ZERO_BYTES = 1 * MiB;
constexpr size_t WS_ROPE = 1 * MiB;
constexpr size_t WS_BIAS = 2 * MiB;
constexpr size_t WS_GW = 2 * MiB + 64 * 1024;
constexpr size_t WS_METAH = 2 * MiB + 256 * 1024;
constexpr size_t WS_DN = 1 * MiB + 520 * 1024;
constexpr size_t WS_NPREV = 2 * MiB + 384 * 1024;
constexpr size_t WS_MSC = 2 * MiB + 704 * 1024;
constexpr size_t WS_GATES = 3 * MiB;
constexpr size_t WS_YM = 3 * MiB + 512 * 1024;
constexpr size_t WS_WUP = 4 * MiB;
constexpr size_t WS_WDN = 48 * MiB;
constexpr size_t WS_WIN = 70 * MiB;
constexpr size_t WS_WMB = 110 * MiB;
constexpr size_t WS_WAB = 114 * MiB;
constexpr size_t WS_WOUT = 118 * MiB;
constexpr size_t WS_XA = 126 * MiB;
constexpr size_t WS_U = 159 * MiB;
constexpr size_t WS_HID = WS_U;
constexpr size_t WS_Y = WS_U + 91 * MiB;
constexpr size_t WS_Z = WS_U;
constexpr size_t ZPIECE = (size_t)MP * 1024;
constexpr size_t WS_YG = WS_U;
constexpr size_t WS_HMG = 324 * MiB;
constexpr size_t WS_HA = WS_HMG + (size_t)MP * 1024 * 2;
constexpr size_t WS_HM = 357 * MiB;
constexpr size_t WS_DCT = WS_WUP;
constexpr size_t WS_END = 390 * MiB;
static_assert(WS_WUP + (size_t)NUP * DM * 2 <= WS_WDN && WS_WDN + (size_t)DM * DFF * 2 <= WS_WIN && WS_WIN + (size_t)NIN * DM * 2 <= WS_WMB, "ws map 1");
static_assert(WS_XA + (size_t)MP * DM * 2 <= WS_U && WS_HID + (size_t)MP * DFF * 2 <= WS_Y && WS_Y + (size_t)MP * DM * 4 <= WS_HMG, "ws map 2");
static_assert(WS_Z + (6 * ZPIECE + 2 * (size_t)MP * 2048) * 2 <= WS_HMG && WS_HA + (size_t)MP * 1024 * 2 <= WS_HM && WS_HM + (size_t)MP * 1024 * 4 <= WS_END, "ws map 3");
static_assert(WS_YG + (size_t)MP * 2048 * 2 <= WS_Y, "YG must not overlap Y");
constexpr int CW_BAR = 4096;

namespace pg8 {
#define PG8_LAS __attribute__((address_space(3)))
typedef unsigned short bf16_t;
typedef short bf16x8 __attribute__((ext_vector_type(8)));
typedef float f32x4 __attribute__((ext_vector_type(4)));
typedef unsigned u32x4 __attribute__((ext_vector_type(4)));
constexpr int BM = 256, BK = 64, HALF = 128, HTB = HALF * BK * 2  , STAGE_BYTES = 8 * HTB, NXCD = 8, WGM = 8;

__host__ __device__ __forceinline__ int lds_byte(int r, int c) { const int st = (r >> 4) * 2 + (c >> 5), rr = r & 15, cc = c & 31, ob = rr * 64 + cc * 2; return st * 1024 + (ob ^ (((ob >> 9) & 1) << 5)); }
__host__ __device__ __forceinline__ void stage_rc(int b, int& R, int& C) { const int st = b / 1024, sb = b % 1024, swz = sb ^ (((sb >> 9) & 1) << 5); R = (st >> 1) * 16 + swz / 64; C = (st & 1) * 32 + (swz % 64) / 2; }
__host__ __device__ __forceinline__ int perm32(int rho) { const int n = rho >> 4, i = rho & 15; return 8 * (i >> 2) + 4 * n + (i & 3); }

struct Unit { int pm, pn; };
struct Gemm { const bf16_t* A; const bf16_t* Bt; int M, N, K; };

struct StaticOrder {
    int nM, nN, nwg, G, c;
    __host__ __device__ void init(int M, int N, int G_, int c_) { nM = M / BM; nN = N / BM; nwg = nM * nN; G = G_; c = c_; }
    __host__ __device__ bool next(int i, Unit& u) const {
        const long L = (long)i * G + c; if (L >= nwg) return false;
        int wgid = (int)L; { const int q = nwg / NXCD, r = nwg % NXCD, xcd = wgid % NXCD, off = wgid / NXCD; wgid = (xcd < r ? xcd * (q + 1) : r * (q + 1) + (xcd - r) * q) + off; }
        const int nig = WGM * nN, gid = wgid / nig, fm = gid * WGM, gsz = (nM - fm) < WGM ? (nM - fm) : WGM;
        u.pm = fm + ((wgid % nig) % gsz); u.pn = (wgid % nig) / gsz; return true;
    }
    __device__ __forceinline__ void a_ready(const Unit&) const {}
    __device__ __forceinline__ void done(const Unit&) const {}
};

__device__ __forceinline__ unsigned cvt_pk_bf16(float lo, float hi) { unsigned r; asm volatile("v_cvt_pk_bf16_f32 %0, %1, %2" : "=v"(r) : "v"(lo), "v"(hi)); return r; }
typedef float f32x2 __attribute__((ext_vector_type(2)));
__device__ __forceinline__ float sigm(float x) { return __builtin_amdgcn_rcpf(1.0f + __expf(-x)); }
__device__ __forceinline__ float bflo(unsigned w) { return __uint_as_float(w << 16); }
__device__ __forceinline__ float bfhi(unsigned w) { return __uint_as_float(w & 0xffff0000u); }

struct EpiF32 {
    static constexpr bool PERM = false, AFTER_DRAIN = false;
    float* C; int ldc;
    __device__ __forceinline__ void operator()(const f32x4 (&acc)[2][2][4][2], const Unit& u, int wr, int wc, int fr, int fq) const {
        const int row0 = u.pm * BM + wr * 64 + fr, col0 = u.pn * BM + wc * 32 + 4 * fq;
#pragma unroll
        for (int ai = 0; ai < 2; ++ai)
#pragma unroll
            for (int m = 0; m < 4; ++m) { float* rowp = C + (size_t)(row0 + ai * HALF + m * 16) * ldc + col0;
#pragma unroll
                for (int bj = 0; bj < 2; ++bj)
#pragma unroll
                    for (int n = 0; n < 2; ++n) *(f32x4*)(rowp + bj * HALF + n * 16) = acc[ai][bj][m][n]; }
    }
};

struct EpiSwiglu {
    static constexpr bool PERM = true, AFTER_DRAIN = false;
    bf16_t* O; int ldc;
    __device__ __forceinline__ void operator()(const f32x4 (&acc)[2][2][4][2], const Unit& u, int wr, int wc, int fr, int fq) const {
        const int row0 = u.pm * BM + wr * 64 + fr, col0 = u.pn * HALF + wc * 32 + 8 * fq;
#pragma unroll
        for (int ai = 0; ai < 2; ++ai)
#pragma unroll
            for (int m = 0; m < 4; ++m) { bf16_t* rowp = O + (size_t)(row0 + ai * HALF + m * 16) * ldc + col0;
                const f32x4 g0 = acc[ai][0][m][0], g1 = acc[ai][0][m][1], u0 = acc[ai][1][m][0], u1 = acc[ai][1][m][1];
                float r[8];
#pragma unroll
                for (int i = 0; i < 4; ++i) { r[i] = g0[i] * sigm(g0[i]) * u0[i]; r[4 + i] = g1[i] * sigm(g1[i]) * u1[i]; }
                u32x4 w; w.x = cvt_pk_bf16(r[0], r[1]); w.y = cvt_pk_bf16(r[2], r[3]); w.z = cvt_pk_bf16(r[4], r[5]); w.w = cvt_pk_bf16(r[6], r[7]);
                *(u32x4*)rowp = w; }
    }
};

struct EpiZ {
    static constexpr bool PERM = true, AFTER_DRAIN = false;
    bf16_t* Z; const float* bias; const float* rope; int rowoff;
    __device__ __forceinline__ void operator()(const f32x4 (&acc)[2][2][4][2], const Unit& u, int wr, int wc, int fr, int fq) const {
        const int pn = u.pn, row0 = rowoff + u.pm * BM + wr * 64 + fr;
        bf16_t* base; int ldc, colt;
        if (pn < 24) { base = Z + (size_t)(pn >> 2) * ZPIECE; ldc = 1024; colt = (pn & 3) * 256; }
        else { const int q = pn - 24; base = Z + 6 * ZPIECE + (size_t)(q >> 3) * ((size_t)MP * 2048); ldc = 2048; colt = (q & 7) * 256; }
        const int mode = ((pn >= 8 && pn < 12) || pn >= 24) ? 1 : ((pn >= 12 && pn < 20) ? 2 : 0);
        const float qs = (pn >= 12 && pn < 16) ? QSCALE : 1.0f;
        const int col0 = colt + wc * 32 + 8 * fq, bcol0 = pn * BM + wc * 32 + 8 * fq;
        f32x4 bv[2][2];
#pragma unroll
        for (int bj = 0; bj < 2; ++bj)
#pragma unroll
            for (int n = 0; n < 2; ++n) bv[bj][n] = *(const f32x4*)(bias + bcol0 + bj * HALF + 4 * n);
        const bool rot = ((wc & 1) == 0) && (fq < 2);
        const float sgn = (fq == 0) ? -1.0f : 1.0f;
#pragma unroll
        for (int ai = 0; ai < 2; ++ai)
#pragma unroll
            for (int m = 0; m < 4; ++m) { const int row = row0 + ai * HALF + m * 16; bf16_t* rowp = base + (size_t)row * ldc + col0;
#pragma unroll
                for (int bj = 0; bj < 2; ++bj) { f32x4 v0 = acc[ai][bj][m][0] + bv[bj][0], v1 = acc[ai][bj][m][1] + bv[bj][1];
                    if (mode == 1) {
#pragma unroll
                        for (int i = 0; i < 4; ++i) { v0[i] = sigm(v0[i]); v1[i] = sigm(v1[i]); }
                    } else if (mode == 2) {
                        f32x4 p0, p1;
#pragma unroll
                        for (int i = 0; i < 4; ++i) { p0[i] = __shfl_xor(v0[i], 16); p1[i] = __shfl_xor(v1[i], 16); }
                        if (rot) { int pos = row - ROW_META0; pos = pos < 0 ? 0 : pos; const float* rp = rope + (size_t)pos * 16;
                            const f32x4 c0 = *(const f32x4*)(rp), c1 = *(const f32x4*)(rp + 4), s0 = *(const f32x4*)(rp + 8), s1 = *(const f32x4*)(rp + 12);
#pragma unroll
                            for (int i = 0; i < 4; ++i) { v0[i] = v0[i] * c0[i] + sgn * p0[i] * s0[i]; v1[i] = v1[i] * c1[i] + sgn * p1[i] * s1[i]; } }
                        v0 = v0 * qs; v1 = v1 * qs;
                    }
                    u32x4 w; w.x = cvt_pk_bf16(v0[0], v0[1]); w.y = cvt_pk_bf16(v0[2], v0[3]); w.z = cvt_pk_bf16(v1[0], v1[1]); w.w = cvt_pk_bf16(v1[2], v1[3]);
                    *(u32x4*)(rowp + bj * HALF) = w; } }
    }
};

struct EpiGate {
    static constexpr bool PERM = true, AFTER_DRAIN = false;
    const bf16_t* G; bf16_t* O; int ldc; int accum;
    __device__ __forceinline__ void operator()(const f32x4 (&acc)[2][2][4][2], const Unit& u, int wr, int wc, int fr, int fq) const {
        const int row0 = u.pm * BM + wr * 64 + fr, col0 = u.pn * BM + wc * 32 + 8 * fq;
#pragma unroll
        for (int ai = 0; ai < 2; ++ai)
#pragma unroll
            for (int m = 0; m < 4; ++m) { const size_t off = (size_t)(row0 + ai * HALF + m * 16) * ldc + col0;
#pragma unroll
                for (int bj = 0; bj < 2; ++bj) { const u32x4 gw = *(const u32x4*)(G + off + bj * HALF);
                    f32x4 v0 = acc[ai][bj][m][0], v1 = acc[ai][bj][m][1];
                    v0[0] *= bflo(gw.x); v0[1] *= bfhi(gw.x); v0[2] *= bflo(gw.y); v0[3] *= bfhi(gw.y);
                    v1[0] *= bflo(gw.z); v1[1] *= bfhi(gw.z); v1[2] *= bflo(gw.w); v1[3] *= bfhi(gw.w);
                    if (accum) { const u32x4 ow = *(const u32x4*)(O + off + bj * HALF);
                        v0[0] += bflo(ow.x); v0[1] += bfhi(ow.x); v0[2] += bflo(ow.y); v0[3] += bfhi(ow.y);
                        v1[0] += bflo(ow.z); v1[1] += bfhi(ow.z); v1[2] += bflo(ow.w); v1[3] += bfhi(ow.w); }
                    u32x4 w; w.x = cvt_pk_bf16(v0[0], v0[1]); w.y = cvt_pk_bf16(v0[2], v0[3]); w.z = cvt_pk_bf16(v1[0], v1[1]); w.w = cvt_pk_bf16(v1[2], v1[3]);
                    *(u32x4*)(O + off + bj * HALF) = w; } }
    }
};

template <class Epi, class Sched, bool ALIGN_EPI = false, bool SP2 = false>
__device__ __forceinline__ void gemm_phase(PG8_LAS unsigned char* lds, const Gemm g, const Sched& S, const Epi& E) {
    int tid_ = threadIdx.x; asm volatile("" : "+v"(tid_));
    const int tid = tid_, wid = __builtin_amdgcn_readfirstlane(tid >> 6), lane = tid & 63, wr = wid >> 2, wc = wid & 3, fr = lane & 15, fq = lane >> 4;
    const int K = g.K, nt = K / BK;
    unsigned voffA[2], voffB[2];
#pragma unroll
    for (int i = 0; i < 2; ++i) { int R, C; stage_rc(tid * 16 + i * 8192, R, C); const int Rb = Epi::PERM ? ((R & ~31) + perm32(R & 31)) : R;
        voffA[i] = (unsigned)(R * K + C) * 2u; voffB[i] = (unsigned)(Rb * K + C) * 2u; }
    const size_t kstep = (size_t)(BK * 2);
    const size_t hstep = (size_t)HALF * K * 2;
    const size_t tstep = 2 * hstep;
    const unsigned ldsw = (unsigned)wid * 1024u;
    const int aoff = lds_byte(wr * 64 + fr, fq * 8), boff = lds_byte(wc * 32 + fr, fq * 8);
#define PG8_SA(b, h) (((b) * 2 + (h)) * HTB)
#define PG8_SB(b, h) ((4 + (b) * 2 + (h)) * HTB)
#define PG8_STAGE(bufoff, gbase, voff) do { _Pragma("unroll") for (int _i = 0; _i < 2; ++_i) \
        __builtin_amdgcn_global_load_lds((const unsigned*)((const char*)(gbase) + (voff)[_i]), (PG8_LAS unsigned*)(lds + (bufoff) + ldsw + _i * 8192), 16, 0, 0); } while (0)
#define PG8_LDA(dst, b, h) do { _Pragma("unroll") for (int m = 0; m < 4; ++m) _Pragma("unroll") for (int k = 0; k < 2; ++k) dst[m][k] = *(const PG8_LAS bf16x8*)(lds + PG8_SA(b, h) + aoff + m * 2048 + k * 1024); } while (0)
#define PG8_LDB(dst, b, h) do { _Pragma("unroll") for (int n = 0; n < 2; ++n) _Pragma("unroll") for (int k = 0; k < 2; ++k) dst[n][k] = *(const PG8_LAS bf16x8*)(lds + PG8_SB(b, h) + boff + n * 2048 + k * 1024); } while (0)
#define PG8_MMA(ai, bj, At, Bt) do { __builtin_amdgcn_s_setprio(1); _Pragma("unroll") for (int m = 0; m < 4; ++m) _Pragma("unroll") for (int n = 0; n < 2; ++n) _Pragma("unroll") for (int k = 0; k < 2; ++k) \
        acc[ai][bj][m][n] = __builtin_amdgcn_mfma_f32_16x16x32_bf16(Bt[n][k], At[m][k], acc[ai][bj][m][n], 0, 0, 0); __builtin_amdgcn_s_setprio(0); } while (0)
#define PG8_WAIT_V(n) asm volatile("s_waitcnt vmcnt(" #n ")" ::: "memory")
#define PG8_WAIT_L(n) asm volatile("s_waitcnt lgkmcnt(" #n ")" ::: "memory")
#define PG8_BAR __builtin_amdgcn_s_barrier()
#define PG8_SCHED __builtin_amdgcn_sched_barrier(0)
    Unit cur, nxt; int ui = 0;
    if (!S.next(0, cur)) return;
    f32x4 acc[2][2][4][2];
#pragma unroll
    for (int a = 0; a < 2; ++a)
#pragma unroll
        for (int b = 0; b < 2; ++b)
#pragma unroll
            for (int m = 0; m < 4; ++m)
#pragma unroll
                for (int n = 0; n < 2; ++n) acc[a][b][m][n] = (f32x4){0.f, 0.f, 0.f, 0.f};
    bf16x8 At[4][2], B0[2][2], B1[2][2];
    const char* cA = (const char*)g.A + (size_t)cur.pm * tstep; const char* cB = (const char*)g.Bt + (size_t)cur.pn * tstep;
    S.a_ready(cur);
    if constexpr (SP2) {
        PG8_STAGE(PG8_SB(0, 0), cB, voffB); PG8_STAGE(PG8_SB(0, 1), cB + hstep, voffB); PG8_STAGE(PG8_SA(0, 0), cA, voffA); PG8_STAGE(PG8_SA(0, 1), cA + hstep, voffA);
        if (wr == 1) PG8_BAR;
        PG8_WAIT_V(2); PG8_BAR;
        PG8_STAGE(PG8_SB(1, 0), cB + kstep, voffB); PG8_STAGE(PG8_SA(1, 0), cA + kstep, voffA); PG8_STAGE(PG8_SB(1, 1), cB + hstep + kstep, voffB);
        PG8_WAIT_V(6); PG8_BAR;
    } else {
        PG8_STAGE(PG8_SB(0, 0), cB, voffB); PG8_STAGE(PG8_SA(0, 0), cA, voffA); PG8_STAGE(PG8_SB(0, 1), cB + hstep, voffB); PG8_STAGE(PG8_SA(0, 1), cA + hstep, voffA);
        if (wr == 1) PG8_BAR;
        PG8_WAIT_V(4); PG8_BAR;
        PG8_STAGE(PG8_SB(1, 0), cB + kstep, voffB); PG8_STAGE(PG8_SA(1, 0), cA + kstep, voffA); PG8_STAGE(PG8_SB(1, 1), cB + hstep + kstep, voffB);
        PG8_WAIT_V(6); PG8_BAR;
    }
    for (;;) {
        const bool has_next = S.next(ui + 1, nxt);
        const char* nA = has_next ? (const char*)g.A + (size_t)nxt.pm * tstep : cA; const char* nB = has_next ? (const char*)g.Bt + (size_t)nxt.pn * tstep : cB;
        for (int t = 0; t < nt; t += 2) {
            const bool last = (t == nt - 2);
            const char* a1 = cA + (size_t)(t + 1) * kstep;
            const char* a2 = last ? nA : cA + (size_t)(t + 2) * kstep; const char* b2 = last ? nB : cB + (size_t)(t + 2) * kstep;
            const char* a3 = a2 + kstep; const char* b3 = b2 + kstep;
            if (last && has_next) S.a_ready(nxt);
            if constexpr (SP2) {
            PG8_LDB(B0, 0, 0); PG8_LDB(B1, 0, 1); PG8_SCHED; PG8_LDA(At, 0, 0); PG8_STAGE(PG8_SA(1, 1), a1 + hstep, voffA);
            PG8_WAIT_V(8); PG8_WAIT_L(0); PG8_BAR; PG8_MMA(0, 0, At, B0); PG8_MMA(0, 1, At, B1); PG8_BAR; PG8_SCHED;
            PG8_LDA(At, 0, 1); PG8_STAGE(PG8_SB(0, 0), b2, voffB); PG8_STAGE(PG8_SB(0, 1), b2 + hstep, voffB); PG8_STAGE(PG8_SA(0, 0), a2, voffA);
            PG8_WAIT_V(8); PG8_WAIT_L(0); PG8_BAR; PG8_MMA(1, 0, At, B0); PG8_MMA(1, 1, At, B1); PG8_BAR; PG8_SCHED;
            PG8_LDB(B0, 1, 0); PG8_LDB(B1, 1, 1); PG8_SCHED; PG8_LDA(At, 1, 0); PG8_STAGE(PG8_SA(0, 1), a2 + hstep, voffA);
            PG8_WAIT_V(8); PG8_WAIT_L(0); PG8_BAR; PG8_MMA(0, 0, At, B0); PG8_MMA(0, 1, At, B1); PG8_BAR; PG8_SCHED;
            PG8_LDA(At, 1, 1); PG8_STAGE(PG8_SB(1, 0), b3, voffB); PG8_STAGE(PG8_SB(1, 1), b3 + hstep, voffB); PG8_STAGE(PG8_SA(1, 0), a3, voffA);
            PG8_WAIT_V(8); PG8_WAIT_L(0); PG8_BAR; PG8_MMA(1, 0, At, B0); PG8_MMA(1, 1, At, B1); PG8_BAR; PG8_SCHED;
            } else {
            PG8_LDB(B0, 0, 0); PG8_SCHED; PG8_LDA(At, 0, 0); PG8_STAGE(PG8_SA(1, 1), a1 + hstep, voffA);
            PG8_WAIT_L(8); PG8_BAR; PG8_WAIT_L(0); PG8_MMA(0, 0, At, B0); PG8_BAR; PG8_SCHED;
            PG8_LDB(B1, 0, 1); PG8_STAGE(PG8_SB(0, 0), b2, voffB);
            PG8_BAR; PG8_WAIT_L(0); PG8_MMA(0, 1, At, B1); PG8_BAR;
            PG8_LDA(At, 0, 1); PG8_STAGE(PG8_SA(0, 0), a2, voffA);
            PG8_BAR; PG8_WAIT_L(0); PG8_MMA(1, 0, At, B0); PG8_BAR; PG8_SCHED;
            PG8_STAGE(PG8_SB(0, 1), b2 + hstep, voffB);
            PG8_WAIT_V(6); PG8_BAR; PG8_MMA(1, 1, At, B1); PG8_BAR;
            PG8_LDB(B0, 1, 0); PG8_SCHED; PG8_LDA(At, 1, 0); PG8_STAGE(PG8_SA(0, 1), a2 + hstep, voffA);
            PG8_WAIT_L(8); PG8_BAR; PG8_WAIT_L(0); PG8_MMA(0, 0, At, B0); PG8_BAR; PG8_SCHED;
            PG8_LDB(B1, 1, 1); PG8_STAGE(PG8_SB(1, 0), b3, voffB);
            PG8_BAR; PG8_WAIT_L(0); PG8_MMA(0, 1, At, B1); PG8_BAR;
            PG8_LDA(At, 1, 1); PG8_STAGE(PG8_SA(1, 0), a3, voffA);
            PG8_BAR; PG8_WAIT_L(0); PG8_MMA(1, 0, At, B0); PG8_BAR; PG8_SCHED;
            PG8_STAGE(PG8_SB(1, 1), b3 + hstep, voffB);
            PG8_WAIT_V(6); PG8_BAR; PG8_MMA(1, 1, At, B1); PG8_BAR;
            }
        }
        if constexpr (ALIGN_EPI) { if (wr == 0) PG8_BAR; }
        if constexpr (!Epi::AFTER_DRAIN) { E(acc, cur, wr, wc, fr, fq); S.done(cur); }
        if (!has_next) break;
#pragma unroll
        for (int a = 0; a < 2; ++a)
#pragma unroll
            for (int b = 0; b < 2; ++b)
#pragma unroll
                for (int m = 0; m < 4; ++m)
#pragma unroll
                    for (int n = 0; n < 2; ++n) acc[a][b][m][n] = (f32x4){0.f, 0.f, 0.f, 0.f};
        cur = nxt; cA = nA; cB = nB; ++ui;
        if constexpr (ALIGN_EPI) { if (wr == 1) PG8_BAR; }
    }
    PG8_WAIT_V(0);
    if constexpr (!ALIGN_EPI) { if (wr == 0) PG8_BAR; }
    PG8_BAR;
    if constexpr (Epi::AFTER_DRAIN) { E.fused(acc, cur, wr, wc, fr, fq, lds, wid, lane); S.done(cur); }
#undef PG8_SA
#undef PG8_SB
#undef PG8_STAGE
#undef PG8_LDA
#undef PG8_LDB
#undef PG8_MMA
#undef PG8_WAIT_V
#undef PG8_WAIT_L
#undef PG8_BAR
#undef PG8_SCHED
}
}
#define GAS __attribute__((address_space(1)))
#define LAS __attribute__((address_space(3)))
typedef unsigned short bf16;
typedef unsigned v4u __attribute__((ext_vector_type(4)));
typedef float f32x4 __attribute__((ext_vector_type(4)));
typedef short bf16x8 __attribute__((ext_vector_type(8)));
typedef GAS unsigned gu32;
typedef GAS unsigned long long gu64;
#define RLX_AGENT __ATOMIC_RELAXED, __HIP_MEMORY_SCOPE_AGENT
#define LDS_WAIT() asm volatile("s_waitcnt lgkmcnt(0)" ::: "memory")
#define VM_WAIT() asm volatile("s_waitcnt vmcnt(0)" ::: "memory")
__device__ __forceinline__ unsigned long long rt() { return __builtin_amdgcn_s_memrealtime(); }
__device__ __forceinline__ unsigned f2bf(float f) { unsigned u = __builtin_bit_cast(unsigned, f); return (u + 0x7fffu + ((u >> 16) & 1u)) >> 16; }
__device__ __forceinline__ unsigned pk2(float lo, float hi) { return f2bf(lo) | (f2bf(hi) << 16); }

#define XB_TMO      128
#define XB_XCNT(j)  (256  + 64 * (j))
#define XB_XSUB(j)  (1280 + 64 * (j))
#define XB_XGEN(j)  (2304 + 64 * (j))
#define XB_TOP      3328
#define XB_TOPGEN   3392
#define XCD_BAR_WORDS 3456
#define XB_SPIN_CAP (1u << 18)

__device__ __forceinline__ unsigned xb_ld(unsigned* p)              { return __hip_atomic_load(p, __ATOMIC_RELAXED, __HIP_MEMORY_SCOPE_AGENT); }
__device__ __forceinline__ unsigned xb_add(unsigned* p, unsigned v) { return __hip_atomic_fetch_add(p, v, __ATOMIC_RELAXED, __HIP_MEMORY_SCOPE_AGENT); }
__device__ __forceinline__ unsigned xb_xcc_id() { return (unsigned)__builtin_amdgcn_s_getreg((3 << 11) | 20) & 0xFu; }
#define XB_SPIN(cond, bar) do { unsigned _sp = 0; while (cond) { __builtin_amdgcn_s_sleep(1); \
    if ((++_sp & 255u) == 0u) { if (xb_ld(&(bar)[XB_TMO])) break; if (_sp > XB_SPIN_CAP) { atomicAdd(&(bar)[XB_TMO], 1u); break; } } } } while (0)

struct XcdBarrier {
    unsigned* bar; unsigned x;
    volatile LAS unsigned* st;
};

__device__ __forceinline__ XcdBarrier xcd_barrier_post(unsigned* bar, volatile LAS unsigned* st) {
    XcdBarrier b; b.bar = bar; b.x = xb_xcc_id(); b.st = st;
    if (threadIdx.x == 0) (void)xb_add(&bar[XB_XCNT(b.x)], 1u);
    return b;
}
__device__ __forceinline__ void xcd_barrier_complete(unsigned* bar, unsigned x, unsigned& nloc, unsigned& nx) {
    const unsigned G = gridDim.x * gridDim.y * gridDim.z;
    unsigned sum, cnt, mine, sp = 0u;
    for (;;) {
        sum = 0u; cnt = 0u; mine = 0u;
#pragma unroll
        for (unsigned j = 0; j < 16; ++j) { const unsigned c = xb_ld(&bar[XB_XCNT(j)]); sum += c; cnt += (c > 0u) ? 1u : 0u; mine = (j == x) ? c : mine; }
        if (sum == G) break;
        __builtin_amdgcn_s_sleep(1);
        if ((++sp & 255u) == 0u) { if (xb_ld(&bar[XB_TMO])) break; if (sp > XB_SPIN_CAP) { atomicAdd(&bar[XB_TMO], 1u); break; } }
    }
    nloc = mine > 0u ? mine : 1u; nx = cnt > 0u ? cnt : 1u;
}

__device__ __forceinline__ void xcd_barrier(const XcdBarrier& b) {
    asm volatile("s_waitcnt vmcnt(0)" ::: "memory");
    __syncthreads();
    if (threadIdx.x == 0) {
        unsigned* bar = b.bar;
        __builtin_amdgcn_s_waitcnt(0);
        unsigned nloc = b.st[0], nx = b.st[1];
        if (nloc == 0u) { xcd_barrier_complete(bar, b.x, nloc, nx); b.st[0] = nloc; b.st[1] = nx; }
        const unsigned old = xb_add(&bar[XB_XSUB(b.x)], 1u);
        const unsigned gen = old / nloc;
        if (old + 1u == (gen + 1u) * nloc) {
            __builtin_amdgcn_fence(__ATOMIC_RELEASE, "agent");
            asm volatile("s_waitcnt vmcnt(0)" ::: "memory");
            const unsigned og = xb_add(&bar[XB_TOP], 1u);
            const unsigned tg = og / nx;
            if (og + 1u == (tg + 1u) * nx) xb_add(&bar[XB_TOPGEN], 1u);
            else XB_SPIN(xb_ld(&bar[XB_TOPGEN]) == tg, bar);
            __builtin_amdgcn_fence(__ATOMIC_ACQUIRE, "agent");
            xb_add(&bar[XB_XGEN(b.x)], 1u);
            asm volatile("s_waitcnt vmcnt(0)" ::: "memory");
        } else {
            XB_SPIN(xb_ld(&bar[XB_XGEN(b.x)]) == gen, bar);
            __builtin_amdgcn_fence(__ATOMIC_ACQUIRE, "agent");
            asm volatile("s_waitcnt vmcnt(0)" ::: "memory");
        }
    }
    __syncthreads();
}
constexpr int NWAVES = 8, NTHREADS = 512;
constexpr int RING_BYTES = 131072, LDSCTL_OFF = RING_BYTES, MISC_OFF = LDSCTL_OFF + 320, LDS_BYTES = 147456;
typedef unsigned v2u __attribute__((ext_vector_type(2)));

#ifndef PH_MASK
#define PH_MASK 0xffff
#endif
struct Args { const float* in[27]; float* out; unsigned char* ws; };
enum { I_X = 0, I_META, I_F1PRE, I_F1POST, I_F1G, I_F1U, I_F1D, I_MIXPRE, I_MIXPOST, I_WIN, I_BIN, I_CONVW, I_CONVB, I_MNORM, I_MWB, I_LQ1, I_LK1, I_LQ2, I_LK2, I_ANORM, I_AWB, I_WOUT, I_F2PRE, I_F2POST, I_F2G, I_F2U, I_F2D };

__device__ __forceinline__ float wave_sum(float v) {
#pragma unroll
    for (int o = 1; o < 64; o <<= 1) v += __shfl_xor(v, o);
    return v;
}
__device__ __forceinline__ float bf2f(bf16 b) { return __uint_as_float(((unsigned)b) << 16); }

struct TrD { const float* src; bf16* dst; const float* sk; float scal; int ldw, K; };
__device__ __forceinline__ void tr_load(const TrD& d, int lane, f32x4 (&v)[8]) {
    const float* p = d.src + (size_t)(lane >> 3) * d.ldw + (lane & 7) * 4;
#pragma unroll
    for (int i = 0; i < 8; ++i) v[i] = *(const f32x4*)(p + (size_t)(8 * i) * d.ldw);
}
__device__ __forceinline__ void tr_finish(const TrD& d, int lane, const f32x4 (&v)[8], LAS float* scr) {
    const int r = lane >> 3, c4 = (lane & 7) * 4;
#pragma unroll
    for (int i = 0; i < 8; ++i) { const int k = 8 * i + r; const float s = d.sk ? d.sk[k] * d.scal : d.scal; LAS float* q = scr + k * 33 + c4;
        q[0] = v[i].x * s; q[1] = v[i].y * s; q[2] = v[i].z * s; q[3] = v[i].w * s; }
    LDS_WAIT(); asm volatile("" ::: "memory");
    const int c = lane & 7;
#pragma unroll
    for (int j = 0; j < 4; ++j) { const int n = (lane >> 3) + 8 * j; const LAS float* s = scr + (8 * c) * 33 + n;
        v4u o; o.x = pk2(s[0 * 33], s[1 * 33]); o.y = pk2(s[2 * 33], s[3 * 33]); o.z = pk2(s[4 * 33], s[5 * 33]); o.w = pk2(s[6 * 33], s[7 * 33]);
        *(GAS v4u*)(d.dst + (size_t)n * d.K + 8 * c) = o; }
    LDS_WAIT(); asm volatile("" ::: "memory");
}
#define CONVERT_LOOP(NITEMS, DESC) do { int it_ = gw; TrD cur_; f32x4 v_[8]; bool has_ = it_ < (NITEMS); if (has_) { DESC(it_, cur_); tr_load(cur_, lane, v_); } \
    while (has_) { const int nx_ = it_ + NGW; const bool hn_ = nx_ < (NITEMS); TrD nd_ = cur_; f32x4 w_[8]; if (hn_) { DESC(nx_, nd_); tr_load(nd_, lane, w_); } \
        tr_finish(cur_, lane, v_, scr); if (hn_) { cur_ = nd_; _Pragma("unroll") for (int q_ = 0; q_ < 8; ++q_) v_[q_] = w_[q_]; } it_ = nx_; has_ = hn_; } } while (0)

__device__ __forceinline__ void convert_ffn(const float* wg, const float* wu, const float* wd, const float* preg, bf16* WUP, bf16* WDN, LAS float* scr, int gw, int NGW, int lane) {
    constexpr int N_UP = (DM / 64) * (NUP / 32), N_DN = (DFF / 64) * (DM / 32);
#define DESC_FFN(it, D) do { if ((it) < N_UP) { const int nblk = NUP / 32, kb = (it) / nblk, nb = (it) % nblk, row0 = 32 * nb, pn = row0 >> 8, j = row0 & 255; \
            const float* src = (j < 128) ? wg : wu; const int col0 = 128 * pn + (j & 127); \
            D.src = src + (size_t)(64 * kb) * DFF + col0; D.dst = WUP + (size_t)row0 * DM + 64 * kb; D.sk = preg + 64 * kb; D.scal = 1.0f; D.ldw = DFF; D.K = DM; } \
        else { const int r = (it) - N_UP, nblk = DM / 32, kb = r / nblk, nb = r % nblk; \
            D.src = wd + (size_t)(64 * kb) * DM + 32 * nb; D.dst = WDN + (size_t)(32 * nb) * DFF + 64 * kb; D.sk = nullptr; D.scal = 1.0f; D.ldw = DM; D.K = DFF; } } while (0)
    CONVERT_LOOP(N_UP + N_DN, DESC_FFN);
#undef DESC_FFN
}

__device__ __forceinline__ void sincos_small(double r, double& s, double& c) {
    const double r2 = r * r; double ts = 1.0, tc = 1.0;
#pragma unroll
    for (int k = 13; k >= 1; --k) { ts = 1.0 - ts * r2 / (double)((2 * k) * (2 * k + 1)); tc = 1.0 - tc * r2 / (double)((2 * k - 1) * (2 * k)); }
    s = r * ts; c = tc;
}

__device__ __forceinline__ void load_row(const float* p, int lane, f32x4 (&v)[8]) {
    const GAS f32x4* r = (const GAS f32x4*)p + lane;
#pragma unroll
    for (int j = 0; j < 8; ++j) v[j] = r[64 * j];
}
__device__ __forceinline__ float row_ssq(const f32x4 (&v)[8]) {
    float s = 0.f;
#pragma unroll
    for (int j = 0; j < 8; ++j) s += (v[j].x * v[j].x + v[j].y * v[j].y) + (v[j].z * v[j].z + v[j].w * v[j].w);
    return wave_sum(s);
}
__device__ __forceinline__ void store_row_bf16(bf16* p, int lane, const f32x4 (&v)[8], float sc) {
    GAS v2u* o = (GAS v2u*)p + lane;
#pragma unroll
    for (int j = 0; j < 8; ++j) { v2u w; w.x = pk2(v[j].x * sc, v[j].y * sc); w.y = pk2(v[j].z * sc, v[j].w * sc); o[64 * j] = w; }
}

__device__ __forceinline__ float log_sigmoid(float x) { return fminf(x, 0.f) - log1pf(__expf(-fabsf(x))); }

namespace fa {
typedef float f32x16 __attribute__((ext_vector_type(16)));
typedef short s16x4 __attribute__((ext_vector_type(4)));
typedef short v4i16_t __attribute__((ext_vector_type(4)));
constexpr int NSLOT = 4, KSLOT = 8192, VSLOT = 16384;
constexpr int L_K = 0, L_V = NSLOT * KSLOT, L_WS = L_V + NSLOT * VSLOT, L_END = L_WS + 8 * 256;
constexpr float THR = 8.0f;
__device__ __forceinline__ int crow(int r, int hi) { return (r & 3) + 8 * (r >> 2) + 4 * hi; }
__device__ __forceinline__ s16x4 vtr(const LAS unsigned char* p) { return __builtin_bit_cast(s16x4, __builtin_amdgcn_ds_read_tr16_b64_v4i16((LAS v4i16_t*)p)); }
__device__ __forceinline__ unsigned cvtpk(float lo, float hi) { typedef float f2 __attribute__((ext_vector_type(2))); typedef __bf16 b2 __attribute__((ext_vector_type(2))); f2 v = {lo, hi}; b2 b = __builtin_convertvector(v, b2); return __builtin_bit_cast(unsigned, b); }
#define FA_MX3(a, b, c) __builtin_fmaxf(__builtin_fmaxf((a), (b)), (c))
#define FA_BAR() asm volatile("s_barrier" ::: "memory")

__device__ __forceinline__ void attn_unit(LAS unsigned char* lds, int sh, int qb, const bf16* AQ, const bf16* AK, const bf16* AV, bf16* OS) {
    int tid_ = threadIdx.x; asm volatile("" : "+v"(tid_));
    const int tid = tid_, lane = tid & 63, r32 = lane & 31, hi = lane >> 5, wid = __builtin_amdgcn_readfirstlane(tid >> 6);
    const int hh = sh >> 1, NT = 4 * qb + 5;
    const int rb = 2 * (wid & 3) + (wid >> 2);
    const int cqw = 4 * qb + 1 + (rb >> 1);
    const int qrow0 = ROW_X0 + 256 * qb + 32 * rb;
    bf16x8 qr[4];
    { const bf16* Qw = AQ + (size_t)(qrow0 + r32) * 1024 + sh * 64 + hi * 8;
#pragma unroll
      for (int d0 = 0; d0 < 4; ++d0) qr[d0] = *(const bf16x8*)(Qw + d0 * 16); }
    const bf16* ksrc = AK + (size_t)(ROW_PAD0 + lane) * 1024 + sh * 64 + wid * 8;
    const bf16* vsrc = AV + (size_t)(ROW_PAD0 + 32 * (wid & 1) + (lane >> 2)) * 1024 + hh * 128 + (wid >> 1) * 32 + (lane & 3) * 8;
    LAS float* wsf = (LAS float*)(lds + L_WS) + wid * 64;
    const LAS unsigned char* kbase = lds + L_K + hi * 1024 + r32 * 16;
    const LAS unsigned char* vbase = lds + L_V + ((lane >> 4) & 1) * 32 + (lane & 3) * 8 + (4 * hi + ((lane & 15) >> 2)) * 64;
#define FA_DMA(t) do { const size_t go_ = (size_t)(t) * 65536; const int sl_ = (t) & (NSLOT - 1); \
        __builtin_amdgcn_global_load_lds((const unsigned*)(ksrc + go_), (LAS unsigned*)(lds + L_K + sl_ * KSLOT + wid * 1024), 16, 0, 0); \
        __builtin_amdgcn_global_load_lds((const unsigned*)(vsrc + go_), (LAS unsigned*)(lds + L_V + sl_ * VSLOT + wid * 2048), 16, 0, 0); \
        __builtin_amdgcn_global_load_lds((const unsigned*)(vsrc + go_ + 16 * 1024), (LAS unsigned*)(lds + L_V + sl_ * VSLOT + wid * 2048 + 1024), 16, 0, 0); } while (0)
    f32x16 o[4];
#pragma unroll
    for (int d0 = 0; d0 < 4; ++d0)
#pragma unroll
        for (int r = 0; r < 16; ++r) o[d0][r] = 0.f;
    f32x16 negm;
#pragma unroll
    for (int r = 0; r < 16; ++r) negm[r] = 0.f;
    float m = 0.f, l = 0.f;
    asm volatile("s_waitcnt vmcnt(0)" ::: "memory");
    FA_DMA(0); FA_DMA(1);
    asm volatile("s_waitcnt vmcnt(3)" ::: "memory");
    if (wid >= 4) FA_BAR();
    FA_BAR();
    for (int t = 0; t < NT; ++t) {
        const int sl = t & (NSLOT - 1);
        if (t + 2 < NT) FA_DMA(t + 2);
        v4u pw[4];
        if (t <= cqw) {
            const LAS unsigned char* kp = kbase + sl * KSLOT;
            f32x16 p0, p1;
            { const bf16x8 k0 = *(const LAS bf16x8*)(kp), k1 = *(const LAS bf16x8*)(kp + 512);
              p0 = __builtin_amdgcn_mfma_f32_32x32x16_bf16(k0, qr[0], negm, 0, 0, 0);
              p1 = __builtin_amdgcn_mfma_f32_32x32x16_bf16(k1, qr[0], negm, 0, 0, 0); }
#pragma unroll
            for (int d0 = 1; d0 < 4; ++d0) {
                const bf16x8 k0 = *(const LAS bf16x8*)(kp + d0 * 2048), k1 = *(const LAS bf16x8*)(kp + d0 * 2048 + 512);
                p0 = __builtin_amdgcn_mfma_f32_32x32x16_bf16(k0, qr[d0], p0, 0, 0, 0);
                p1 = __builtin_amdgcn_mfma_f32_32x32x16_bf16(k1, qr[d0], p1, 0, 0, 0); }
            if (t == 0) {
#pragma unroll
                for (int r = 0; r < 16; ++r) p0[r] = -INFINITY;
#pragma unroll
                for (int r = 0; r < 8; ++r) p1[r] = -INFINITY;
                float rm = FA_MX3(p1[8], p1[9], p1[10]); rm = FA_MX3(rm, p1[11], p1[12]); rm = FA_MX3(rm, p1[13], p1[14]); rm = __builtin_fmaxf(rm, p1[15]);
                { auto rr = __builtin_amdgcn_permlane32_swap(__float_as_uint(rm), __float_as_uint(rm), false, false); rm = __builtin_fmaxf(__uint_as_float(rr[0]), __uint_as_float(rr[1])); }
                m = rm;
#pragma unroll
                for (int r = 8; r < 16; ++r) p1[r] -= rm;
#pragma unroll
                for (int r = 0; r < 16; ++r) negm[r] = -m;
            } else {
                float a = FA_MX3(p0[0], p0[1], p1[0]), b = FA_MX3(p0[2], p0[3], p1[1]); a = FA_MX3(a, p1[2], p1[3]);
#pragma unroll
                for (int r = 4; r < 16; r += 4) { a = FA_MX3(a, p0[r], p0[r + 1]); b = FA_MX3(b, p0[r + 2], p0[r + 3]); a = FA_MX3(a, p1[r], p1[r + 1]); b = FA_MX3(b, p1[r + 2], p1[r + 3]); }
                float rm = __builtin_fmaxf(a, b);
                { auto rr = __builtin_amdgcn_permlane32_swap(__float_as_uint(rm), __float_as_uint(rm), false, false); rm = __builtin_fmaxf(__uint_as_float(rr[0]), __uint_as_float(rr[1])); }
                if (__builtin_expect(__any(rm > THR), 0)) {
                    const float dl = __builtin_fmaxf(rm, 0.f); m += dl;
#pragma unroll
                    for (int r = 0; r < 16; ++r) { p0[r] -= dl; p1[r] -= dl; negm[r] = -m; }
                    const float f = __builtin_amdgcn_exp2f(-dl); l *= f;
                    if (hi == 0) wsf[r32] = f;
#pragma unroll
                    for (int r = 0; r < 16; ++r) { const float a2 = wsf[crow(r, hi)];
#pragma unroll
                        for (int d0 = 0; d0 < 4; ++d0) o[d0][r] *= a2; }
                }
            }
            float ls0 = 0.f, ls1 = 0.f;
#pragma unroll
            for (int r = 0; r < 16; ++r) { p0[r] = __builtin_amdgcn_exp2f(p0[r]); p1[r] = __builtin_amdgcn_exp2f(p1[r]); ls0 += p0[r]; ls1 += p1[r]; }
            l += ls0 + ls1;
#pragma unroll
            for (int i = 0; i < 4; ++i) { pw[0][i] = cvtpk(p0[2 * i], p0[2 * i + 1]); pw[1][i] = cvtpk(p0[8 + 2 * i], p0[8 + 2 * i + 1]); pw[2][i] = cvtpk(p1[2 * i], p1[2 * i + 1]); pw[3][i] = cvtpk(p1[8 + 2 * i], p1[8 + 2 * i + 1]); }
        }
        if (t + 2 < NT) asm volatile("s_waitcnt vmcnt(3) lgkmcnt(0)" ::: "memory"); else asm volatile("s_waitcnt vmcnt(0) lgkmcnt(0)" ::: "memory");
        FA_BAR();
        if (t <= cqw) {
            const LAS unsigned char* vp = vbase + sl * VSLOT;
#pragma unroll
            for (int d0 = 0; d0 < 4; ++d0)
#pragma unroll
                for (int ks = 0; ks < 4; ++ks) {
                    const s16x4 lo = vtr(vp + d0 * 4096 + ks * 1024), hi4 = vtr(vp + d0 * 4096 + ks * 1024 + 512);
                    const bf16x8 vf = (bf16x8){lo[0], lo[1], lo[2], lo[3], hi4[0], hi4[1], hi4[2], hi4[3]};
                    o[d0] = __builtin_amdgcn_mfma_f32_32x32x16_bf16(__builtin_bit_cast(bf16x8, pw[ks]), vf, o[d0], 0, 0, 0); }
        }
        asm volatile("s_waitcnt lgkmcnt(0)" ::: "memory");
        FA_BAR();
    }
    if (wid < 4) FA_BAR();
    { auto rr = __builtin_amdgcn_permlane32_swap(__float_as_uint(l), __float_as_uint(l), false, false); l = __uint_as_float(rr[0]) + __uint_as_float(rr[1]); }
    if (hi == 0) wsf[32 + r32] = l;
    bf16* Ow = OS + (size_t)qrow0 * 2048 + sh * 128 + r32;
#pragma unroll
    for (int r = 0; r < 16; ++r) { const float rl = __builtin_amdgcn_rcpf(wsf[32 + crow(r, hi)]); bf16* op = Ow + (size_t)crow(r, hi) * 2048;
#pragma unroll
        for (int d0 = 0; d0 < 4; ++d0) op[d0 * 32] = (bf16)f2bf(o[d0][r] * rl); }
    asm volatile("s_waitcnt lgkmcnt(0)" ::: "memory");
    FA_BAR();
#undef FA_DMA
}
}
namespace ml {
typedef float f32x16 __attribute__((ext_vector_type(16)));
typedef short s16x4 __attribute__((ext_vector_type(4)));
constexpr int L_QI = 0, L_KI = 16384, L_VI = 32768, L_SM = 69632, HL_LD = 260;
constexpr int S_WJ = 0, S_US = 64, S_TS = 128, S_WINT = 192, S_EMR = 256, S_RS = 320, S_DINV = 384, S_QN = 448;
__device__ __forceinline__ float wave_scan_add(float v, int lane) {
#pragma unroll
    for (int o = 1; o < 64; o <<= 1) { const float t = __shfl_up(v, o); if (lane >= o) v += t; }
    return v;
}
__device__ __forceinline__ float wave_scan_max(float v, int lane) {
#pragma unroll
    for (int o = 1; o < 64; o <<= 1) { const float t = __shfl_up(v, o); if (lane >= o) v = fmaxf(v, t); }
    return v;
}
__device__ __forceinline__ float wave_max(float v) {
#pragma unroll
    for (int o = 1; o < 64; o <<= 1) v = fmaxf(v, __shfl_xor(v, o));
    return v;
}
__device__ __forceinline__ void conv16(const bf16* QK, const float* cw, const float* cb, int R, int cc0, float (&out)[16]) {
    float a[16];
#pragma unroll
    for (int q = 0; q < 4; ++q) { const f32x4 b = *(const f32x4*)(cb + cc0 + 4 * q); a[4 * q] = b.x; a[4 * q + 1] = b.y; a[4 * q + 2] = b.z; a[4 * q + 3] = b.w; }
#pragma unroll
    for (int jj = 0; jj < 4; ++jj) { const int Rr = R - 3 + jj;
        if (Rr >= ROW_META0) { const v4u x0 = *(const v4u*)(QK + (size_t)Rr * 1024 + cc0), x1 = *(const v4u*)(QK + (size_t)Rr * 1024 + cc0 + 8);
            const unsigned xw[8] = {x0.x, x0.y, x0.z, x0.w, x1.x, x1.y, x1.z, x1.w};
#pragma unroll
            for (int q = 0; q < 4; ++q) { const f32x4 w = *(const f32x4*)(cw + jj * 1024 + cc0 + 4 * q);
                a[4 * q] += w.x * pg8::bflo(xw[2 * q]); a[4 * q + 1] += w.y * pg8::bfhi(xw[2 * q]); a[4 * q + 2] += w.z * pg8::bflo(xw[2 * q + 1]); a[4 * q + 3] += w.w * pg8::bfhi(xw[2 * q + 1]); } } }
#pragma unroll
    for (int i = 0; i < 16; ++i) out[i] = a[i] * pg8::sigm(a[i]);
}
__device__ __forceinline__ s16x4 vtr(const LAS unsigned char* p) { return __builtin_bit_cast(s16x4, __builtin_amdgcn_ds_read_tr16_b64_v4i16((LAS fa::v4i16_t*)p)); }
#define ML_FRAG(base, off) ({ const s16x4 lo_ = ml::vtr((base) + (off)), hi_ = ml::vtr((base) + (off) + 512); (bf16x8){lo_[0], lo_[1], lo_[2], lo_[3], hi_[0], hi_[1], hi_[2], hi_[3]}; })

__device__ __forceinline__ void v_dma(LAS unsigned char* lds, const bf16* MV, int R0, int h, int wid, int lane) {
#pragma unroll
    for (int i = 0; i < 4; ++i)
        __builtin_amdgcn_global_load_lds((const unsigned*)(MV + (size_t)(R0 + 16 * i + (lane >> 2)) * 1024 + h * 256 + wid * 32 + (lane & 3) * 8), (LAS unsigned*)(lds + L_VI + (4 * wid + i) * 1024), 16, 0, 0);
}

__device__ __forceinline__ void stepA(LAS unsigned char* lds, int c, int h, const bf16* QK, const bf16* MV, const float* GATES, const float* cw, const float* cb, float* DCT, float* DN, float* MSC) {
    int tid_ = threadIdx.x; asm volatile("" : "+v"(tid_));
    const int tid = tid_, lane = tid & 63, r32 = lane & 31, hi = lane >> 5, wid = __builtin_amdgcn_readfirstlane(tid >> 6);
    const int R0 = ROW_PAD0 + 64 * c; LAS float* sm = (LAS float*)(lds + L_SM);
    if (wid == 0) { const int R = R0 + lane; const float li = GATES[(size_t)R * 8 + h], lf = GATES[(size_t)R * 8 + 4 + h];
        const float b = wave_scan_add(lf, lane), g = __shfl(b, 63), a = g - b + li, mloc = wave_max(a);
        sm[S_WJ + lane] = __expf(a - mloc);
        if (lane == 0) { MSC[(c * 4 + h) * 4 + 0] = g; MSC[(c * 4 + h) * 4 + 1] = mloc; } }
    v_dma(lds, MV, R0, h, wid, lane);
    __syncthreads();
    { const int j = tid >> 3, part = tid & 7, R = R0 + j; float kv[16];
      if (R >= ROW_META0) { conv16(QK, cw, cb, R, 512 + h * 128 + part * 16, kv); const float s = 0.08838834764831845f * sm[S_WJ + j];
#pragma unroll
          for (int i = 0; i < 16; ++i) kv[i] *= s; }
      else {
#pragma unroll
          for (int i = 0; i < 16; ++i) kv[i] = 0.f; }
      v4u w0, w1; w0.x = pk2(kv[0], kv[1]); w0.y = pk2(kv[2], kv[3]); w0.z = pk2(kv[4], kv[5]); w0.w = pk2(kv[6], kv[7]); w1.x = pk2(kv[8], kv[9]); w1.y = pk2(kv[10], kv[11]); w1.z = pk2(kv[12], kv[13]); w1.w = pk2(kv[14], kv[15]);
      LAS unsigned char* kp = lds + L_KI + (part >> 1) * 4096 + j * 64 + (part & 1) * 32;
      *(LAS v4u*)kp = w0; *(LAS v4u*)(kp + 16) = w1; }
    asm volatile("s_waitcnt vmcnt(0) lgkmcnt(0)" ::: "memory");
    __syncthreads();
    { const LAS unsigned char* tb = lds + ((lane >> 4) & 1) * 32 + (lane & 3) * 8 + (4 * hi + ((lane & 15) >> 2)) * 64;
      bf16x8 af[4];
#pragma unroll
      for (int s = 0; s < 4; ++s) af[s] = ML_FRAG(tb + L_VI + wid * 4096, s * 1024);
      float* outp = DCT + ((size_t)(c * 4 + h) * 256 + wid * 32) * 128 + r32;
#pragma unroll
      for (int db = 0; db < 4; ++db) { f32x16 acc;
#pragma unroll
          for (int r = 0; r < 16; ++r) acc[r] = 0.f;
#pragma unroll
          for (int s = 0; s < 4; ++s) { const bf16x8 bfr = ML_FRAG(tb + L_KI + db * 4096, s * 1024); acc = __builtin_amdgcn_mfma_f32_32x32x16_bf16(af[s], bfr, acc, 0, 0, 0); }
#pragma unroll
          for (int r = 0; r < 16; ++r) outp[(size_t)fa::crow(r, hi) * 128 + db * 32] = acc[r]; } }
    if (tid < 128) { const int d = tid; const LAS unsigned char* kp = lds + L_KI + (d >> 5) * 4096 + (d & 31) * 2; float s = 0.f;
#pragma unroll 8
        for (int j = 0; j < 64; ++j) s += bf2f(*(const LAS bf16*)(kp + j * 64));
        DN[(size_t)(c * 4 + h) * 128 + d] = s; }
    __syncthreads();
}

__device__ __forceinline__ void stepB(int gtid, int ngt, const float* DCT, const float* DN, float* MSC, bf16* CT, float* NPREV) {
    for (int idx = gtid; idx < 4 * 32768; idx += ngt) { const int h = idx >> 15, ed = idx & 32767; const bool isn = ed < 128;
        float C = 0.f, n = 0.f, m = 0.f;
        for (int c0 = 0; c0 < 128; c0 += 8) { float dc[8], dn[8], gg[8], ml_[8];
#pragma unroll
            for (int u = 0; u < 8; ++u) { const int c = c0 + u; dc[u] = DCT[(size_t)(c * 4 + h) * 32768 + ed]; dn[u] = isn ? DN[(size_t)(c * 4 + h) * 128 + ed] : 0.f; gg[u] = MSC[(c * 4 + h) * 4]; ml_[u] = MSC[(c * 4 + h) * 4 + 1]; }
#pragma unroll
            for (int u = 0; u < 8; ++u) { const int c = c0 + u; const float mn = fmaxf(gg[u] + m, ml_[u]), dec = __expf(gg[u] + m - mn), sc = __expf(ml_[u] - mn);
                C = dec * C + sc * dc[u]; n = dec * n + sc * dn[u]; m = mn;
                CT[(size_t)((c + 1) * 4 + h) * 32768 + ed] = (bf16)f2bf(C);
                if (isn) NPREV[(size_t)((c + 1) * 4 + h) * 128 + ed] = n;
                if (ed == 0) MSC[((c + 1) * 4 + h) * 4 + 2] = m; } }
    }
}

__device__ __forceinline__ void stepC(LAS unsigned char* lds, int c, int h, const bf16* QK, const bf16* MV, const bf16* MO, const float* GATES, const float* cw, const float* cb, const bf16* CT, const float* NPREV, const float* MSC, bf16* HMG) {
    int tid_ = threadIdx.x; asm volatile("" : "+v"(tid_));
    const int tid = tid_, lane = tid & 63, r32 = lane & 31, hi = lane >> 5, wid = __builtin_amdgcn_readfirstlane(tid >> 6);
    const int R0 = ROW_PAD0 + 64 * c; LAS float* sm = (LAS float*)(lds + L_SM);
    if (wid == 0) { const int R = R0 + lane; const float li = GATES[(size_t)R * 8 + h], lf = GATES[(size_t)R * 8 + 4 + h], mprev = MSC[(c * 4 + h) * 4 + 2];
        const float b = wave_scan_add(lf, lane), u = li - b, pm = wave_scan_max(u, lane), mrow = b + fmaxf(mprev, pm);
        sm[S_US + lane] = u; sm[S_TS + lane] = b - mrow; sm[S_WINT + lane] = __expf(b + mprev - mrow); sm[S_EMR + lane] = __expf(-mrow); }
    v_dma(lds, MV, R0, h, wid, lane);
    { const int j = tid >> 3, part = tid & 7, R = R0 + j; float qv[16], kv[16];
      conv16(QK, cw, cb, R, h * 128 + part * 16, qv); conv16(QK, cw, cb, R, 512 + h * 128 + part * 16, kv);
      const float* np = NPREV + (size_t)(c * 4 + h) * 128 + part * 16; float qn = 0.f;
#pragma unroll
      for (int q = 0; q < 4; ++q) { const f32x4 nv = *(const f32x4*)(np + 4 * q); qn += (qv[4 * q] * nv.x + qv[4 * q + 1] * nv.y) + (qv[4 * q + 2] * nv.z + qv[4 * q + 3] * nv.w); }
      sm[S_QN + part * 64 + j] = qn;
#pragma unroll
      for (int i = 0; i < 16; ++i) kv[i] *= 0.08838834764831845f;
      v4u w0, w1; w0.x = pk2(qv[0], qv[1]); w0.y = pk2(qv[2], qv[3]); w0.z = pk2(qv[4], qv[5]); w0.w = pk2(qv[6], qv[7]); w1.x = pk2(qv[8], qv[9]); w1.y = pk2(qv[10], qv[11]); w1.z = pk2(qv[12], qv[13]); w1.w = pk2(qv[14], qv[15]);
      *(LAS v4u*)(lds + L_QI + (2 * part) * 1024 + j * 16) = w0; *(LAS v4u*)(lds + L_QI + (2 * part + 1) * 1024 + j * 16) = w1;
      w0.x = pk2(kv[0], kv[1]); w0.y = pk2(kv[2], kv[3]); w0.z = pk2(kv[4], kv[5]); w0.w = pk2(kv[6], kv[7]); w1.x = pk2(kv[8], kv[9]); w1.y = pk2(kv[10], kv[11]); w1.z = pk2(kv[12], kv[13]); w1.w = pk2(kv[14], kv[15]);
      *(LAS v4u*)(lds + L_KI + (2 * part) * 1024 + j * 16) = w0; *(LAS v4u*)(lds + L_KI + (2 * part + 1) * 1024 + j * 16) = w1; }
    asm volatile("s_waitcnt vmcnt(0) lgkmcnt(0)" ::: "memory");
    __syncthreads();
    const int ib = wid & 1, ep = wid >> 1;
    f32x16 acc[2];
    {
        bf16x8 qf[8];
#pragma unroll
        for (int s = 0; s < 8; ++s) qf[s] = *(const LAS bf16x8*)(lds + L_QI + (2 * s + hi) * 1024 + (32 * ib + r32) * 16);
#pragma unroll
        for (int eb = 0; eb < 2; ++eb) {
#pragma unroll
            for (int r = 0; r < 16; ++r) acc[eb][r] = 0.f;
            const bf16* cp = CT + ((size_t)(c * 4 + h) * 256 + (2 * ep + eb) * 32 + r32) * 128 + 8 * hi;
#pragma unroll
            for (int s = 0; s < 8; ++s) { const bf16x8 cf = *(const bf16x8*)(cp + 16 * s); acc[eb] = __builtin_amdgcn_mfma_f32_32x32x16_bf16(qf[s], cf, acc[eb], 0, 0, 0); } }
#pragma unroll
        for (int r = 0; r < 16; ++r) { const float wv = sm[S_WINT + 32 * ib + fa::crow(r, hi)]; acc[0][r] *= wv; acc[1][r] *= wv; }
        f32x16 p0, p1;
#pragma unroll
        for (int r = 0; r < 16; ++r) { p0[r] = 0.f; p1[r] = 0.f; }
#pragma unroll
        for (int s = 0; s < 8; ++s) { const bf16x8 k0 = *(const LAS bf16x8*)(lds + L_KI + (2 * s + hi) * 1024 + r32 * 16); p0 = __builtin_amdgcn_mfma_f32_32x32x16_bf16(k0, qf[s], p0, 0, 0, 0); }
        if (ib == 1) {
#pragma unroll
            for (int s = 0; s < 8; ++s) { const bf16x8 k1 = *(const LAS bf16x8*)(lds + L_KI + (2 * s + hi) * 1024 + (32 + r32) * 16); p1 = __builtin_amdgcn_mfma_f32_32x32x16_bf16(k1, qf[s], p1, 0, 0, 0); } }
        const int i = 32 * ib + r32; const float ti = sm[S_TS + i]; float rs = 0.f;
#pragma unroll
        for (int r = 0; r < 16; ++r) { const int j = fa::crow(r, hi);
            p0[r] = (j <= i) ? p0[r] * __expf(ti + sm[S_US + j]) : 0.f;
            p1[r] = (ib == 1 && j + 32 <= i) ? p1[r] * __expf(ti + sm[S_US + j + 32]) : 0.f;
            rs += p0[r] + p1[r]; }
        { auto rr = __builtin_amdgcn_permlane32_swap(__float_as_uint(rs), __float_as_uint(rs), false, false); rs = __uint_as_float(rr[0]) + __uint_as_float(rr[1]); }
        if (ep == 0 && hi == 0) sm[S_RS + i] = rs;
        v4u pw[4];
#pragma unroll
        for (int q = 0; q < 4; ++q) { pw[0][q] = pg8::cvt_pk_bf16(p0[2 * q], p0[2 * q + 1]); pw[1][q] = pg8::cvt_pk_bf16(p0[8 + 2 * q], p0[8 + 2 * q + 1]); pw[2][q] = pg8::cvt_pk_bf16(p1[2 * q], p1[2 * q + 1]); pw[3][q] = pg8::cvt_pk_bf16(p1[8 + 2 * q], p1[8 + 2 * q + 1]); }
        const LAS unsigned char* tb = lds + L_VI + ((lane >> 4) & 1) * 32 + (lane & 3) * 8 + (4 * hi + ((lane & 15) >> 2)) * 64;
#pragma unroll
        for (int eb = 0; eb < 2; ++eb) {
#pragma unroll
            for (int ks = 0; ks < 2; ++ks) { const bf16x8 vf = ML_FRAG(tb + (2 * ep + eb) * 4096, ks * 1024); acc[eb] = __builtin_amdgcn_mfma_f32_32x32x16_bf16(__builtin_bit_cast(bf16x8, pw[ks]), vf, acc[eb], 0, 0, 0); }
            if (ib == 1) {
#pragma unroll
                for (int ks = 2; ks < 4; ++ks) { const bf16x8 vf = ML_FRAG(tb + (2 * ep + eb) * 4096, ks * 1024); acc[eb] = __builtin_amdgcn_mfma_f32_32x32x16_bf16(__builtin_bit_cast(bf16x8, pw[ks]), vf, acc[eb], 0, 0, 0); } } }
    }
    __syncthreads();
    if (tid < 64) { float qn = 0.f;
#pragma unroll
        for (int p = 0; p < 8; ++p) qn += sm[S_QN + p * 64 + tid];
        const float den = sm[S_WINT + tid] * qn + sm[S_RS + tid]; sm[S_DINV + tid] = 1.0f / fmaxf(fabsf(den), sm[S_EMR + tid]); }
    __syncthreads();
    { LAS float* HL = (LAS float*)lds;
#pragma unroll
      for (int r = 0; r < 16; ++r) { const int i = 32 * ib + fa::crow(r, hi); const float dv = sm[S_DINV + i];
          HL[i * HL_LD + (2 * ep) * 32 + r32] = acc[0][r] * dv; HL[i * HL_LD + (2 * ep + 1) * 32 + r32] = acc[1][r] * dv; } }
    __syncthreads();
    { const LAS float* HL = (const LAS float*)lds; const int i = tid >> 3, part = tid & 7; f32x4 v[8]; float ss = 0.f;
#pragma unroll
      for (int k = 0; k < 8; ++k) { v[k] = *(const LAS f32x4*)(HL + i * HL_LD + 32 * k + 4 * part); ss += (v[k].x * v[k].x + v[k].y * v[k].y) + (v[k].z * v[k].z + v[k].w * v[k].w); }
      ss += __shfl_xor(ss, 1); ss += __shfl_xor(ss, 2); ss += __shfl_xor(ss, 4);
      const float rs = 1.0f / sqrtf(ss * (1.0f / 256.0f) + EPS);
      const size_t go = (size_t)(R0 + i) * 1024 + h * 256 + 4 * part;
#pragma unroll
      for (int k = 0; k < 8; ++k) { const v2u mo = *(const v2u*)(MO + go + 32 * k);
          v2u w; w.x = pk2(v[k].x * rs * pg8::bflo(mo.x), v[k].y * rs * pg8::bfhi(mo.x)); w.y = pk2(v[k].z * rs * pg8::bflo(mo.y), v[k].w * rs * pg8::bfhi(mo.y));
          *(v2u*)(HMG + go + 32 * k) = w; } }
    __syncthreads();
}
}
namespace sk {
template <int NS> __device__ __forceinline__ f32x4 mma(const bf16* A, int lda, const bf16* W, int ldw, int lane) {
    const bf16* ap = A + (size_t)(lane & 15) * lda + 8 * (lane >> 4); const bf16* wp = W + (size_t)(lane & 15) * ldw + 8 * (lane >> 4);
    bf16x8 a[NS], b[NS];
#pragma unroll
    for (int s = 0; s < NS; ++s) { a[s] = *(const bf16x8*)(ap + 32 * s); b[s] = *(const bf16x8*)(wp + 32 * s); }
    f32x4 acc = {0.f, 0.f, 0.f, 0.f};
#pragma unroll
    for (int s = 0; s < NS; ++s) acc = __builtin_amdgcn_mfma_f32_16x16x32_bf16(a[s], b[s], acc, 0, 0, 0);
    return acc;
}
__device__ __forceinline__ void put(LAS float* red, int wid, int lane, f32x4 acc) {
    red[wid * 256 + lane] = acc.x; red[wid * 256 + 64 + lane] = acc.y; red[wid * 256 + 128 + lane] = acc.z; red[wid * 256 + 192 + lane] = acc.w;
}
__device__ __forceinline__ int eidx(int r, int c) { return (r & 3) * 64 + (r >> 2) * 16 + c; }

__device__ __forceinline__ void up_task(LAS float* red, int ht, const bf16* XA, const bf16* WUP, bf16* HID, int tid, int wid, int lane) {
    const int h0 = 16 * ht, pn = h0 >> 7, j = h0 & 127, which = wid & 1, ks = wid >> 1;
    const f32x4 acc = mma<16>(XA + (size_t)ROW_META0 * DM + 512 * ks, DM, WUP + (size_t)(256 * pn + 128 * which + j) * DM + 512 * ks, DM, lane);
    put(red, wid, lane, acc);
    __syncthreads();
    if (tid < 256) { const int r = tid >> 4, c = tid & 15, e = eidx(r, c); float g = 0.f, u = 0.f;
#pragma unroll
        for (int k = 0; k < 4; ++k) { g += red[(2 * k) * 256 + e]; u += red[(2 * k + 1) * 256 + e]; }
        HID[(size_t)(ROW_META0 + r) * DFF + h0 + c] = (bf16)f2bf(g * pg8::sigm(g) * u); }
    __syncthreads();
}
__device__ __forceinline__ void down_task(LAS float* red, int task, const bf16* HID, const bf16* WDN, float* YM, int tid, int wid, int lane) {
    const int ct = task >> 1, kh = task & 1, k0 = 2816 * kh + 352 * wid;
    const f32x4 acc = mma<11>(HID + (size_t)ROW_META0 * DFF + k0, DFF, WDN + (size_t)(16 * ct) * DFF + k0, DFF, lane);
    put(red, wid, lane, acc);
    __syncthreads();
    if (tid < 256) { const int r = tid >> 4, c = tid & 15, e = eidx(r, c); float s = 0.f;
#pragma unroll
        for (int k = 0; k < 8; ++k) s += red[k * 256 + e];
        YM[(size_t)(kh * 16 + r) * DM + 16 * ct + c] = s; }
    __syncthreads();
}
__device__ __forceinline__ void in_task(LAS float* red, int task, const bf16* XA, const bf16* WIN, const float* BIAS, const float* ROPE, bf16* Z, int tid, int wid, int lane) {
    const int col0 = (task < 128) ? 16 * task : 4096 + 16 * (task - 128);
    const f32x4 acc = mma<8>(XA + (size_t)ROW_META0 * DM + 256 * wid, DM, WIN + (size_t)col0 * DM + 256 * wid, DM, lane);
    put(red, wid, lane, acc);
    __syncthreads();
    LAS float* til = red + 8 * 256;
    if (tid < 256) { const int r = tid >> 4, c = tid & 15, e = eidx(r, c); float s = 0.f;
#pragma unroll
        for (int k = 0; k < 8; ++k) s += red[k * 256 + e];
        til[r * 16 + c] = s + BIAS[col0 + c]; }
    __syncthreads();
    if (tid < 256) { const int r = tid >> 4, c = tid & 15; float v = til[r * 16 + c];
        const int piece = col0 >> 10, pc = col0 & 1023;
        if (piece == 4 && (pc & 63) == 0) {
            const float o = til[r * 16 + (c ^ 8)]; const int i = c & 7; const float cs = ROPE[r * 16 + i], sn = ROPE[r * 16 + 8 + i];
            v = (c < 8) ? (v * cs - o * sn) : (v * cs + o * sn); }
        Z[(size_t)piece * ZPIECE + (size_t)(ROW_META0 + r) * 1024 + pc + c] = (bf16)f2bf(v); }
    __syncthreads();
}
}
__global__ void __launch_bounds__(NTHREADS, 2) mega_fwd(Args args) {
    extern __shared__ __attribute__((aligned(16))) unsigned char lds_raw[];
    LAS unsigned char* lds = (LAS unsigned char*)lds_raw;
    volatile LAS unsigned* MISC = (volatile LAS unsigned*)(lds + MISC_OFF);
    const int tid = threadIdx.x, lane = tid & 63, wave = __builtin_amdgcn_readfirstlane(tid >> 6);
    const int G = gridDim.x, bx = blockIdx.x;
    const int vcu = (G % 8 == 0) ? (bx % 8) * (G / 8) + bx / 8 : bx;
    unsigned char* ws = args.ws;
    gu32* ctl = (gu32*)(ws + WS_CTL);
    for (int u = tid; u < (LDS_BYTES - LDSCTL_OFF) / 4; u += NTHREADS) ((LAS unsigned*)(lds + LDSCTL_OFF))[u] = 0u;
    __syncthreads();
    XcdBarrier bar = xcd_barrier_post((unsigned*)(ctl + CW_BAR), MISC + 8);
#define GRID_BAR() xcd_barrier(bar)

    float* ROPE = (float*)(ws + WS_ROPE); float* BIAS = (float*)(ws + WS_BIAS); float* GW = (float*)(ws + WS_GW); float* METAH = (float*)(ws + WS_METAH);
    float* GATES = (float*)(ws + WS_GATES); float* YM = (float*)(ws + WS_YM);
    bf16* WUP = (bf16*)(ws + WS_WUP); bf16* WDN = (bf16*)(ws + WS_WDN); bf16* WIN = (bf16*)(ws + WS_WIN); bf16* WMB = (bf16*)(ws + WS_WMB); bf16* WAB = (bf16*)(ws + WS_WAB); bf16* WOUT = (bf16*)(ws + WS_WOUT);
    bf16* XA = (bf16*)(ws + WS_XA); bf16* HID = (bf16*)(ws + WS_HID); float* Y = (float*)(ws + WS_Y); bf16* Z = (bf16*)(ws + WS_Z); bf16* YG = (bf16*)(ws + WS_YG);
    bf16* HMG = (bf16*)(ws + WS_HMG); bf16* HA = (bf16*)(ws + WS_HA); bf16* CT = (bf16*)(ws + WS_HM); float* DCT = (float*)(ws + WS_DCT); float* DNB = (float*)(ws + WS_DN); float* NPREV = (float*)(ws + WS_NPREV); float* MSC = (float*)(ws + WS_MSC);
    bf16* ZQK = Z; bf16* ZMV = Z + ZPIECE; bf16* ZMO = Z + 2 * ZPIECE; bf16* ZAQ = Z + 3 * ZPIECE; bf16* ZAK = Z + 4 * ZPIECE; bf16* ZAV = Z + 5 * ZPIECE;
    bf16* ZGM = Z + 6 * ZPIECE; bf16* ZGA = ZGM + (size_t)MP * 2048;
    const int gw = vcu * NWAVES + wave, NGW = G * NWAVES;
    LAS float* scr = (LAS float*)(lds + wave * 16384);

#if PH_MASK & (1 << 0)
    {
        convert_ffn(args.in[I_F1G], args.in[I_F1U], args.in[I_F1D], args.in[I_F1PRE], WUP, WDN, scr, gw, NGW, lane);
        const int gt = vcu * NTHREADS + tid, NGT = G * NTHREADS;
        for (int i = gt; i < NIN; i += NGT) BIAS[i] = args.in[I_BIN][i < 3072 ? i : i + 8];
        for (int i = gt; i < 8 * DM; i += NGT) { const int c = i / DM, k = i % DM; GW[i] = args.in[I_WIN][(size_t)k * NIN_SRC + 3072 + c] * args.in[I_MIXPRE][k]; }
        for (int i = gt; i < (SEQ + NMETA) * 8; i += NGT) { const int pos = i >> 3, k = i & 7;
            const float invf = k == 0 ? 1.0f : k == 1 ? 0.19392274474868576f : k == 2 ? 0.03760603093086393f : k == 3 ? 0.007292664737217109f : k == 4 ? 0.001414213562373095f : k == 5 ? 0.0002742481756762073f : k == 6 ? 5.318295896944988e-05f : 1.031338537721246e-05f;
            const float ang = (float)pos * invf; const double a = (double)ang;
            const double q = rint(a * 0.15915494309189535); const double rr = a - q * 6.283185307179586476925;
            double s, c; sincos_small(rr, s, c);
            ROPE[(size_t)pos * 16 + k] = (float)c; ROPE[(size_t)pos * 16 + 8 + k] = (float)s; }
        for (int R = gw; R < MP; R += NGW) {
            bf16* xo = XA + (size_t)R * DM;
            if (R < ROW_META0) { GAS v2u* o = (GAS v2u*)xo + lane; v2u z; z.x = 0u; z.y = 0u;
#pragma unroll
                for (int j = 0; j < 8; ++j) o[64 * j] = z; }
            else { const float* hp = (R >= ROW_X0) ? args.in[I_X] + (size_t)(R - ROW_X0) * DM : args.in[I_META] + (size_t)(R - ROW_META0) * DM;
                f32x4 v[8]; load_row(hp, lane, v); const float r1 = 1.0f / sqrtf(row_ssq(v) * (1.0f / DM) + EPS); store_row_bf16(xo, lane, v, r1); }
        }
    }
#endif
    GRID_BAR();

#if PH_MASK & (1 << 1)
    { pg8::Gemm g{XA + (size_t)ROW_X0 * DM, WUP, SEQ, NUP, DM}; pg8::StaticOrder S; S.init(SEQ, NUP, G, bx); pg8::EpiSwiglu E{HID + (size_t)ROW_X0 * DFF, DFF};
      pg8::gemm_phase<pg8::EpiSwiglu, pg8::StaticOrder, true, true>(lds, g, S, E);
      const int nun = (SEQ / 256) * (NUP / 256), rem = nun % G; const int nshort = rem ? G - rem : G, rank = rem ? bx - rem : bx;
      if (rank >= 0) {
          for (int t = rank; t < DFF / 16; t += nshort) sk::up_task((LAS float*)lds, t, XA, WUP, HID, tid, wave, lane);
          const int gw = rank * NWAVES + wave, NGW = nshort * NWAVES;
        constexpr int N_IN = (DM / 64) * (NIN / 32), N_MB = (1024 / 64) * (DM / 32), N_WO = (DM / 64) * (DM / 32);
#define DESC_REST(it, D) do { int r = (it); \
            if (r < N_IN) { const int nblk = NIN / 32, kb = r / nblk, nb = r % nblk, row0 = 32 * nb; const int col0 = row0 < 3072 ? row0 : row0 + 8; \
                D.src = args.in[I_WIN] + (size_t)(64 * kb) * NIN_SRC + col0; D.dst = WIN + (size_t)row0 * DM + 64 * kb; D.sk = args.in[I_MIXPRE] + 64 * kb; D.scal = 1.0f; D.ldw = NIN_SRC; D.K = DM; } \
            else if ((r -= N_IN) < N_MB) { const int nblk = DM / 32, kb = r / nblk, nb = r % nblk; \
                D.src = args.in[I_MWB] + (size_t)(64 * kb) * DM + 32 * nb; D.dst = WMB + (size_t)(32 * nb) * 1024 + 64 * kb; D.sk = args.in[I_MNORM] + 64 * kb; D.scal = 1.0f; D.ldw = DM; D.K = 1024; } \
            else if ((r -= N_MB) < N_MB) { const int nblk = DM / 32, kb = r / nblk, nb = r % nblk; \
                D.src = args.in[I_AWB] + (size_t)(64 * kb) * DM + 32 * nb; D.dst = WAB + (size_t)(32 * nb) * 1024 + 64 * kb; D.sk = args.in[I_ANORM] + 64 * kb; D.scal = 0.8f; D.ldw = DM; D.K = 1024; } \
            else { r -= N_MB; const int nblk = DM / 32, kb = r / nblk, nb = r % nblk; \
                D.src = args.in[I_WOUT] + (size_t)(64 * kb) * DM + 32 * nb; D.dst = WOUT + (size_t)(32 * nb) * DM + 64 * kb; D.sk = nullptr; D.scal = 1.0f; D.ldw = DM; D.K = DM; } } while (0)
        CONVERT_LOOP(N_IN + 2 * N_MB + N_WO, DESC_REST);
#undef DESC_REST
      }
    }
#endif
    GRID_BAR();
#if PH_MASK & (1 << 2)
    { pg8::Gemm g{HID + (size_t)ROW_X0 * DFF, WDN, SEQ, DM, DFF}; pg8::StaticOrder S; S.init(SEQ, DM, G, bx); pg8::EpiF32 E{Y + (size_t)ROW_X0 * DM, DM};
      pg8::gemm_phase<pg8::EpiF32, pg8::StaticOrder, true, true>(lds, g, S, E);
      for (int t = bx; t < 256; t += G) sk::down_task((LAS float*)lds, t, HID, WDN, YM, tid, wave, lane); }
#endif
    GRID_BAR();
#if PH_MASK & (1 << 3)
    {
        { const int gt = vcu * NTHREADS + tid, NGT = G * NTHREADS;
          for (int i = gt; i < 3 * 48 * 128; i += NGT) { const int pz = i / (48 * 128), rem = i % (48 * 128); const int piece = pz == 0 ? 1 : (pz == 1 ? 4 : 5);
            *(GAS v4u*)(Z + (size_t)piece * ZPIECE + (size_t)ROW_PAD0 * 1024 + (size_t)rem * 8) = (v4u){0u, 0u, 0u, 0u}; }
        }
        for (int R = ROW_PAD0 + gw; R < MP; R += NGW) {
            if (R < ROW_META0) { if (lane < 8) GATES[(size_t)R * 8 + lane] = (lane < 4) ? -INFINITY : 0.f; continue; }
            const float* hp = (R >= ROW_X0) ? args.in[I_X] + (size_t)(R - ROW_X0) * DM : args.in[I_META] + (size_t)(R - ROW_META0) * DM;
            float* ho = (R >= ROW_X0) ? args.out + (size_t)(R - ROW_X0) * DM : METAH + (size_t)(R - ROW_META0) * DM;
            f32x4 y[8], h[8], g[8];
            if (R >= ROW_X0) load_row(Y + (size_t)R * DM, lane, y);
            else { f32x4 y2[8]; load_row(YM + (size_t)(R - ROW_META0) * DM, lane, y); load_row(YM + (size_t)(16 + R - ROW_META0) * DM, lane, y2);
#pragma unroll
                for (int j = 0; j < 8; ++j) y[j] = y[j] + y2[j]; }
            load_row(hp, lane, h); load_row(args.in[I_F1POST], lane, g);
            const float rs = 0.5f / sqrtf(row_ssq(y) * (1.0f / DM) + EPS);
#pragma unroll
            for (int j = 0; j < 8; ++j) h[j] = h[j] + (y[j] * rs) * g[j];
            { GAS f32x4* o = (GAS f32x4*)ho + lane;
#pragma unroll
              for (int j = 0; j < 8; ++j) o[64 * j] = h[j]; }
            const float r2 = 1.0f / sqrtf(row_ssq(h) * (1.0f / DM) + EPS);
            store_row_bf16(XA + (size_t)R * DM, lane, h, r2);
            float gv = 0.f;
#pragma unroll 1
            for (int c = 0; c < 8; ++c) { const GAS f32x4* wp = (const GAS f32x4*)(GW + (size_t)c * DM) + lane; float s = 0.f;
#pragma unroll
                for (int j = 0; j < 8; ++j) { const f32x4 w = wp[64 * j]; s += (h[j].x * w.x + h[j].y * w.y) + (h[j].z * w.z + h[j].w * w.w); }
                s = wave_sum(s); if (lane == c) gv = s; }
            if (lane < 8) { float v = gv * r2 + args.in[I_BIN][3072 + lane]; if (lane >= 4) v = log_sigmoid(v); GATES[(size_t)R * 8 + lane] = v; }
        }
    }
#endif
    GRID_BAR();
#if PH_MASK & (1 << 4)
    { pg8::Gemm g{XA + (size_t)ROW_X0 * DM, WIN, SEQ, NIN, DM}; pg8::StaticOrder S; S.init(SEQ, NIN, G, bx); pg8::EpiZ E{Z, BIAS, ROPE, ROW_X0};
      pg8::gemm_phase<pg8::EpiZ, pg8::StaticOrder, true, true>(lds, g, S, E);
      for (int t = bx; t < 256; t += G) sk::in_task((LAS float*)lds, t, XA, WIN, BIAS, ROPE, Z, tid, wave, lane); }
#endif
    GRID_BAR();
#if PH_MASK & (1 << 5)
    {
        for (int it = bx; it < 512; it += G) ml::stepA(lds, it >> 2, it & 3, ZQK, ZMV, GATES, args.in[I_CONVW], args.in[I_CONVB], DCT, DNB, MSC);
    }
    GRID_BAR();
    {
        ml::stepB(vcu * NTHREADS + tid, G * NTHREADS, DCT, DNB, MSC, CT, NPREV);
        bf16* OS = XA;
        for (int u = bx; u < 256; u += G) { const int x = u & 7, j = u >> 3, sh = 2 * x + (j & 1), p = j >> 1;
            fa::attn_unit(lds, sh, p, ZAQ, ZAK, ZAV, OS);
            fa::attn_unit(lds, sh, 31 - p, ZAQ, ZAK, ZAV, OS); }
    }
#endif
    GRID_BAR();
#if PH_MASK & (1 << 6)
    {
        for (int it = bx; it < 512; it += G) ml::stepC(lds, 1 + (it >> 2), it & 3, ZQK, ZMV, ZMO, GATES, args.in[I_CONVW], args.in[I_CONVB], CT, NPREV, MSC, HMG);
        float s1 = 0.f, s2 = 0.f;
        { const float a1 = args.in[I_LQ1][lane] * args.in[I_LK1][lane], a2 = args.in[I_LQ2][lane] * args.in[I_LK2][lane]; s1 = wave_sum(a1); s2 = wave_sum(a2); }
        const float lam = expf(s1) - expf(s2) + 0.2f;
        const bf16* OS = XA;
        for (int R = ROW_X0 + gw; R < MP; R += NGW) {
            const GAS unsigned* osr = (const GAS unsigned*)(OS + (size_t)R * 2048) + lane; GAS unsigned* hao = (GAS unsigned*)(HA + (size_t)R * 1024) + lane;
#pragma unroll
            for (int hh = 0; hh < 8; ++hh) { const unsigned w1 = osr[hh * 128], w2 = osr[hh * 128 + 64];
                const float v0 = pg8::bflo(w1) - lam * pg8::bflo(w2), v1 = pg8::bfhi(w1) - lam * pg8::bfhi(w2);
                const float ss = wave_sum(v0 * v0 + v1 * v1); const float rs = 1.0f / sqrtf(ss * (1.0f / 128.0f) + EPS);
                hao[hh * 64] = pk2(v0 * rs, v1 * rs); }
        }
    }
#endif
    GRID_BAR();
#if PH_MASK & (1 << 7)
    { pg8::Gemm g{HMG + (size_t)ROW_X0 * 1024, WMB, SEQ, DM, 1024}; pg8::StaticOrder S; S.init(SEQ, DM, G, bx); pg8::EpiGate E{ZGM + (size_t)ROW_X0 * 2048, YG + (size_t)ROW_X0 * 2048, DM, 0};
      pg8::gemm_phase<pg8::EpiGate, pg8::StaticOrder, true, true>(lds, g, S, E); }
#endif
    GRID_BAR();
#if PH_MASK & (1 << 8)
    { pg8::Gemm g{HA + (size_t)ROW_X0 * 1024, WAB, SEQ, DM, 1024}; pg8::StaticOrder S; S.init(SEQ, DM, G, bx); pg8::EpiGate E{ZGA + (size_t)ROW_X0 * 2048, YG + (size_t)ROW_X0 * 2048, DM, 1};
      pg8::gemm_phase<pg8::EpiGate, pg8::StaticOrder, true, true>(lds, g, S, E); }
#endif
    GRID_BAR();
#if PH_MASK & (1 << 9)
    { pg8::Gemm g{YG + (size_t)ROW_X0 * 2048, WOUT, SEQ, DM, DM}; pg8::StaticOrder S; S.init(SEQ, DM, G, bx); pg8::EpiF32 E{Y + (size_t)ROW_X0 * DM, DM};
      pg8::gemm_phase<pg8::EpiF32, pg8::StaticOrder, true, true>(lds, g, S, E); }
#endif
    GRID_BAR();
#if PH_MASK & (1 << 10)
    {
        for (int R = ROW_X0 + gw; R < MP; R += NGW) {
            float* ho = args.out + (size_t)(R - ROW_X0) * DM;
            f32x4 y[8], h[8], g[8]; load_row(Y + (size_t)R * DM, lane, y); load_row(ho, lane, h); load_row(args.in[I_MIXPOST], lane, g);
            const float rs = 1.0f / sqrtf(row_ssq(y) * (1.0f / DM) + EPS);
#pragma unroll
            for (int j = 0; j < 8; ++j) h[j] = h[j] + (y[j] * rs) * g[j];
            { GAS f32x4* o = (GAS f32x4*)ho + lane;
#pragma unroll
              for (int j = 0; j < 8; ++j) o[64 * j] = h[j]; }
            const float r2 = 1.0f / sqrtf(row_ssq(h) * (1.0f / DM) + EPS);
            store_row_bf16(XA + (size_t)R * DM, lane, h, r2);
        }
        convert_ffn(args.in[I_F2G], args.in[I_F2U], args.in[I_F2D], args.in[I_F2PRE], WUP, WDN, scr, gw, NGW, lane);
    }
#endif
    GRID_BAR();
#if PH_MASK & (1 << 11)
    { pg8::Gemm g{XA + (size_t)ROW_X0 * DM, WUP, SEQ, NUP, DM}; pg8::StaticOrder S; S.init(SEQ, NUP, G, bx); pg8::EpiSwiglu E{HID + (size_t)ROW_X0 * DFF, DFF};
      pg8::gemm_phase<pg8::EpiSwiglu, pg8::StaticOrder, true, true>(lds, g, S, E); }
#endif
    GRID_BAR();
#if PH_MASK & (1 << 12)
    { pg8::Gemm g{HID + (size_t)ROW_X0 * DFF, WDN, SEQ, DM, DFF}; pg8::StaticOrder S; S.init(SEQ, DM, G, bx); pg8::EpiF32 E{Y + (size_t)ROW_X0 * DM, DM};
      pg8::gemm_phase<pg8::EpiF32, pg8::StaticOrder, true, true>(lds, g, S, E); }
#endif
    GRID_BAR();
#if PH_MASK & (1 << 13)
    {
        for (int R = ROW_X0 + gw; R < MP; R += NGW) {
            float* ho = args.out + (size_t)(R - ROW_X0) * DM;
            f32x4 y[8], h[8], g[8]; load_row(Y + (size_t)R * DM, lane, y); load_row(ho, lane, h); load_row(args.in[I_F2POST], lane, g);
            const float rs = 0.5f / sqrtf(row_ssq(y) * (1.0f / DM) + EPS);
            GAS f32x4* o = (GAS f32x4*)ho + lane;
#pragma unroll
            for (int j = 0; j < 8; ++j) o[64 * j] = h[j] + (y[j] * rs) * g[j];
        }
    }
#endif
}

extern "C" void kernel_launch(void* const* d_in, const int* in_sizes, int n_in, void* d_out, int out_size, void* d_ws, size_t ws_size, hipStream_t stream) {
    static int grid = 0;
    if (grid == 0) {
        if (n_in != 27 || in_sizes[0] != SEQ * DM || out_size != SEQ * DM || ws_size < WS_END) { fprintf(stderr, "kernel_launch: unexpected shapes (n_in %d, in0 %d, out %d, ws %zu); nothing launched\n", n_in, n_in > 0 ? in_sizes[0] : -1, out_size, ws_size); grid = -1; return; }
        int dev = 0, cus = 0, per_cu = 0;
        if (hipGetDevice(&dev) != hipSuccess || hipDeviceGetAttribute(&cus, hipDeviceAttributeMultiprocessorCount, dev) != hipSuccess) { grid = -1; return; }
        if (hipFuncSetAttribute((const void*)mega_fwd, hipFuncAttributeMaxDynamicSharedMemorySize, LDS_BYTES) != hipSuccess) { fprintf(stderr, "kernel_launch: hipFuncSetAttribute failed\n"); grid = -1; return; }
        if (hipOccupancyMaxActiveBlocksPerMultiprocessor(&per_cu, (const void*)mega_fwd, NTHREADS, LDS_BYTES) != hipSuccess || per_cu < 1) { fprintf(stderr, "kernel_launch: occupancy query says %d blocks per CU\n", per_cu); (void)hipGetLastError(); grid = -1; return; }
        grid = cus;
    }
    if (grid < 0) return;
    if (hipMemsetAsync((char*)d_ws + WS_CTL, 0, CTL_ZERO_BYTES, stream) != hipSuccess) { fprintf(stderr, "kernel_launch: memset failed\n"); return; }
    Args a{};
    for (int i = 0; i < 27; ++i) a.in[i] = (const float*)d_in[i];
    a.out = (float*)d_out; a.ws = (unsigned char*)d_ws;
    hipLaunchKernelGGL(mega_fwd, dim3(grid), dim3(NTHREADS), LDS_BYTES, stream, a);
}
```

```cpp
#include <hip/hip_runtime.h>
#include <cstdio>
#include <cstdint>

constexpr int DM = 2048, SEQ = 8192, NMETA = 16, DFF = 5632, NUP = 2 * DFF, NIN = 10240, NIN_SRC = 10248;
constexpr int MP = 8448, ROW_X0 = 256, ROW_META0 = 240, ROW_PAD0 = 192, NCHUNK = 129;
constexpr float EPS = 1e-6f;
constexpr float QSCALE = 0.125f * 1.4426950408889634f;

constexpr size_t MiB = 1u << 20;
constexpr size_t WS_CTL = 0, CTL_ZERO_BYTES = 1 * MiB;
constexpr size_t WS_ROPE = 1 * MiB;
constexpr size_t WS_BIAS = 2 * MiB;
constexpr size_t WS_GW = 2 * MiB + 64 * 1024;
constexpr size_t WS_METAH = 2 * MiB + 256 * 1024;
constexpr size_t WS_DN = 1 * MiB + 520 * 1024;
constexpr size_t WS_NPREV = 2 * MiB + 384 * 1024;
constexpr size_t WS_MSC = 2 * MiB + 704 * 1024;
constexpr size_t WS_GATES = 3 * MiB;
constexpr size_t WS_YM = 3 * MiB + 512 * 1024;
constexpr size_t WS_WUP = 4 * MiB;
constexpr size_t WS_WDN = 48 * MiB;
constexpr size_t WS_WIN = 70 * MiB;
constexpr size_t WS_WMB = 110 * MiB;
constexpr size_t WS_WAB = 114 * MiB;
constexpr size_t WS_WOUT = 118 * MiB;
constexpr size_t WS_XA = 126 * MiB;
constexpr size_t WS_U = 159 * MiB;
constexpr size_t WS_HID = WS_U;
constexpr size_t WS_Y = WS_U + 91 * MiB;
constexpr size_t WS_Z = WS_U;
constexpr size_t ZPIECE = (size_t)MP * 1024;
constexpr size_t WS_YG = WS_U;
constexpr size_t WS_HMG = 324 * MiB;
constexpr size_t WS_HA = WS_HMG + (size_t)MP * 1024 * 2;
constexpr size_t WS_HM = 357 * MiB;
constexpr size_t WS_DCT = WS_WUP;
constexpr size_t WS_END = 390 * MiB;
static_assert(WS_WUP + (size_t)NUP * DM * 2 <= WS_WDN && WS_WDN + (size_t)DM * DFF * 2 <= WS_WIN && WS_WIN + (size_t)NIN * DM * 2 <= WS_WMB, "ws map 1");
static_assert(WS_XA + (size_t)MP * DM * 2 <= WS_U && WS_HID + (size_t)MP * DFF * 2 <= WS_Y && WS_Y + (size_t)MP * DM * 4 <= WS_HMG, "ws map 2");
static_assert(WS_Z + (6 * ZPIECE + 2 * (size_t)MP * 2048) * 2 <= WS_HMG && WS_HA + (size_t)MP * 1024 * 2 <= WS_HM && WS_HM + (size_t)MP * 1024 * 4 <= WS_END, "ws map 3");
static_assert(WS_YG + (size_t)MP * 2048 * 2 <= WS_Y, "YG must not overlap Y");
constexpr int CW_BAR = 4096;

namespace pg8 {
#define PG8_LAS __attribute__((address_space(3)))
typedef unsigned short bf16_t;
typedef short bf16x8 __attribute__((ext_vector_type(8)));
typedef float f32x4 __attribute__((ext_vector_type(4)));
typedef unsigned u32x4 __attribute__((ext_vector_type(4)));
constexpr int BM = 256, BK = 64, HALF = 128, HTB = HALF * BK * 2  , STAGE_BYTES = 8 * HTB, NXCD = 8, WGM = 8;

__host__ __device__ __forceinline__ int lds_byte(int r, int c) { const int st = (r >> 4) * 2 + (c >> 5), rr = r & 15, cc = c & 31, ob = rr * 64 + cc * 2; return st * 1024 + (ob ^ (((ob >> 9) & 1) << 5)); }
__host__ __device__ __forceinline__ void stage_rc(int b, int& R, int& C) { const int st = b / 1024, sb = b % 1024, swz = sb ^ (((sb >> 9) & 1) << 5); R = (st >> 1) * 16 + swz / 64; C = (st & 1) * 32 + (swz % 64) / 2; }
__host__ __device__ __forceinline__ int perm32(int rho) { const int n = rho >> 4, i = rho & 15; return 8 * (i >> 2) + 4 * n + (i & 3); }

struct Unit { int pm, pn, sel; };
struct Gemm { const bf16_t* A; const bf16_t* Bt; int M, N, K; const bf16_t* A2; const bf16_t* Bt2; };

struct StaticOrder {
    int nM, nN, nwg, G, c;
    __host__ __device__ void init(int M, int N, int G_, int c_) { nM = M / BM; nN = N / BM; nwg = nM * nN; G = G_; c = c_; }
    __host__ __device__ bool next(int i, Unit& u) const {
        const long L = (long)i * G + c; if (L >= nwg) return false;
        int wgid = (int)L; { const int q = nwg / NXCD, r = nwg % NXCD, xcd = wgid % NXCD, off = wgid / NXCD; wgid = (xcd < r ? xcd * (q + 1) : r * (q + 1) + (xcd - r) * q) + off; }
        const int nig = WGM * nN, gid = wgid / nig, fm = gid * WGM, gsz = (nM - fm) < WGM ? (nM - fm) : WGM;
        u.pm = fm + ((wgid % nig) % gsz); u.pn = (wgid % nig) / gsz; u.sel = 0; return true;
    }
    __device__ __forceinline__ void a_ready(const Unit&) const {}
    __device__ __forceinline__ void done(const Unit&) const {}
};
struct DualOrder : StaticOrder {
    __host__ __device__ bool next(int i, Unit& u) const { if (!StaticOrder::next(i >> 1, u)) return false; u.sel = i & 1; return true; }
};

__device__ __forceinline__ unsigned cvt_pk_bf16(float lo, float hi) { unsigned r; asm volatile("v_cvt_pk_bf16_f32 %0, %1, %2" : "=v"(r) : "v"(lo), "v"(hi)); return r; }
typedef float f32x2 __attribute__((ext_vector_type(2)));
__device__ __forceinline__ float sigm(float x) { return __builtin_amdgcn_rcpf(1.0f + __expf(-x)); }
__device__ __forceinline__ float bflo(unsigned w) { return __uint_as_float(w << 16); }
__device__ __forceinline__ float bfhi(unsigned w) { return __uint_as_float(w & 0xffff0000u); }

struct EpiF32 {
    static constexpr bool PERM = false, AFTER_DRAIN = false;
    float* C; int ldc;
    __device__ __forceinline__ void operator()(const f32x4 (&acc)[2][2][4][2], const Unit& u, int wr, int wc, int fr, int fq) const {
        const int row0 = u.pm * BM + wr * 64 + fr, col0 = u.pn * BM + wc * 32 + 4 * fq;
#pragma unroll
        for (int ai = 0; ai < 2; ++ai)
#pragma unroll
            for (int m = 0; m < 4; ++m) { float* rowp = C + (size_t)(row0 + ai * HALF + m * 16) * ldc + col0;
#pragma unroll
                for (int bj = 0; bj < 2; ++bj)
#pragma unroll
                    for (int n = 0; n < 2; ++n) *(f32x4*)(rowp + bj * HALF + n * 16) = acc[ai][bj][m][n]; }
    }
};

struct EpiSwiglu {
    static constexpr bool PERM = true, AFTER_DRAIN = false;
    bf16_t* O; int ldc;
    __device__ __forceinline__ void operator()(const f32x4 (&acc)[2][2][4][2], const Unit& u, int wr, int wc, int fr, int fq) const {
        const int row0 = u.pm * BM + wr * 64 + fr, col0 = u.pn * HALF + wc * 32 + 8 * fq;
#pragma unroll
        for (int ai = 0; ai < 2; ++ai)
#pragma unroll
            for (int m = 0; m < 4; ++m) { bf16_t* rowp = O + (size_t)(row0 + ai * HALF + m * 16) * ldc + col0;
                const f32x4 g0 = acc[ai][0][m][0], g1 = acc[ai][0][m][1], u0 = acc[ai][1][m][0], u1 = acc[ai][1][m][1];
                float r[8];
#pragma unroll
                for (int i = 0; i < 4; ++i) { r[i] = g0[i] * sigm(g0[i]) * u0[i]; r[4 + i] = g1[i] * sigm(g1[i]) * u1[i]; }
                u32x4 w; w.x = cvt_pk_bf16(r[0], r[1]); w.y = cvt_pk_bf16(r[2], r[3]); w.z = cvt_pk_bf16(r[4], r[5]); w.w = cvt_pk_bf16(r[6], r[7]);
                *(u32x4*)rowp = w; }
    }
};

struct EpiZ {
    static constexpr bool PERM = true, AFTER_DRAIN = false;
    bf16_t* Z; const float* bias; const float* rope; int rowoff;
    __device__ __forceinline__ void operator()(const f32x4 (&acc)[2][2][4][2], const Unit& u, int wr, int wc, int fr, int fq) const {
        const int pn = u.pn, row0 = rowoff + u.pm * BM + wr * 64 + fr;
        bf16_t* base; int ldc, colt;
        if (pn < 24) { base = Z + (size_t)(pn >> 2) * ZPIECE; ldc = 1024; colt = (pn & 3) * 256; }
        else { const int q = pn - 24; base = Z + 6 * ZPIECE + (size_t)(q >> 3) * ((size_t)MP * 2048); ldc = 2048; colt = (q & 7) * 256; }
        const int mode = ((pn >= 8 && pn < 12) || pn >= 24) ? 1 : ((pn >= 12 && pn < 20) ? 2 : 0);
        const float qs = (pn >= 12 && pn < 16) ? QSCALE : 1.0f;
        const int col0 = colt + wc * 32 + 8 * fq, bcol0 = pn * BM + wc * 32 + 8 * fq;
        f32x4 bv[2][2];
#pragma unroll
        for (int bj = 0; bj < 2; ++bj)
#pragma unroll
            for (int n = 0; n < 2; ++n) bv[bj][n] = *(const f32x4*)(bias + bcol0 + bj * HALF + 4 * n);
        const bool rot = ((wc & 1) == 0) && (fq < 2);
        const float sgn = (fq == 0) ? -1.0f : 1.0f;
#pragma unroll
        for (int ai = 0; ai < 2; ++ai)
#pragma unroll
            for (int m = 0; m < 4; ++m) { const int row = row0 + ai * HALF + m * 16; bf16_t* rowp = base + (size_t)row * ldc + col0;
#pragma unroll
                for (int bj = 0; bj < 2; ++bj) { f32x4 v0 = acc[ai][bj][m][0] + bv[bj][0], v1 = acc[ai][bj][m][1] + bv[bj][1];
                    if (mode == 1) {
#pragma unroll
                        for (int i = 0; i < 4; ++i) { v0[i] = sigm(v0[i]); v1[i] = sigm(v1[i]); }
                    } else if (mode == 2) {
                        f32x4 p0, p1;
#pragma unroll
                        for (int i = 0; i < 4; ++i) { p0[i] = __shfl_xor(v0[i], 16); p1[i] = __shfl_xor(v1[i], 16); }
                        if (rot) { int pos = row - ROW_META0; pos = pos < 0 ? 0 : pos; const float* rp = rope + (size_t)pos * 16;
                            const f32x4 c0 = *(const f32x4*)(rp), c1 = *(const f32x4*)(rp + 4), s0 = *(const f32x4*)(rp + 8), s1 = *(const f32x4*)(rp + 12);
#pragma unroll
                            for (int i = 0; i < 4; ++i) { v0[i] = v0[i] * c0[i] + sgn * p0[i] * s0[i]; v1[i] = v1[i] * c1[i] + sgn * p1[i] * s1[i]; } }
                        v0 = v0 * qs; v1 = v1 * qs;
                    }
                    u32x4 w; w.x = cvt_pk_bf16(v0[0], v0[1]); w.y = cvt_pk_bf16(v0[2], v0[3]); w.z = cvt_pk_bf16(v1[0], v1[1]); w.w = cvt_pk_bf16(v1[2], v1[3]);
                    *(u32x4*)(rowp + bj * HALF) = w; } }
    }
};

struct EpiGate {
    static constexpr bool PERM = true, AFTER_DRAIN = false;
    const bf16_t* G0; const bf16_t* G1; bf16_t* O; int ldc;
    __device__ __forceinline__ void operator()(const f32x4 (&acc)[2][2][4][2], const Unit& u, int wr, int wc, int fr, int fq) const {
        const int row0 = u.pm * BM + wr * 64 + fr, col0 = u.pn * BM + wc * 32 + 8 * fq; const bf16_t* G = u.sel ? G1 : G0; const int accum = u.sel;
#pragma unroll
        for (int ai = 0; ai < 2; ++ai)
#pragma unroll
            for (int m = 0; m < 4; ++m) { const size_t off = (size_t)(row0 + ai * HALF + m * 16) * ldc + col0;
#pragma unroll
                for (int bj = 0; bj < 2; ++bj) { const u32x4 gw = *(const u32x4*)(G + off + bj * HALF);
                    f32x4 v0 = acc[ai][bj][m][0], v1 = acc[ai][bj][m][1];
                    v0[0] *= bflo(gw.x); v0[1] *= bfhi(gw.x); v0[2] *= bflo(gw.y); v0[3] *= bfhi(gw.y);
                    v1[0] *= bflo(gw.z); v1[1] *= bfhi(gw.z); v1[2] *= bflo(gw.w); v1[3] *= bfhi(gw.w);
                    if (accum) { const u32x4 ow = *(const u32x4*)(O + off + bj * HALF);
                        v0[0] += bflo(ow.x); v0[1] += bfhi(ow.x); v0[2] += bflo(ow.y); v0[3] += bfhi(ow.y);
                        v1[0] += bflo(ow.z); v1[1] += bfhi(ow.z); v1[2] += bflo(ow.w); v1[3] += bfhi(ow.w); }
                    u32x4 w; w.x = cvt_pk_bf16(v0[0], v0[1]); w.y = cvt_pk_bf16(v0[2], v0[3]); w.z = cvt_pk_bf16(v1[0], v1[1]); w.w = cvt_pk_bf16(v1[2], v1[3]);
                    *(u32x4*)(O + off + bj * HALF) = w; } }
    }
};

template <class Epi, class Sched, bool ALIGN_EPI = false, bool SP2 = false>
__device__ __forceinline__ void gemm_phase(PG8_LAS unsigned char* lds, const Gemm g, const Sched& S, const Epi& E) {
    int tid_ = threadIdx.x; asm volatile("" : "+v"(tid_));
    const int tid = tid_, wid = __builtin_amdgcn_readfirstlane(tid >> 6), lane = tid & 63, wr = wid >> 2, wc = wid & 3, fr = lane & 15, fq = lane >> 4;
    const int K = g.K, nt = K / BK;
    unsigned voffA[2], voffB[2];
#pragma unroll
    for (int i = 0; i < 2; ++i) { int R, C; stage_rc(tid * 16 + i * 8192, R, C); const int Rb = Epi::PERM ? ((R & ~31) + perm32(R & 31)) : R;
        voffA[i] = (unsigned)(R * K + C) * 2u; voffB[i] = (unsigned)(Rb * K + C) * 2u; }
    const size_t kstep = (size_t)(BK * 2);
    const size_t hstep = (size_t)HALF * K * 2;
    const size_t tstep = 2 * hstep;
    const unsigned ldsw = (unsigned)wid * 1024u;
    const int aoff = lds_byte(wr * 64 + fr, fq * 8), boff = lds_byte(wc * 32 + fr, fq * 8);
#define PG8_SA(b, h) (((b) * 2 + (h)) * HTB)
#define PG8_SB(b, h) ((4 + (b) * 2 + (h)) * HTB)
#define PG8_STAGE(bufoff, gbase, voff) do { _Pragma("unroll") for (int _i = 0; _i < 2; ++_i) \
        __builtin_amdgcn_global_load_lds((const unsigned*)((const char*)(gbase) + (voff)[_i]), (PG8_LAS unsigned*)(lds + (bufoff) + ldsw + _i * 8192), 16, 0, 0); } while (0)
#define PG8_LDA(dst, b, h) do { _Pragma("unroll") for (int m = 0; m < 4; ++m) _Pragma("unroll") for (int k = 0; k < 2; ++k) dst[m][k] = *(const PG8_LAS bf16x8*)(lds + PG8_SA(b, h) + aoff + m * 2048 + k * 1024); } while (0)
#define PG8_LDB(dst, b, h) do { _Pragma("unroll") for (int n = 0; n < 2; ++n) _Pragma("unroll") for (int k = 0; k < 2; ++k) dst[n][k] = *(const PG8_LAS bf16x8*)(lds + PG8_SB(b, h) + boff + n * 2048 + k * 1024); } while (0)
#define PG8_MMA(ai, bj, At, Bt) do { __builtin_amdgcn_s_setprio(1); _Pragma("unroll") for (int m = 0; m < 4; ++m) _Pragma("unroll") for (int n = 0; n < 2; ++n) _Pragma("unroll") for (int k = 0; k < 2; ++k) \
        acc[ai][bj][m][n] = __builtin_amdgcn_mfma_f32_16x16x32_bf16(Bt[n][k], At[m][k], acc[ai][bj][m][n], 0, 0, 0); __builtin_amdgcn_s_setprio(0); } while (0)
#define PG8_WAIT_V(n) asm volatile("s_waitcnt vmcnt(" #n ")" ::: "memory")
#define PG8_WAIT_L(n) asm volatile("s_waitcnt lgkmcnt(" #n ")" ::: "memory")
#define PG8_BAR __builtin_amdgcn_s_barrier()
#define PG8_SCHED __builtin_amdgcn_sched_barrier(0)
    Unit cur, nxt; int ui = 0;
    if (!S.next(0, cur)) return;
    f32x4 acc[2][2][4][2];
#pragma unroll
    for (int a = 0; a < 2; ++a)
#pragma unroll
        for (int b = 0; b < 2; ++b)
#pragma unroll
            for (int m = 0; m < 4; ++m)
#pragma unroll
                for (int n = 0; n < 2; ++n) acc[a][b][m][n] = (f32x4){0.f, 0.f, 0.f, 0.f};
    bf16x8 At[4][2], B0[2][2], B1[2][2];
    const char* cA = (const char*)(cur.sel ? g.A2 : g.A) + (size_t)cur.pm * tstep; const char* cB = (const char*)(cur.sel ? g.Bt2 : g.Bt) + (size_t)cur.pn * tstep;
    S.a_ready(cur);
    if constexpr (SP2) {
        PG8_STAGE(PG8_SB(0, 0), cB, voffB); PG8_STAGE(PG8_SB(0, 1), cB + hstep, voffB); PG8_STAGE(PG8_SA(0, 0), cA, voffA); PG8_STAGE(PG8_SA(0, 1), cA + hstep, voffA);
        if (wr == 1) PG8_BAR;
        PG8_WAIT_V(2); PG8_BAR;
        PG8_STAGE(PG8_SB(1, 0), cB + kstep, voffB); PG8_STAGE(PG8_SA(1, 0), cA + kstep, voffA); PG8_STAGE(PG8_SB(1, 1), cB + hstep + kstep, voffB);
        PG8_WAIT_V(6); PG8_BAR;
    } else {
        PG8_STAGE(PG8_SB(0, 0), cB, voffB); PG8_STAGE(PG8_SA(0, 0), cA, voffA); PG8_STAGE(PG8_SB(0, 1), cB + hstep, voffB); PG8_STAGE(PG8_SA(0, 1), cA + hstep, voffA);
        if (wr == 1) PG8_BAR;
        PG8_WAIT_V(4); PG8_BAR;
        PG8_STAGE(PG8_SB(1, 0), cB + kstep, voffB); PG8_STAGE(PG8_SA(1, 0), cA + kstep, voffA); PG8_STAGE(PG8_SB(1, 1), cB + hstep + kstep, voffB);
        PG8_WAIT_V(6); PG8_BAR;
    }
    for (;;) {
        const bool has_next = S.next(ui + 1, nxt);
        const char* nA = has_next ? (const char*)(nxt.sel ? g.A2 : g.A) + (size_t)nxt.pm * tstep : cA; const char* nB = has_next ? (const char*)(nxt.sel ? g.Bt2 : g.Bt) + (size_t)nxt.pn * tstep : cB;
        for (int t = 0; t < nt; t += 2) {
            const bool last = (t == nt - 2);
            const char* a1 = cA + (size_t)(t + 1) * kstep;
            const char* a2 = last ? nA : cA + (size_t)(t + 2) * kstep; const char* b2 = last ? nB : cB + (size_t)(t + 2) * kstep;
            const char* a3 = a2 + kstep; const char* b3 = b2 + kstep;
            if (last && has_next) S.a_ready(nxt);
            if constexpr (SP2) {
            PG8_LDB(B0, 0, 0); PG8_LDB(B1, 0, 1); PG8_SCHED; PG8_LDA(At, 0, 0); PG8_STAGE(PG8_SA(1, 1), a1 + hstep, voffA);
            PG8_WAIT_V(8); PG8_WAIT_L(0); PG8_BAR; PG8_MMA(0, 0, At, B0); PG8_MMA(0, 1, At, B1); PG8_BAR; PG8_SCHED;
            PG8_LDA(At, 0, 1); PG8_STAGE(PG8_SB(0, 0), b2, voffB); PG8_STAGE(PG8_SB(0, 1), b2 + hstep, voffB); PG8_STAGE(PG8_SA(0, 0), a2, voffA);
            PG8_WAIT_V(8); PG8_WAIT_L(0); PG8_BAR; PG8_MMA(1, 0, At, B0); PG8_MMA(1, 1, At, B1); PG8_BAR; PG8_SCHED;
            PG8_LDB(B0, 1, 0); PG8_LDB(B1, 1, 1); PG8_SCHED; PG8_LDA(At, 1, 0); PG8_STAGE(PG8_SA(0, 1), a2 + hstep, voffA);
            PG8_WAIT_V(8); PG8_WAIT_L(0); PG8_BAR; PG8_MMA(0, 0, At, B0); PG8_MMA(0, 1, At, B1); PG8_BAR; PG8_SCHED;
            PG8_LDA(At, 1, 1); PG8_STAGE(PG8_SB(1, 0), b3, voffB); PG8_STAGE(PG8_SB(1, 1), b3 + hstep, voffB); PG8_STAGE(PG8_SA(1, 0), a3, voffA);
            PG8_WAIT_V(8); PG8_WAIT_L(0); PG8_BAR; PG8_MMA(1, 0, At, B0); PG8_MMA(1, 1, At, B1); PG8_BAR; PG8_SCHED;
            } else {
            PG8_LDB(B0, 0, 0); PG8_SCHED; PG8_LDA(At, 0, 0); PG8_STAGE(PG8_SA(1, 1), a1 + hstep, voffA);
            PG8_WAIT_L(8); PG8_BAR; PG8_WAIT_L(0); PG8_MMA(0, 0, At, B0); PG8_BAR; PG8_SCHED;
            PG8_LDB(B1, 0, 1); PG8_STAGE(PG8_SB(0, 0), b2, voffB);
            PG8_BAR; PG8_WAIT_L(0); PG8_MMA(0, 1, At, B1); PG8_BAR;
            PG8_LDA(At, 0, 1); PG8_STAGE(PG8_SA(0, 0), a2, voffA);
            PG8_BAR; PG8_WAIT_L(0); PG8_MMA(1, 0, At, B0); PG8_BAR; PG8_SCHED;
            PG8_STAGE(PG8_SB(0, 1), b2 + hstep, voffB);
            PG8_WAIT_V(6); PG8_BAR; PG8_MMA(1, 1, At, B1); PG8_BAR;
            PG8_LDB(B0, 1, 0); PG8_SCHED; PG8_LDA(At, 1, 0); PG8_STAGE(PG8_SA(0, 1), a2 + hstep, voffA);
            PG8_WAIT_L(8); PG8_BAR; PG8_WAIT_L(0); PG8_MMA(0, 0, At, B0); PG8_BAR; PG8_SCHED;
            PG8_LDB(B1, 1, 1); PG8_STAGE(PG8_SB(1, 0), b3, voffB);
            PG8_BAR; PG8_WAIT_L(0); PG8_MMA(0, 1, At, B1); PG8_BAR;
            PG8_LDA(At, 1, 1); PG8_STAGE(PG8_SA(1, 0), a3, voffA);
            PG8_BAR; PG8_WAIT_L(0); PG8_MMA(1, 0, At, B0); PG8_BAR; PG8_SCHED;
            PG8_STAGE(PG8_SB(1, 1), b3 + hstep, voffB);
            PG8_WAIT_V(6); PG8_BAR; PG8_MMA(1, 1, At, B1); PG8_BAR;
            }
        }
        if constexpr (ALIGN_EPI) { if (wr == 0) PG8_BAR; }
        if constexpr (!Epi::AFTER_DRAIN) { E(acc, cur, wr, wc, fr, fq); S.done(cur); }
        if (!has_next) break;
#pragma unroll
        for (int a = 0; a < 2; ++a)
#pragma unroll
            for (int b = 0; b < 2; ++b)
#pragma unroll
                for (int m = 0; m < 4; ++m)
#pragma unroll
                    for (int n = 0; n < 2; ++n) acc[a][b][m][n] = (f32x4){0.f, 0.f, 0.f, 0.f};
        cur = nxt; cA = nA; cB = nB; ++ui;
        if constexpr (ALIGN_EPI) { if (wr == 1) PG8_BAR; }
    }
    PG8_WAIT_V(0);
    if constexpr (!ALIGN_EPI) { if (wr == 0) PG8_BAR; }
    PG8_BAR;
    if constexpr (Epi::AFTER_DRAIN) { E.fused(acc, cur, wr, wc, fr, fq, lds, wid, lane); S.done(cur); }
#undef PG8_SA
#undef PG8_SB
#undef PG8_STAGE
#undef PG8_LDA
#undef PG8_LDB
#undef PG8_MMA
#undef PG8_WAIT_V
#undef PG8_WAIT_L
#undef PG8_BAR
#undef PG8_SCHED
}
}
#define GAS __attribute__((address_space(1)))
#define LAS __attribute__((address_space(3)))
typedef unsigned short bf16;
typedef unsigned v4u __attribute__((ext_vector_type(4)));
typedef float f32x4 __attribute__((ext_vector_type(4)));
typedef short bf16x8 __attribute__((ext_vector_type(8)));
typedef GAS unsigned gu32;
typedef GAS unsigned long long gu64;
#define RLX_AGENT __ATOMIC_RELAXED, __HIP_MEMORY_SCOPE_AGENT
#define LDS_WAIT() asm volatile("s_waitcnt lgkmcnt(0)" ::: "memory")
#define VM_WAIT() asm volatile("s_waitcnt vmcnt(0)" ::: "memory")
__device__ __forceinline__ unsigned long long rt() { return __builtin_amdgcn_s_memrealtime(); }
__device__ __forceinline__ unsigned f2bf(float f) { unsigned u = __builtin_bit_cast(unsigned, f); return (u + 0x7fffu + ((u >> 16) & 1u)) >> 16; }
__device__ __forceinline__ unsigned pk2(float lo, float hi) { return f2bf(lo) | (f2bf(hi) << 16); }

#define XB_TMO      128
#define XB_XCNT(j)  (256  + 64 * (j))
#define XB_XSUB(j)  (1280 + 64 * (j))
#define XB_XGEN(j)  (2304 + 64 * (j))
#define XB_TOP      3328
#define XB_TOPGEN   3392
#define XCD_BAR_WORDS 3456
#define XB_SPIN_CAP (1u << 18)

__device__ __forceinline__ unsigned xb_ld(unsigned* p)              { return __hip_atomic_load(p, __ATOMIC_RELAXED, __HIP_MEMORY_SCOPE_AGENT); }
__device__ __forceinline__ unsigned xb_add(unsigned* p, unsigned v) { return __hip_atomic_fetch_add(p, v, __ATOMIC_RELAXED, __HIP_MEMORY_SCOPE_AGENT); }
__device__ __forceinline__ unsigned xb_xcc_id() { return (unsigned)__builtin_amdgcn_s_getreg((3 << 11) | 20) & 0xFu; }
#define XB_SPIN(cond, bar) do { unsigned _sp = 0; while (cond) { __builtin_amdgcn_s_sleep(1); \
    if ((++_sp & 255u) == 0u) { if (xb_ld(&(bar)[XB_TMO])) break; if (_sp > XB_SPIN_CAP) { atomicAdd(&(bar)[XB_TMO], 1u); break; } } } } while (0)

struct XcdBarrier {
    unsigned* bar; unsigned x;
    volatile LAS unsigned* st;
};

__device__ __forceinline__ XcdBarrier xcd_barrier_post(unsigned* bar, volatile LAS unsigned* st) {
    XcdBarrier b; b.bar = bar; b.x = xb_xcc_id(); b.st = st;
    if (threadIdx.x == 0) (void)xb_add(&bar[XB_XCNT(b.x)], 1u);
    return b;
}
__device__ __forceinline__ void xcd_barrier_complete(unsigned* bar, unsigned x, unsigned& nloc, unsigned& nx) {
    const unsigned G = gridDim.x * gridDim.y * gridDim.z;
    unsigned sum, cnt, mine, sp = 0u;
    for (;;) {
        sum = 0u; cnt = 0u; mine = 0u;
#pragma unroll
        for (unsigned j = 0; j < 16; ++j) { const unsigned c = xb_ld(&bar[XB_XCNT(j)]); sum += c; cnt += (c > 0u) ? 1u : 0u; mine = (j == x) ? c : mine; }
        if (sum == G) break;
        __builtin_amdgcn_s_sleep(1);
        if ((++sp & 255u) == 0u) { if (xb_ld(&bar[XB_TMO])) break; if (sp > XB_SPIN_CAP) { atomicAdd(&bar[XB_TMO], 1u); break; } }
    }
    nloc = mine > 0u ? mine : 1u; nx = cnt > 0u ? cnt : 1u;
}

__device__ __forceinline__ void xcd_barrier(const XcdBarrier& b) {
    asm volatile("s_waitcnt vmcnt(0)" ::: "memory");
    __syncthreads();
    if (threadIdx.x == 0) {
        unsigned* bar = b.bar;
        __builtin_amdgcn_s_waitcnt(0);
        unsigned nloc = b.st[0], nx = b.st[1];
        if (nloc == 0u) { xcd_barrier_complete(bar, b.x, nloc, nx); b.st[0] = nloc; b.st[1] = nx; }
        const unsigned old = xb_add(&bar[XB_XSUB(b.x)], 1u);
        const unsigned gen = old / nloc;
        if (old + 1u == (gen + 1u) * nloc) {
            __builtin_amdgcn_fence(__ATOMIC_RELEASE, "agent");
            asm volatile("s_waitcnt vmcnt(0)" ::: "memory");
            const unsigned og = xb_add(&bar[XB_TOP], 1u);
            const unsigned tg = og / nx;
            if (og + 1u == (tg + 1u) * nx) xb_add(&bar[XB_TOPGEN], 1u);
            else XB_SPIN(xb_ld(&bar[XB_TOPGEN]) == tg, bar);
            __builtin_amdgcn_fence(__ATOMIC_ACQUIRE, "agent");
            xb_add(&bar[XB_XGEN(b.x)], 1u);
            asm volatile("s_waitcnt vmcnt(0)" ::: "memory");
        } else {
            XB_SPIN(xb_ld(&bar[XB_XGEN(b.x)]) == gen, bar);
            __builtin_amdgcn_fence(__ATOMIC_ACQUIRE, "agent");
            asm volatile("s_waitcnt vmcnt(0)" ::: "memory");
        }
    }
    __syncthreads();
}
constexpr int NWAVES = 8, NTHREADS = 512;
constexpr int RING_BYTES = 131072, LDSCTL_OFF = RING_BYTES, MISC_OFF = LDSCTL_OFF + 320, LDS_BYTES = 147456;
typedef unsigned v2u __attribute__((ext_vector_type(2)));

#ifndef PH_MASK
#define PH_MASK 0xffff
#endif
struct Args { const float* in[27]; float* out; unsigned char* ws; };
enum { I_X = 0, I_META, I_F1PRE, I_F1POST, I_F1G, I_F1U, I_F1D, I_MIXPRE, I_MIXPOST, I_WIN, I_BIN, I_CONVW, I_CONVB, I_MNORM, I_MWB, I_LQ1, I_LK1, I_LQ2, I_LK2, I_ANORM, I_AWB, I_WOUT, I_F2PRE, I_F2POST, I_F2G, I_F2U, I_F2D };

__device__ __forceinline__ float wave_sum(float v) {
#pragma unroll
    for (int o = 1; o < 64; o <<= 1) v += __shfl_xor(v, o);
    return v;
}
__device__ __forceinline__ float bf2f(bf16 b) { return __uint_as_float(((unsigned)b) << 16); }

struct TrD { const float* src; bf16* dst; const float* sk; float scal; int ldw, K; };
__device__ __forceinline__ void tr_load(const TrD& d, int lane, f32x4 (&v)[8]) {
    const float* p = d.src + (size_t)(lane >> 3) * d.ldw + (lane & 7) * 4;
#pragma unroll
    for (int i = 0; i < 8; ++i) v[i] = *(const f32x4*)(p + (size_t)(8 * i) * d.ldw);
}
__device__ __forceinline__ void tr_finish(const TrD& d, int lane, const f32x4 (&v)[8], LAS float* scr) {
    const int r = lane >> 3, c4 = (lane & 7) * 4;
#pragma unroll
    for (int i = 0; i < 8; ++i) { const int k = 8 * i + r; const float s = d.sk ? d.sk[k] * d.scal : d.scal; LAS float* q = scr + k * 33 + c4;
        q[0] = v[i].x * s; q[1] = v[i].y * s; q[2] = v[i].z * s; q[3] = v[i].w * s; }
    LDS_WAIT(); asm volatile("" ::: "memory");
    const int c = lane & 7;
#pragma unroll
    for (int j = 0; j < 4; ++j) { const int n = (lane >> 3) + 8 * j; const LAS float* s = scr + (8 * c) * 33 + n;
        v4u o; o.x = pk2(s[0 * 33], s[1 * 33]); o.y = pk2(s[2 * 33], s[3 * 33]); o.z = pk2(s[4 * 33], s[5 * 33]); o.w = pk2(s[6 * 33], s[7 * 33]);
        *(GAS v4u*)(d.dst + (size_t)n * d.K + 8 * c) = o; }
    LDS_WAIT(); asm volatile("" ::: "memory");
}
#define CONVERT_LOOP(NITEMS, DESC) do { int it_ = gw; TrD cur_; f32x4 v_[8]; bool has_ = it_ < (NITEMS); if (has_) { DESC(it_, cur_); tr_load(cur_, lane, v_); } \
    while (has_) { const int nx_ = it_ + NGW; const bool hn_ = nx_ < (NITEMS); TrD nd_ = cur_; f32x4 w_[8]; if (hn_) { DESC(nx_, nd_); tr_load(nd_, lane, w_); } \
        tr_finish(cur_, lane, v_, scr); if (hn_) { cur_ = nd_; _Pragma("unroll") for (int q_ = 0; q_ < 8; ++q_) v_[q_] = w_[q_]; } it_ = nx_; has_ = hn_; } } while (0)

template <bool WITH_DOWN> __device__ __forceinline__ void convert_ffn(const float* wg, const float* wu, const float* wd, const float* preg, bf16* WUP, bf16* WDN, LAS float* scr, int gw, int NGW, int lane) {
    constexpr int N_UP = (DM / 64) * (NUP / 32), N_DN = (DFF / 64) * (DM / 32);
#define DESC_FFN(it, D) do { if ((it) < N_UP) { const int nblk = NUP / 32, kb = (it) / nblk, nb = (it) % nblk, row0 = 32 * nb, pn = row0 >> 8, j = row0 & 255; \
            const float* src = (j < 128) ? wg : wu; const int col0 = 128 * pn + (j & 127); \
            D.src = src + (size_t)(64 * kb) * DFF + col0; D.dst = WUP + (size_t)row0 * DM + 64 * kb; D.sk = preg + 64 * kb; D.scal = 1.0f; D.ldw = DFF; D.K = DM; } \
        else { const int r = (it) - N_UP, nblk = DM / 32, kb = r / nblk, nb = r % nblk; \
            D.src = wd + (size_t)(64 * kb) * DM + 32 * nb; D.dst = WDN + (size_t)(32 * nb) * DFF + 64 * kb; D.sk = nullptr; D.scal = 1.0f; D.ldw = DM; D.K = DFF; } } while (0)
    CONVERT_LOOP(WITH_DOWN ? N_UP + N_DN : N_UP, DESC_FFN);
#undef DESC_FFN
}

__device__ __forceinline__ void sincos_small(double r, double& s, double& c) {
    const double r2 = r * r; double ts = 1.0, tc = 1.0;
#pragma unroll
    for (int k = 13; k >= 1; --k) { ts = 1.0 - ts * r2 / (double)((2 * k) * (2 * k + 1)); tc = 1.0 - tc * r2 / (double)((2 * k - 1) * (2 * k)); }
    s = r * ts; c = tc;
}

__device__ __forceinline__ void load_row(const float* p, int lane, f32x4 (&v)[8]) {
    const GAS f32x4* r = (const GAS f32x4*)p + lane;
#pragma unroll
    for (int j = 0; j < 8; ++j) v[j] = r[64 * j];
}
__device__ __forceinline__ float row_ssq(const f32x4 (&v)[8]) {
    float s = 0.f;
#pragma unroll
    for (int j = 0; j < 8; ++j) s += (v[j].x * v[j].x + v[j].y * v[j].y) + (v[j].z * v[j].z + v[j].w * v[j].w);
    return wave_sum(s);
}
__device__ __forceinline__ void store_row_bf16(bf16* p, int lane, const f32x4 (&v)[8], float sc) {
    GAS v2u* o = (GAS v2u*)p + lane;
#pragma unroll
    for (int j = 0; j < 8; ++j) { v2u w; w.x = pk2(v[j].x * sc, v[j].y * sc); w.y = pk2(v[j].z * sc, v[j].w * sc); o[64 * j] = w; }
}

__device__ __forceinline__ float log_sigmoid(float x) { return fminf(x, 0.f) - log1pf(__expf(-fabsf(x))); }

namespace fa {
typedef float f32x16 __attribute__((ext_vector_type(16)));
typedef short s16x4 __attribute__((ext_vector_type(4)));
typedef short v4i16_t __attribute__((ext_vector_type(4)));
constexpr int NSLOT = 4, KSLOT = 8192, VSLOT = 16384;
constexpr int L_K = 0, L_V = NSLOT * KSLOT, L_WS = L_V + NSLOT * VSLOT, L_END = L_WS + 8 * 256;
constexpr float THR = 8.0f;
__device__ __forceinline__ int crow(int r, int hi) { return (r & 3) + 8 * (r >> 2) + 4 * hi; }
__device__ __forceinline__ s16x4 vtr(const LAS unsigned char* p) { return __builtin_bit_cast(s16x4, __builtin_amdgcn_ds_read_tr16_b64_v4i16((LAS v4i16_t*)p)); }
__device__ __forceinline__ unsigned cvtpk(float lo, float hi) { typedef float f2 __attribute__((ext_vector_type(2))); typedef __bf16 b2 __attribute__((ext_vector_type(2))); f2 v = {lo, hi}; b2 b = __builtin_convertvector(v, b2); return __builtin_bit_cast(unsigned, b); }
#define FA_MX3(a, b, c) __builtin_fmaxf(__builtin_fmaxf((a), (b)), (c))
#define FA_BAR() asm volatile("s_barrier" ::: "memory")

__device__ __forceinline__ void attn_unit(LAS unsigned char* lds, int sh, int qb, const bf16* AQ, const bf16* AK, const bf16* AV, bf16* OS) {
    int tid_ = threadIdx.x; asm volatile("" : "+v"(tid_));
    const int tid = tid_, lane = tid & 63, r32 = lane & 31, hi = lane >> 5, wid = __builtin_amdgcn_readfirstlane(tid >> 6);
    const int hh = sh >> 1, NT = 4 * qb + 5;
    const int rb = 2 * (wid & 3) + (wid >> 2);
    const int cqw = 4 * qb + 1 + (rb >> 1);
    const int qrow0 = ROW_X0 + 256 * qb + 32 * rb;
    bf16x8 qr[4];
    { const bf16* Qw = AQ + (size_t)(qrow0 + r32) * 1024 + sh * 64 + hi * 8;
#pragma unroll
      for (int d0 = 0; d0 < 4; ++d0) qr[d0] = *(const bf16x8*)(Qw + d0 * 16); }
    const bf16* ksrc = AK + (size_t)(ROW_PAD0 + lane) * 1024 + sh * 64 + wid * 8;
    const bf16* vsrc = AV + (size_t)(ROW_PAD0 + 32 * (wid & 1) + (lane >> 2)) * 1024 + hh * 128 + (wid >> 1) * 32 + (lane & 3) * 8;
    LAS float* wsf = (LAS float*)(lds + L_WS) + wid * 64;
    const LAS unsigned char* kbase = lds + L_K + hi * 1024 + r32 * 16;
    const LAS unsigned char* vbase = lds + L_V + ((lane >> 4) & 1) * 32 + (lane & 3) * 8 + (4 * hi + ((lane & 15) >> 2)) * 64;
#define FA_DMA(t) do { const size_t go_ = (size_t)(t) * 65536; const int sl_ = (t) & (NSLOT - 1); \
        __builtin_amdgcn_global_load_lds((const unsigned*)(ksrc + go_), (LAS unsigned*)(lds + L_K + sl_ * KSLOT + wid * 1024), 16, 0, 0); \
        __builtin_amdgcn_global_load_lds((const unsigned*)(vsrc + go_), (LAS unsigned*)(lds + L_V + sl_ * VSLOT + wid * 2048), 16, 0, 0); \
        __builtin_amdgcn_global_load_lds((const unsigned*)(vsrc + go_ + 16 * 1024), (LAS unsigned*)(lds + L_V + sl_ * VSLOT + wid * 2048 + 1024), 16, 0, 0); } while (0)
    f32x16 o[4];
#pragma unroll
    for (int d0 = 0; d0 < 4; ++d0)
#pragma unroll
        for (int r = 0; r < 16; ++r) o[d0][r] = 0.f;
    f32x16 negm;
#pragma unroll
    for (int r = 0; r < 16; ++r) negm[r] = 0.f;
    float m = 0.f, l = 0.f;
    asm volatile("s_waitcnt vmcnt(0)" ::: "memory");
    FA_DMA(0); FA_DMA(1);
    asm volatile("s_waitcnt vmcnt(3)" ::: "memory");
    if (wid >= 4) FA_BAR();
    FA_BAR();
    for (int t = 0; t < NT; ++t) {
        const int sl = t & (NSLOT - 1);
        if (t + 2 < NT) FA_DMA(t + 2);
        v4u pw[4];
        if (t <= cqw) {
            const LAS unsigned char* kp = kbase + sl * KSLOT;
            f32x16 p0, p1;
            { const bf16x8 k0 = *(const LAS bf16x8*)(kp), k1 = *(const LAS bf16x8*)(kp + 512);
              p0 = __builtin_amdgcn_mfma_f32_32x32x16_bf16(k0, qr[0], negm, 0, 0, 0);
              p1 = __builtin_amdgcn_mfma_f32_32x32x16_bf16(k1, qr[0], negm, 0, 0, 0); }
#pragma unroll
            for (int d0 = 1; d0 < 4; ++d0) {
                const bf16x8 k0 = *(const LAS bf16x8*)(kp + d0 * 2048), k1 = *(const LAS bf16x8*)(kp + d0 * 2048 + 512);
                p0 = __builtin_amdgcn_mfma_f32_32x32x16_bf16(k0, qr[d0], p0, 0, 0, 0);
                p1 = __builtin_amdgcn_mfma_f32_32x32x16_bf16(k1, qr[d0], p1, 0, 0, 0); }
            if (t == 0) {
#pragma unroll
                for (int r = 0; r < 16; ++r) p0[r] = -INFINITY;
#pragma unroll
                for (int r = 0; r < 8; ++r) p1[r] = -INFINITY;
                float rm = FA_MX3(p1[8], p1[9], p1[10]); rm = FA_MX3(rm, p1[11], p1[12]); rm = FA_MX3(rm, p1[13], p1[14]); rm = __builtin_fmaxf(rm, p1[15]);
                { auto rr = __builtin_amdgcn_permlane32_swap(__float_as_uint(rm), __float_as_uint(rm), false, false); rm = __builtin_fmaxf(__uint_as_float(rr[0]), __uint_as_float(rr[1])); }
                m = rm;
#pragma unroll
                for (int r = 8; r < 16; ++r) p1[r] -= rm;
#pragma unroll
                for (int r = 0; r < 16; ++r) negm[r] = -m;
            } else {
                float a = FA_MX3(p0[0], p0[1], p1[0]), b = FA_MX3(p0[2], p0[3], p1[1]); a = FA_MX3(a, p1[2], p1[3]);
#pragma unroll
                for (int r = 4; r < 16; r += 4) { a = FA_MX3(a, p0[r], p0[r + 1]); b = FA_MX3(b, p0[r + 2], p0[r + 3]); a = FA_MX3(a, p1[r], p1[r + 1]); b = FA_MX3(b, p1[r + 2], p1[r + 3]); }
                float rm = __builtin_fmaxf(a, b);
                { auto rr = __builtin_amdgcn_permlane32_swap(__float_as_uint(rm), __float_as_uint(rm), false, false); rm = __builtin_fmaxf(__uint_as_float(rr[0]), __uint_as_float(rr[1])); }
                if (__builtin_expect(__any(rm > THR), 0)) {
                    const float dl = __builtin_fmaxf(rm, 0.f); m += dl;
#pragma unroll
                    for (int r = 0; r < 16; ++r) { p0[r] -= dl; p1[r] -= dl; negm[r] = -m; }
                    const float f = __builtin_amdgcn_exp2f(-dl); l *= f;
                    if (hi == 0) wsf[r32] = f;
#pragma unroll
                    for (int r = 0; r < 16; ++r) { const float a2 = wsf[crow(r, hi)];
#pragma unroll
                        for (int d0 = 0; d0 < 4; ++d0) o[d0][r] *= a2; }
                }
            }
            float ls0 = 0.f, ls1 = 0.f;
#pragma unroll
            for (int r = 0; r < 16; ++r) { p0[r] = __builtin_amdgcn_exp2f(p0[r]); p1[r] = __builtin_amdgcn_exp2f(p1[r]); ls0 += p0[r]; ls1 += p1[r]; }
            l += ls0 + ls1;
#pragma unroll
            for (int i = 0; i < 4; ++i) { pw[0][i] = cvtpk(p0[2 * i], p0[2 * i + 1]); pw[1][i] = cvtpk(p0[8 + 2 * i], p0[8 + 2 * i + 1]); pw[2][i] = cvtpk(p1[2 * i], p1[2 * i + 1]); pw[3][i] = cvtpk(p1[8 + 2 * i], p1[8 + 2 * i + 1]); }
        }
        if (t + 2 < NT) asm volatile("s_waitcnt vmcnt(3) lgkmcnt(0)" ::: "memory"); else asm volatile("s_waitcnt vmcnt(0) lgkmcnt(0)" ::: "memory");
        FA_BAR();
        if (t <= cqw) {
            const LAS unsigned char* vp = vbase + sl * VSLOT;
#pragma unroll
            for (int d0 = 0; d0 < 4; ++d0)
#pragma unroll
                for (int ks = 0; ks < 4; ++ks) {
                    const s16x4 lo = vtr(vp + d0 * 4096 + ks * 1024), hi4 = vtr(vp + d0 * 4096 + ks * 1024 + 512);
                    const bf16x8 vf = (bf16x8){lo[0], lo[1], lo[2], lo[3], hi4[0], hi4[1], hi4[2], hi4[3]};
                    o[d0] = __builtin_amdgcn_mfma_f32_32x32x16_bf16(__builtin_bit_cast(bf16x8, pw[ks]), vf, o[d0], 0, 0, 0); }
        }
        asm volatile("s_waitcnt lgkmcnt(0)" ::: "memory");
        FA_BAR();
    }
    if (wid < 4) FA_BAR();
    { auto rr = __builtin_amdgcn_permlane32_swap(__float_as_uint(l), __float_as_uint(l), false, false); l = __uint_as_float(rr[0]) + __uint_as_float(rr[1]); }
    if (hi == 0) wsf[32 + r32] = l;
    bf16* Ow = OS + (size_t)qrow0 * 2048 + sh * 128 + r32;
#pragma unroll
    for (int r = 0; r < 16; ++r) { const float rl = __builtin_amdgcn_rcpf(wsf[32 + crow(r, hi)]); bf16* op = Ow + (size_t)crow(r, hi) * 2048;
#pragma unroll
        for (int d0 = 0; d0 < 4; ++d0) op[d0 * 32] = (bf16)f2bf(o[d0][r] * rl); }
    asm volatile("s_waitcnt lgkmcnt(0)" ::: "memory");
    FA_BAR();
#undef FA_DMA
}
}
namespace ml {
typedef float f32x16 __attribute__((ext_vector_type(16)));
typedef short s16x4 __attribute__((ext_vector_type(4)));
constexpr int L_QI = 0, L_KI = 16384, L_VI = 32768, L_SM = 69632, HL_LD = 260;
constexpr int S_WJ = 0, S_US = 64, S_TS = 128, S_WINT = 192, S_EMR = 256, S_RS = 320, S_DINV = 384, S_QN = 448;
__device__ __forceinline__ float wave_scan_add(float v, int lane) {
#pragma unroll
    for (int o = 1; o < 64; o <<= 1) { const float t = __shfl_up(v, o); if (lane >= o) v += t; }
    return v;
}
__device__ __forceinline__ float wave_scan_max(float v, int lane) {
#pragma unroll
    for (int o = 1; o < 64; o <<= 1) { const float t = __shfl_up(v, o); if (lane >= o) v = fmaxf(v, t); }
    return v;
}
__device__ __forceinline__ float wave_max(float v) {
#pragma unroll
    for (int o = 1; o < 64; o <<= 1) v = fmaxf(v, __shfl_xor(v, o));
    return v;
}
__device__ __forceinline__ void conv16(const bf16* QK, const float* cw, const float* cb, int R, int cc0, float (&out)[16]) {
    float a[16];
#pragma unroll
    for (int q = 0; q < 4; ++q) { const f32x4 b = *(const f32x4*)(cb + cc0 + 4 * q); a[4 * q] = b.x; a[4 * q + 1] = b.y; a[4 * q + 2] = b.z; a[4 * q + 3] = b.w; }
#pragma unroll
    for (int jj = 0; jj < 4; ++jj) { const int Rr = R - 3 + jj;
        if (Rr >= ROW_META0) { const v4u x0 = *(const v4u*)(QK + (size_t)Rr * 1024 + cc0), x1 = *(const v4u*)(QK + (size_t)Rr * 1024 + cc0 + 8);
            const unsigned xw[8] = {x0.x, x0.y, x0.z, x0.w, x1.x, x1.y, x1.z, x1.w};
#pragma unroll
            for (int q = 0; q < 4; ++q) { const f32x4 w = *(const f32x4*)(cw + jj * 1024 + cc0 + 4 * q);
                a[4 * q] += w.x * pg8::bflo(xw[2 * q]); a[4 * q + 1] += w.y * pg8::bfhi(xw[2 * q]); a[4 * q + 2] += w.z * pg8::bflo(xw[2 * q + 1]); a[4 * q + 3] += w.w * pg8::bfhi(xw[2 * q + 1]); } } }
#pragma unroll
    for (int i = 0; i < 16; ++i) out[i] = a[i] * pg8::sigm(a[i]);
}
__device__ __forceinline__ s16x4 vtr(const LAS unsigned char* p) { return __builtin_bit_cast(s16x4, __builtin_amdgcn_ds_read_tr16_b64_v4i16((LAS fa::v4i16_t*)p)); }
#define ML_FRAG(base, off) ({ const s16x4 lo_ = ml::vtr((base) + (off)), hi_ = ml::vtr((base) + (off) + 512); (bf16x8){lo_[0], lo_[1], lo_[2], lo_[3], hi_[0], hi_[1], hi_[2], hi_[3]}; })

__device__ __forceinline__ void v_dma(LAS unsigned char* lds, const bf16* MV, int R0, int h, int wid, int lane) {
#pragma unroll
    for (int i = 0; i < 4; ++i)
        __builtin_amdgcn_global_load_lds((const unsigned*)(MV + (size_t)(R0 + 16 * i + (lane >> 2)) * 1024 + h * 256 + wid * 32 + (lane & 3) * 8), (LAS unsigned*)(lds + L_VI + (4 * wid + i) * 1024), 16, 0, 0);
}

__device__ __forceinline__ void stepA(LAS unsigned char* lds, int c, int h, const bf16* QK, const bf16* MV, const float* GATES, const float* cw, const float* cb, float* DCT, float* DN, float* MSC) {
    int tid_ = threadIdx.x; asm volatile("" : "+v"(tid_));
    const int tid = tid_, lane = tid & 63, r32 = lane & 31, hi = lane >> 5, wid = __builtin_amdgcn_readfirstlane(tid >> 6);
    const int R0 = ROW_PAD0 + 64 * c; LAS float* sm = (LAS float*)(lds + L_SM);
    if (wid == 0) { const int R = R0 + lane; const float li = GATES[(size_t)R * 8 + h], lf = GATES[(size_t)R * 8 + 4 + h];
        const float b = wave_scan_add(lf, lane), g = __shfl(b, 63), a = g - b + li, mloc = wave_max(a);
        sm[S_WJ + lane] = __expf(a - mloc);
        if (lane == 0) { MSC[(c * 4 + h) * 4 + 0] = g; MSC[(c * 4 + h) * 4 + 1] = mloc; } }
    v_dma(lds, MV, R0, h, wid, lane);
    __syncthreads();
    { const int j = tid >> 3, part = tid & 7, R = R0 + j; float kv[16];
      if (R >= ROW_META0) { conv16(QK, cw, cb, R, 512 + h * 128 + part * 16, kv); const float s = 0.08838834764831845f * sm[S_WJ + j];
#pragma unroll
          for (int i = 0; i < 16; ++i) kv[i] *= s; }
      else {
#pragma unroll
          for (int i = 0; i < 16; ++i) kv[i] = 0.f; }
      v4u w0, w1; w0.x = pk2(kv[0], kv[1]); w0.y = pk2(kv[2], kv[3]); w0.z = pk2(kv[4], kv[5]); w0.w = pk2(kv[6], kv[7]); w1.x = pk2(kv[8], kv[9]); w1.y = pk2(kv[10], kv[11]); w1.z = pk2(kv[12], kv[13]); w1.w = pk2(kv[14], kv[15]);
      LAS unsigned char* kp = lds + L_KI + (part >> 1) * 4096 + j * 64 + (part & 1) * 32;
      *(LAS v4u*)kp = w0; *(LAS v4u*)(kp + 16) = w1; }
    asm volatile("s_waitcnt vmcnt(0) lgkmcnt(0)" ::: "memory");
    __syncthreads();
    { const LAS unsigned char* tb = lds + ((lane >> 4) & 1) * 32 + (lane & 3) * 8 + (4 * hi + ((lane & 15) >> 2)) * 64;
      bf16x8 af[4];
#pragma unroll
      for (int s = 0; s < 4; ++s) af[s] = ML_FRAG(tb + L_VI + wid * 4096, s * 1024);
      float* outp = DCT + ((size_t)(c * 4 + h) * 256 + wid * 32) * 128 + r32;
#pragma unroll
      for (int db = 0; db < 4; ++db) { f32x16 acc;
#pragma unroll
          for (int r = 0; r < 16; ++r) acc[r] = 0.f;
#pragma unroll
          for (int s = 0; s < 4; ++s) { const bf16x8 bfr = ML_FRAG(tb + L_KI + db * 4096, s * 1024); acc = __builtin_amdgcn_mfma_f32_32x32x16_bf16(af[s], bfr, acc, 0, 0, 0); }
#pragma unroll
          for (int r = 0; r < 16; ++r) outp[(size_t)fa::crow(r, hi) * 128 + db * 32] = acc[r]; } }
    if (tid < 128) { const int d = tid; const LAS unsigned char* kp = lds + L_KI + (d >> 5) * 4096 + (d & 31) * 2; float s = 0.f;
#pragma unroll 8
        for (int j = 0; j < 64; ++j) s += bf2f(*(const LAS bf16*)(kp + j * 64));
        DN[(size_t)(c * 4 + h) * 128 + d] = s; }
    __syncthreads();
}

__device__ __forceinline__ void stepB(int gtid, int ngt, const float* DCT, const float* DN, float* MSC, bf16* CT, float* NPREV) {
    for (int idx = gtid; idx < 4 * 32768; idx += ngt) { const int h = idx >> 15, ed = idx & 32767; const bool isn = ed < 128;
        float C = 0.f, n = 0.f, m = 0.f;
        for (int c0 = 0; c0 < 128; c0 += 8) { float dc[8], dn[8], gg[8], ml_[8];
#pragma unroll
            for (int u = 0; u < 8; ++u) { const int c = c0 + u; dc[u] = DCT[(size_t)(c * 4 + h) * 32768 + ed]; dn[u] = isn ? DN[(size_t)(c * 4 + h) * 128 + ed] : 0.f; gg[u] = MSC[(c * 4 + h) * 4]; ml_[u] = MSC[(c * 4 + h) * 4 + 1]; }
#pragma unroll
            for (int u = 0; u < 8; ++u) { const int c = c0 + u; const float mn = fmaxf(gg[u] + m, ml_[u]), dec = __expf(gg[u] + m - mn), sc = __expf(ml_[u] - mn);
                C = dec * C + sc * dc[u]; n = dec * n + sc * dn[u]; m = mn;
                CT[(size_t)((c + 1) * 4 + h) * 32768 + ed] = (bf16)f2bf(C);
                if (isn) NPREV[(size_t)((c + 1) * 4 + h) * 128 + ed] = n;
                if (ed == 0) MSC[((c + 1) * 4 + h) * 4 + 2] = m; } }
    }
}

__device__ __forceinline__ void stepC(LAS unsigned char* lds, int c, int h, const bf16* QK, const bf16* MV, const bf16* MO, const float* GATES, const float* cw, const float* cb, const bf16* CT, const float* NPREV, const float* MSC, bf16* HMG) {
    int tid_ = threadIdx.x; asm volatile("" : "+v"(tid_));
    const int tid = tid_, lane = tid & 63, r32 = lane & 31, hi = lane >> 5, wid = __builtin_amdgcn_readfirstlane(tid >> 6);
    const int R0 = ROW_PAD0 + 64 * c; LAS float* sm = (LAS float*)(lds + L_SM);
    if (wid == 0) { const int R = R0 + lane; const float li = GATES[(size_t)R * 8 + h], lf = GATES[(size_t)R * 8 + 4 + h], mprev = MSC[(c * 4 + h) * 4 + 2];
        const float b = wave_scan_add(lf, lane), u = li - b, pm = wave_scan_max(u, lane), mrow = b + fmaxf(mprev, pm);
        sm[S_US + lane] = u; sm[S_TS + lane] = b - mrow; sm[S_WINT + lane] = __expf(b + mprev - mrow); sm[S_EMR + lane] = __expf(-mrow); }
    v_dma(lds, MV, R0, h, wid, lane);
    { const int j = tid >> 3, part = tid & 7, R = R0 + j; float qv[16], kv[16];
      conv16(QK, cw, cb, R, h * 128 + part * 16, qv); conv16(QK, cw, cb, R, 512 + h * 128 + part * 16, kv);
      const float* np = NPREV + (size_t)(c * 4 + h) * 128 + part * 16; float qn = 0.f;
#pragma unroll
      for (int q = 0; q < 4; ++q) { const f32x4 nv = *(const f32x4*)(np + 4 * q); qn += (qv[4 * q] * nv.x + qv[4 * q + 1] * nv.y) + (qv[4 * q + 2] * nv.z + qv[4 * q + 3] * nv.w); }
      sm[S_QN + part * 64 + j] = qn;
#pragma unroll
      for (int i = 0; i < 16; ++i) kv[i] *= 0.08838834764831845f;
      v4u w0, w1; w0.x = pk2(qv[0], qv[1]); w0.y = pk2(qv[2], qv[3]); w0.z = pk2(qv[4], qv[5]); w0.w = pk2(qv[6], qv[7]); w1.x = pk2(qv[8], qv[9]); w1.y = pk2(qv[10], qv[11]); w1.z = pk2(qv[12], qv[13]); w1.w = pk2(qv[14], qv[15]);
      *(LAS v4u*)(lds + L_QI + (2 * part) * 1024 + j * 16) = w0; *(LAS v4u*)(lds + L_QI + (2 * part + 1) * 1024 + j * 16) = w1;
      w0.x = pk2(kv[0], kv[1]); w0.y = pk2(kv[2], kv[3]); w0.z = pk2(kv[4], kv[5]); w0.w = pk2(kv[6], kv[7]); w1.x = pk2(kv[8], kv[9]); w1.y = pk2(kv[10], kv[11]); w1.z = pk2(kv[12], kv[13]); w1.w = pk2(kv[14], kv[15]);
      *(LAS v4u*)(lds + L_KI + (2 * part) * 1024 + j * 16) = w0; *(LAS v4u*)(lds + L_KI + (2 * part + 1) * 1024 + j * 16) = w1; }
    asm volatile("s_waitcnt vmcnt(0) lgkmcnt(0)" ::: "memory");
    __syncthreads();
    const int ib = wid & 1, ep = wid >> 1;
    f32x16 acc[2];
    {
        bf16x8 qf[8];
#pragma unroll
        for (int s = 0; s < 8; ++s) qf[s] = *(const LAS bf16x8*)(lds + L_QI + (2 * s + hi) * 1024 + (32 * ib + r32) * 16);
#pragma unroll
        for (int eb = 0; eb < 2; ++eb) {
#pragma unroll
            for (int r = 0; r < 16; ++r) acc[eb][r] = 0.f;
            const bf16* cp = CT + ((size_t)(c * 4 + h) * 256 + (2 * ep + eb) * 32 + r32) * 128 + 8 * hi;
#pragma unroll
            for (int s = 0; s < 8; ++s) { const bf16x8 cf = *(const bf16x8*)(cp + 16 * s); acc[eb] = __builtin_amdgcn_mfma_f32_32x32x16_bf16(qf[s], cf, acc[eb], 0, 0, 0); } }
#pragma unroll
        for (int r = 0; r < 16; ++r) { const float wv = sm[S_WINT + 32 * ib + fa::crow(r, hi)]; acc[0][r] *= wv; acc[1][r] *= wv; }
        f32x16 p0, p1;
#pragma unroll
        for (int r = 0; r < 16; ++r) { p0[r] = 0.f; p1[r] = 0.f; }
#pragma unroll
        for (int s = 0; s < 8; ++s) { const bf16x8 k0 = *(const LAS bf16x8*)(lds + L_KI + (2 * s + hi) * 1024 + r32 * 16); p0 = __builtin_amdgcn_mfma_f32_32x32x16_bf16(k0, qf[s], p0, 0, 0, 0); }
        if (ib == 1) {
#pragma unroll
            for (int s = 0; s < 8; ++s) { const bf16x8 k1 = *(const LAS bf16x8*)(lds + L_KI + (2 * s + hi) * 1024 + (32 + r32) * 16); p1 = __builtin_amdgcn_mfma_f32_32x32x16_bf16(k1, qf[s], p1, 0, 0, 0); } }
        const int i = 32 * ib + r32; const float ti = sm[S_TS + i]; float rs = 0.f;
#pragma unroll
        for (int r = 0; r < 16; ++r) { const int j = fa::crow(r, hi);
            p0[r] = (j <= i) ? p0[r] * __expf(ti + sm[S_US + j]) : 0.f;
            p1[r] = (ib == 1 && j + 32 <= i) ? p1[r] * __expf(ti + sm[S_US + j + 32]) : 0.f;
            rs += p0[r] + p1[r]; }
        { auto rr = __builtin_amdgcn_permlane32_swap(__float_as_uint(rs), __float_as_uint(rs), false, false); rs = __uint_as_float(rr[0]) + __uint_as_float(rr[1]); }
        if (ep == 0 && hi == 0) sm[S_RS + i] = rs;
        v4u pw[4];
#pragma unroll
        for (int q = 0; q < 4; ++q) { pw[0][q] = pg8::cvt_pk_bf16(p0[2 * q], p0[2 * q + 1]); pw[1][q] = pg8::cvt_pk_bf16(p0[8 + 2 * q], p0[8 + 2 * q + 1]); pw[2][q] = pg8::cvt_pk_bf16(p1[2 * q], p1[2 * q + 1]); pw[3][q] = pg8::cvt_pk_bf16(p1[8 + 2 * q], p1[8 + 2 * q + 1]); }
        const LAS unsigned char* tb = lds + L_VI + ((lane >> 4) & 1) * 32 + (lane & 3) * 8 + (4 * hi + ((lane & 15) >> 2)) * 64;
#pragma unroll
        for (int eb = 0; eb < 2; ++eb) {
#pragma unroll
            for (int ks = 0; ks < 2; ++ks) { const bf16x8 vf = ML_FRAG(tb + (2 * ep + eb) * 4096, ks * 1024); acc[eb] = __builtin_amdgcn_mfma_f32_32x32x16_bf16(__builtin_bit_cast(bf16x8, pw[ks]), vf, acc[eb], 0, 0, 0); }
            if (ib == 1) {
#pragma unroll
                for (int ks = 2; ks < 4; ++ks) { const bf16x8 vf = ML_FRAG(tb + (2 * ep + eb) * 4096, ks * 1024); acc[eb] = __builtin_amdgcn_mfma_f32_32x32x16_bf16(__builtin_bit_cast(bf16x8, pw[ks]), vf, acc[eb], 0, 0, 0); } } }
    }
    __syncthreads();
    if (tid < 64) { float qn = 0.f;
#pragma unroll
        for (int p = 0; p < 8; ++p) qn += sm[S_QN + p * 64 + tid];
        const float den = sm[S_WINT + tid] * qn + sm[S_RS + tid]; sm[S_DINV + tid] = 1.0f / fmaxf(fabsf(den), sm[S_EMR + tid]); }
    __syncthreads();
    { LAS float* HL = (LAS float*)lds;
#pragma unroll
      for (int r = 0; r < 16; ++r) { const int i = 32 * ib + fa::crow(r, hi); const float dv = sm[S_DINV + i];
          HL[i * HL_LD + (2 * ep) * 32 + r32] = acc[0][r] * dv; HL[i * HL_LD + (2 * ep + 1) * 32 + r32] = acc[1][r] * dv; } }
    __syncthreads();
    { const LAS float* HL = (const LAS float*)lds; const int i = tid >> 3, part = tid & 7; f32x4 v[8]; float ss = 0.f;
#pragma unroll
      for (int k = 0; k < 8; ++k) { v[k] = *(const LAS f32x4*)(HL + i * HL_LD + 32 * k + 4 * part); ss += (v[k].x * v[k].x + v[k].y * v[k].y) + (v[k].z * v[k].z + v[k].w * v[k].w); }
      ss += __shfl_xor(ss, 1); ss += __shfl_xor(ss, 2); ss += __shfl_xor(ss, 4);
      const float rs = 1.0f / sqrtf(ss * (1.0f / 256.0f) + EPS);
      const size_t go = (size_t)(R0 + i) * 1024 + h * 256 + 4 * part;
#pragma unroll
      for (int k = 0; k < 8; ++k) { const v2u mo = *(const v2u*)(MO + go + 32 * k);
          v2u w; w.x = pk2(v[k].x * rs * pg8::bflo(mo.x), v[k].y * rs * pg8::bfhi(mo.x)); w.y = pk2(v[k].z * rs * pg8::bflo(mo.y), v[k].w * rs * pg8::bfhi(mo.y));
          *(v2u*)(HMG + go + 32 * k) = w; } }
    __syncthreads();
}
}
namespace sk {
template <int NS> __device__ __forceinline__ f32x4 mma(const bf16* A, int lda, const bf16* W, int ldw, int lane) {
    const bf16* ap = A + (size_t)(lane & 15) * lda + 8 * (lane >> 4); const bf16* wp = W + (size_t)(lane & 15) * ldw + 8 * (lane >> 4);
    bf16x8 a[NS], b[NS];
#pragma unroll
    for (int s = 0; s < NS; ++s) { a[s] = *(const bf16x8*)(ap + 32 * s); b[s] = *(const bf16x8*)(wp + 32 * s); }
    f32x4 acc = {0.f, 0.f, 0.f, 0.f};
#pragma unroll
    for (int s = 0; s < NS; ++s) acc = __builtin_amdgcn_mfma_f32_16x16x32_bf16(a[s], b[s], acc, 0, 0, 0);
    return acc;
}
__device__ __forceinline__ void put(LAS float* red, int wid, int lane, f32x4 acc) {
    red[wid * 256 + lane] = acc.x; red[wid * 256 + 64 + lane] = acc.y; red[wid * 256 + 128 + lane] = acc.z; red[wid * 256 + 192 + lane] = acc.w;
}
__device__ __forceinline__ int eidx(int r, int c) { return (r & 3) * 64 + (r >> 2) * 16 + c; }

__device__ __forceinline__ void up_task(LAS float* red, int ht, const bf16* XA, const bf16* WUP, bf16* HID, int tid, int wid, int lane) {
    const int h0 = 16 * ht, pn = h0 >> 7, j = h0 & 127, which = wid & 1, ks = wid >> 1;
    const f32x4 acc = mma<16>(XA + (size_t)ROW_META0 * DM + 512 * ks, DM, WUP + (size_t)(256 * pn + 128 * which + j) * DM + 512 * ks, DM, lane);
    put(red, wid, lane, acc);
    __syncthreads();
    if (tid < 256) { const int r = tid >> 4, c = tid & 15, e = eidx(r, c); float g = 0.f, u = 0.f;
#pragma unroll
        for (int k = 0; k < 4; ++k) { g += red[(2 * k) * 256 + e]; u += red[(2 * k + 1) * 256 + e]; }
        HID[(size_t)(ROW_META0 + r) * DFF + h0 + c] = (bf16)f2bf(g * pg8::sigm(g) * u); }
    __syncthreads();
}
__device__ __forceinline__ void down_task(LAS float* red, int task, const bf16* HID, const bf16* WDN, float* YM, int tid, int wid, int lane) {
    const int ct = task >> 1, kh = task & 1, k0 = 2816 * kh + 352 * wid;
    const f32x4 acc = mma<11>(HID + (size_t)ROW_META0 * DFF + k0, DFF, WDN + (size_t)(16 * ct) * DFF + k0, DFF, lane);
    put(red, wid, lane, acc);
    __syncthreads();
    if (tid < 256) { const int r = tid >> 4, c = tid & 15, e = eidx(r, c); float s = 0.f;
#pragma unroll
        for (int k = 0; k < 8; ++k) s += red[k * 256 + e];
        YM[(size_t)(kh * 16 + r) * DM + 16 * ct + c] = s; }
    __syncthreads();
}
__device__ __forceinline__ void in_task(LAS float* red, int task, const bf16* XA, const bf16* WIN, const float* BIAS, const float* ROPE, bf16* Z, int tid, int wid, int lane) {
    const int col0 = (task < 128) ? 16 * task : 4096 + 16 * (task - 128);
    const f32x4 acc = mma<8>(XA + (size_t)ROW_META0 * DM + 256 * wid, DM, WIN + (size_t)col0 * DM + 256 * wid, DM, lane);
    put(red, wid, lane, acc);
    __syncthreads();
    LAS float* til = red + 8 * 256;
    if (tid < 256) { const int r = tid >> 4, c = tid & 15, e = eidx(r, c); float s = 0.f;
#pragma unroll
        for (int k = 0; k < 8; ++k) s += red[k * 256 + e];
        til[r * 16 + c] = s + BIAS[col0 + c]; }
    __syncthreads();
    if (tid < 256) { const int r = tid >> 4, c = tid & 15; float v = til[r * 16 + c];
        const int piece = col0 >> 10, pc = col0 & 1023;
        if (piece == 4 && (pc & 63) == 0) {
            const float o = til[r * 16 + (c ^ 8)]; const int i = c & 7; const float cs = ROPE[r * 16 + i], sn = ROPE[r * 16 + 8 + i];
            v = (c < 8) ? (v * cs - o * sn) : (v * cs + o * sn); }
        Z[(size_t)piece * ZPIECE + (size_t)(ROW_META0 + r) * 1024 + pc + c] = (bf16)f2bf(v); }
    __syncthreads();
}
}
__global__ void __launch_bounds__(NTHREADS, 2) mega_fwd(Args args) {
    extern __shared__ __attribute__((aligned(16))) unsigned char lds_raw[];
    LAS unsigned char* lds = (LAS unsigned char*)lds_raw;
    volatile LAS unsigned* MISC = (volatile LAS unsigned*)(lds + MISC_OFF);
    const int tid = threadIdx.x, lane = tid & 63, wave = __builtin_amdgcn_readfirstlane(tid >> 6);
    const int G = gridDim.x, bx = blockIdx.x;
    const int vcu = (G % 8 == 0) ? (bx % 8) * (G / 8) + bx / 8 : bx;
    unsigned char* ws = args.ws;
    gu32* ctl = (gu32*)(ws + WS_CTL);
    for (int u = tid; u < (LDS_BYTES - LDSCTL_OFF) / 4; u += NTHREADS) ((LAS unsigned*)(lds + LDSCTL_OFF))[u] = 0u;
    __syncthreads();
    XcdBarrier bar = xcd_barrier_post((unsigned*)(ctl + CW_BAR), MISC + 8);
#define GRID_BAR() xcd_barrier(bar)

    float* ROPE = (float*)(ws + WS_ROPE); float* BIAS = (float*)(ws + WS_BIAS); float* GW = (float*)(ws + WS_GW); float* METAH = (float*)(ws + WS_METAH);
    float* GATES = (float*)(ws + WS_GATES); float* YM = (float*)(ws + WS_YM);
    bf16* WUP = (bf16*)(ws + WS_WUP); bf16* WDN = (bf16*)(ws + WS_WDN); bf16* WIN = (bf16*)(ws + WS_WIN); bf16* WMB = (bf16*)(ws + WS_WMB); bf16* WAB = (bf16*)(ws + WS_WAB); bf16* WOUT = (bf16*)(ws + WS_WOUT);
    bf16* XA = (bf16*)(ws + WS_XA); bf16* HID = (bf16*)(ws + WS_HID); float* Y = (float*)(ws + WS_Y); bf16* Z = (bf16*)(ws + WS_Z); bf16* YG = (bf16*)(ws + WS_YG);
    bf16* HMG = (bf16*)(ws + WS_HMG); bf16* HA = (bf16*)(ws + WS_HA); bf16* CT = (bf16*)(ws + WS_HM); float* DCT = (float*)(ws + WS_DCT); float* DNB = (float*)(ws + WS_DN); float* NPREV = (float*)(ws + WS_NPREV); float* MSC = (float*)(ws + WS_MSC);
    bf16* ZQK = Z; bf16* ZMV = Z + ZPIECE; bf16* ZMO = Z + 2 * ZPIECE; bf16* ZAQ = Z + 3 * ZPIECE; bf16* ZAK = Z + 4 * ZPIECE; bf16* ZAV = Z + 5 * ZPIECE;
    bf16* ZGM = Z + 6 * ZPIECE; bf16* ZGA = ZGM + (size_t)MP * 2048;
    const int gw = vcu * NWAVES + wave, NGW = G * NWAVES;
    LAS float* scr = (LAS float*)(lds + wave * 16384);

#if PH_MASK & (1 << 0)
    {
        convert_ffn<false>(args.in[I_F1G], args.in[I_F1U], args.in[I_F1D], args.in[I_F1PRE], WUP, WDN, scr, gw, NGW, lane);
        constexpr int N_IN = (DM / 64) * (NIN / 32), N_MB = (1024 / 64) * (DM / 32), N_WO = (DM / 64) * (DM / 32);
#define DESC_REST(it, D) do { int r = (it); \
            if (r < N_IN) { const int nblk = NIN / 32, kb = r / nblk, nb = r % nblk, row0 = 32 * nb; const int col0 = row0 < 3072 ? row0 : row0 + 8; \
                D.src = args.in[I_WIN] + (size_t)(64 * kb) * NIN_SRC + col0; D.dst = WIN + (size_t)row0 * DM + 64 * kb; D.sk = args.in[I_MIXPRE] + 64 * kb; D.scal = 1.0f; D.ldw = NIN_SRC; D.K = DM; } \
            else if ((r -= N_IN) < N_MB) { const int nblk = DM / 32, kb = r / nblk, nb = r % nblk; \
                D.src = args.in[I_MWB] + (size_t)(64 * kb) * DM + 32 * nb; D.dst = WMB + (size_t)(32 * nb) * 1024 + 64 * kb; D.sk = args.in[I_MNORM] + 64 * kb; D.scal = 1.0f; D.ldw = DM; D.K = 1024; } \
            else if ((r -= N_MB) < N_MB) { const int nblk = DM / 32, kb = r / nblk, nb = r % nblk; \
                D.src = args.in[I_AWB] + (size_t)(64 * kb) * DM + 32 * nb; D.dst = WAB + (size_t)(32 * nb) * 1024 + 64 * kb; D.sk = args.in[I_ANORM] + 64 * kb; D.scal = 0.8f; D.ldw = DM; D.K = 1024; } \
            else { r -= N_MB; const int nblk = DM / 32, kb = r / nblk, nb = r % nblk; \
                D.src = args.in[I_WOUT] + (size_t)(64 * kb) * DM + 32 * nb; D.dst = WOUT + (size_t)(32 * nb) * DM + 64 * kb; D.sk = nullptr; D.scal = 1.0f; D.ldw = DM; D.K = DM; } } while (0)
        CONVERT_LOOP(N_IN + 2 * N_MB + N_WO, DESC_REST);
#undef DESC_REST
        const int gt = vcu * NTHREADS + tid, NGT = G * NTHREADS;
        for (int i = gt; i < NIN; i += NGT) BIAS[i] = args.in[I_BIN][i < 3072 ? i : i + 8];
        for (int i = gt; i < 8 * DM; i += NGT) { const int c = i / DM, k = i % DM; GW[i] = args.in[I_WIN][(size_t)k * NIN_SRC + 3072 + c] * args.in[I_MIXPRE][k]; }
        for (int i = gt; i < (SEQ + NMETA) * 8; i += NGT) { const int pos = i >> 3, k = i & 7;
            const float invf = k == 0 ? 1.0f : k == 1 ? 0.19392274474868576f : k == 2 ? 0.03760603093086393f : k == 3 ? 0.007292664737217109f : k == 4 ? 0.001414213562373095f : k == 5 ? 0.0002742481756762073f : k == 6 ? 5.318295896944988e-05f : 1.031338537721246e-05f;
            const float ang = (float)pos * invf; const double a = (double)ang;
            const double q = rint(a * 0.15915494309189535); const double rr = a - q * 6.283185307179586476925;
            double s, c; sincos_small(rr, s, c);
            ROPE[(size_t)pos * 16 + k] = (float)c; ROPE[(size_t)pos * 16 + 8 + k] = (float)s; }
        for (int R = gw; R < MP; R += NGW) {
            bf16* xo = XA + (size_t)R * DM;
            if (R < ROW_META0) { GAS v2u* o = (GAS v2u*)xo + lane; v2u z; z.x = 0u; z.y = 0u;
#pragma unroll
                for (int j = 0; j < 8; ++j) o[64 * j] = z; }
            else { const float* hp = (R >= ROW_X0) ? args.in[I_X] + (size_t)(R - ROW_X0) * DM : args.in[I_META] + (size_t)(R - ROW_META0) * DM;
                f32x4 v[8]; load_row(hp, lane, v); const float r1 = 1.0f / sqrtf(row_ssq(v) * (1.0f / DM) + EPS); store_row_bf16(xo, lane, v, r1); }
        }
    }
#endif
    GRID_BAR();

#if PH_MASK & (1 << 1)
    { pg8::Gemm g{XA + (size_t)ROW_X0 * DM, WUP, SEQ, NUP, DM, nullptr, nullptr}; pg8::StaticOrder S; S.init(SEQ, NUP, G, bx); pg8::EpiSwiglu E{HID + (size_t)ROW_X0 * DFF, DFF};
      pg8::gemm_phase<pg8::EpiSwiglu, pg8::StaticOrder, true, true>(lds, g, S, E);
      const int nun = (SEQ / 256) * (NUP / 256), rem = nun % G; const int nshort = rem ? G - rem : G, rank = rem ? bx - rem : bx;
      if (rank >= 0) {
          for (int t = rank; t < DFF / 16; t += nshort) sk::up_task((LAS float*)lds, t, XA, WUP, HID, tid, wave, lane);
          const int gw = rank * NWAVES + wave, NGW = nshort * NWAVES;
          { constexpr int N_DN = (DFF / 64) * (DM / 32);
#define DESC_DN(it, D) do { const int nblk = DM / 32, kb = (it) / nblk, nb = (it) % nblk; D.src = args.in[I_F1D] + (size_t)(64 * kb) * DM + 32 * nb; D.dst = WDN + (size_t)(32 * nb) * DFF + 64 * kb; D.sk = nullptr; D.scal = 1.0f; D.ldw = DM; D.K = DFF; } while (0)
            CONVERT_LOOP(N_DN, DESC_DN);
#undef DESC_DN
          }
      }
    }
#endif
    GRID_BAR();
#if PH_MASK & (1 << 2)
    { pg8::Gemm g{HID + (size_t)ROW_X0 * DFF, WDN, SEQ, DM, DFF, nullptr, nullptr}; pg8::StaticOrder S; S.init(SEQ, DM, G, bx); pg8::EpiF32 E{Y + (size_t)ROW_X0 * DM, DM};
      pg8::gemm_phase<pg8::EpiF32, pg8::StaticOrder, true, true>(lds, g, S, E);
      for (int t = bx; t < 256; t += G) sk::down_task((LAS float*)lds, t, HID, WDN, YM, tid, wave, lane); }
#endif
    GRID_BAR();
#if PH_MASK & (1 << 3)
    {
        { const int gt = vcu * NTHREADS + tid, NGT = G * NTHREADS;
          for (int i = gt; i < 3 * 48 * 128; i += NGT) { const int pz = i / (48 * 128), rem = i % (48 * 128); const int piece = pz == 0 ? 1 : (pz == 1 ? 4 : 5);
            *(GAS v4u*)(Z + (size_t)piece * ZPIECE + (size_t)ROW_PAD0 * 1024 + (size_t)rem * 8) = (v4u){0u, 0u, 0u, 0u}; }
        }
        { const GAS f32x4* gsrc = (const GAS f32x4*)GW; LAS f32x4* gl = (LAS f32x4*)lds;
          for (int i = tid; i < 8 * DM / 4; i += NTHREADS) gl[i] = gsrc[i];
          __syncthreads(); }
        f32x4 g[8]; load_row(args.in[I_F1POST], lane, g);
        for (int R = ROW_PAD0 + gw; R < MP; R += NGW) {
            if (R < ROW_META0) { if (lane < 8) GATES[(size_t)R * 8 + lane] = (lane < 4) ? -INFINITY : 0.f; continue; }
            const float* hp = (R >= ROW_X0) ? args.in[I_X] + (size_t)(R - ROW_X0) * DM : args.in[I_META] + (size_t)(R - ROW_META0) * DM;
            float* ho = (R >= ROW_X0) ? args.out + (size_t)(R - ROW_X0) * DM : METAH + (size_t)(R - ROW_META0) * DM;
            f32x4 y[8], h[8];
            if (R >= ROW_X0) load_row(Y + (size_t)R * DM, lane, y);
            else { f32x4 y2[8]; load_row(YM + (size_t)(R - ROW_META0) * DM, lane, y); load_row(YM + (size_t)(16 + R - ROW_META0) * DM, lane, y2);
#pragma unroll
                for (int j = 0; j < 8; ++j) y[j] = y[j] + y2[j]; }
            load_row(hp, lane, h);
            const float rs = 0.5f / sqrtf(row_ssq(y) * (1.0f / DM) + EPS);
#pragma unroll
            for (int j = 0; j < 8; ++j) h[j] = h[j] + (y[j] * rs) * g[j];
            { GAS f32x4* o = (GAS f32x4*)ho + lane;
#pragma unroll
              for (int j = 0; j < 8; ++j) o[64 * j] = h[j]; }
            const float r2 = 1.0f / sqrtf(row_ssq(h) * (1.0f / DM) + EPS);
            store_row_bf16(XA + (size_t)R * DM, lane, h, r2);
            float gv = 0.f;
#pragma unroll 2
            for (int c = 0; c < 8; ++c) { const LAS f32x4* wp = (const LAS f32x4*)lds + c * (DM / 4) + lane; float s = 0.f;
#pragma unroll
                for (int j = 0; j < 8; ++j) { const f32x4 w = wp[64 * j]; s += (h[j].x * w.x + h[j].y * w.y) + (h[j].z * w.z + h[j].w * w.w); }
                s = wave_sum(s); if (lane == c) gv = s; }
            if (lane < 8) { float v = gv * r2 + args.in[I_BIN][3072 + lane]; if (lane >= 4) v = log_sigmoid(v); GATES[(size_t)R * 8 + lane] = v; }
        }
    }
#endif
    GRID_BAR();
#if PH_MASK & (1 << 4)
    { pg8::Gemm g{XA + (size_t)ROW_X0 * DM, WIN, SEQ, NIN, DM, nullptr, nullptr}; pg8::StaticOrder S; S.init(SEQ, NIN, G, bx); pg8::EpiZ E{Z, BIAS, ROPE, ROW_X0};
      pg8::gemm_phase<pg8::EpiZ, pg8::StaticOrder, true, true>(lds, g, S, E);
      for (int t = bx; t < 256; t += G) sk::in_task((LAS float*)lds, t, XA, WIN, BIAS, ROPE, Z, tid, wave, lane); }
#endif
    GRID_BAR();
#if PH_MASK & (1 << 5)
    {
        for (int it = bx; it < 512; it += G) ml::stepA(lds, it >> 2, it & 3, ZQK, ZMV, GATES, args.in[I_CONVW], args.in[I_CONVB], DCT, DNB, MSC);
    }
    GRID_BAR();
    {
        ml::stepB(vcu * NTHREADS + tid, G * NTHREADS, DCT, DNB, MSC, CT, NPREV);
        bf16* OS = XA;
        for (int u = bx; u < 256; u += G) { const int x = u & 7, j = u >> 3, sh = 2 * x + (j & 1), p = j >> 1;
            fa::attn_unit(lds, sh, p, ZAQ, ZAK, ZAV, OS);
            fa::attn_unit(lds, sh, 31 - p, ZAQ, ZAK, ZAV, OS); }
    }
#endif
    GRID_BAR();
#if PH_MASK & (1 << 6)
    {
        for (int it = bx; it < 512; it += G) ml::stepC(lds, 1 + (it >> 2), it & 3, ZQK, ZMV, ZMO, GATES, args.in[I_CONVW], args.in[I_CONVB], CT, NPREV, MSC, HMG);
        float s1 = 0.f, s2 = 0.f;
        { const float a1 = args.in[I_LQ1][lane] * args.in[I_LK1][lane], a2 = args.in[I_LQ2][lane] * args.in[I_LK2][lane]; s1 = wave_sum(a1); s2 = wave_sum(a2); }
        const float lam = expf(s1) - expf(s2) + 0.2f;
        const bf16* OS = XA;
        for (int R = ROW_X0 + gw; R < MP; R += NGW) {
            const GAS unsigned* osr = (const GAS unsigned*)(OS + (size_t)R * 2048) + lane; GAS unsigned* hao = (GAS unsigned*)(HA + (size_t)R * 1024) + lane;
#pragma unroll
            for (int hh = 0; hh < 8; ++hh) { const unsigned w1 = osr[hh * 128], w2 = osr[hh * 128 + 64];
                const float v0 = pg8::bflo(w1) - lam * pg8::bflo(w2), v1 = pg8::bfhi(w1) - lam * pg8::bfhi(w2);
                const float ss = wave_sum(v0 * v0 + v1 * v1); const float rs = 1.0f / sqrtf(ss * (1.0f / 128.0f) + EPS);
                hao[hh * 64] = pk2(v0 * rs, v1 * rs); }
        }
    }
#endif
    GRID_BAR();
#if PH_MASK & (1 << 7)
    { pg8::Gemm g{HMG + (size_t)ROW_X0 * 1024, WMB, SEQ, DM, 1024, HA + (size_t)ROW_X0 * 1024, WAB}; pg8::DualOrder S; S.init(SEQ, DM, G, bx);
      pg8::EpiGate E{ZGM + (size_t)ROW_X0 * 2048, ZGA + (size_t)ROW_X0 * 2048, YG + (size_t)ROW_X0 * 2048, DM};
      pg8::gemm_phase<pg8::EpiGate, pg8::DualOrder, true, true>(lds, g, S, E); }
#endif
    GRID_BAR();
#if PH_MASK & (1 << 9)
    { pg8::Gemm g{YG + (size_t)ROW_X0 * 2048, WOUT, SEQ, DM, DM, nullptr, nullptr}; pg8::StaticOrder S; S.init(SEQ, DM, G, bx); pg8::EpiF32 E{Y + (size_t)ROW_X0 * DM, DM};
      pg8::gemm_phase<pg8::EpiF32, pg8::StaticOrder, true, true>(lds, g, S, E); }
#endif
    GRID_BAR();
#if PH_MASK & (1 << 10)
    {
        for (int R = ROW_X0 + gw; R < MP; R += NGW) {
            float* ho = args.out + (size_t)(R - ROW_X0) * DM;
            f32x4 y[8], h[8], g[8]; load_row(Y + (size_t)R * DM, lane, y); load_row(ho, lane, h); load_row(args.in[I_MIXPOST], lane, g);
            const float rs = 1.0f / sqrtf(row_ssq(y) * (1.0f / DM) + EPS);
#pragma unroll
            for (int j = 0; j < 8; ++j) h[j] = h[j] + (y[j] * rs) * g[j];
            { GAS f32x4* o = (GAS f32x4*)ho + lane;
#pragma unroll
              for (int j = 0; j < 8; ++j) o[64 * j] = h[j]; }
            const float r2 = 1.0f / sqrtf(row_ssq(h) * (1.0f / DM) + EPS);
            store_row_bf16(XA + (size_t)R * DM, lane, h, r2);
        }
        convert_ffn<true>(args.in[I_F2G], args.in[I_F2U], args.in[I_F2D], args.in[I_F2PRE], WUP, WDN, scr, gw, NGW, lane);
    }
#endif
    GRID_BAR();
#if PH_MASK & (1 << 11)
    { pg8::Gemm g{XA + (size_t)ROW_X0 * DM, WUP, SEQ, NUP, DM, nullptr, nullptr}; pg8::StaticOrder S; S.init(SEQ, NUP, G, bx); pg8::EpiSwiglu E{HID + (size_t)ROW_X0 * DFF, DFF};
      pg8::gemm_phase<pg8::EpiSwiglu, pg8::StaticOrder, true, true>(lds, g, S, E); }
#endif
    GRID_BAR();
#if PH_MASK & (1 << 12)
    { pg8::Gemm g{HID + (size_t)ROW_X0 * DFF, WDN, SEQ, DM, DFF, nullptr, nullptr}; pg8::StaticOrder S; S.init(SEQ, DM, G, bx); pg8::EpiF32 E{Y + (size_t)ROW_X0 * DM, DM};
      pg8::gemm_phase<pg8::EpiF32, pg8::StaticOrder, true, true>(lds, g, S, E); }
#endif
    GRID_BAR();
#if PH_MASK & (1 << 13)
    {
        for (int R = ROW_X0 + gw; R < MP; R += NGW) {
            float* ho = args.out + (size_t)(R - ROW_X0) * DM;
            f32x4 y[8], h[8], g[8]; load_row(Y + (size_t)R * DM, lane, y); load_row(ho, lane, h); load_row(args.in[I_F2POST], lane, g);
            const float rs = 0.5f / sqrtf(row_ssq(y) * (1.0f / DM) + EPS);
            GAS f32x4* o = (GAS f32x4*)ho + lane;
#pragma unroll
            for (int j = 0; j < 8; ++j) o[64 * j] = h[j] + (y[j] * rs) * g[j];
        }
    }
#endif
}

extern "C" void kernel_launch(void* const* d_in, const int* in_sizes, int n_in, void* d_out, int out_size, void* d_ws, size_t ws_size, hipStream_t stream) {
    static int grid = 0;
    if (grid == 0) {
        if (n_in != 27 || in_sizes[0] != SEQ * DM || out_size != SEQ * DM || ws_size < WS_END) { fprintf(stderr, "kernel_launch: unexpected shapes (n_in %d, in0 %d, out %d, ws %zu); nothing launched\n", n_in, n_in > 0 ? in_sizes[0] : -1, out_size, ws_size); grid = -1; return; }
        int dev = 0, cus = 0, per_cu = 0;
        if (hipGetDevice(&dev) != hipSuccess || hipDeviceGetAttribute(&cus, hipDeviceAttributeMultiprocessorCount, dev) != hipSuccess) { grid = -1; return; }
        if (hipFuncSetAttribute((const void*)mega_fwd, hipFuncAttributeMaxDynamicSharedMemorySize, LDS_BYTES) != hipSuccess) { fprintf(stderr, "kernel_launch: hipFuncSetAttribute failed\n"); grid = -1; return; }
        if (hipOccupancyMaxActiveBlocksPerMultiprocessor(&per_cu, (const void*)mega_fwd, NTHREADS, LDS_BYTES) != hipSuccess || per_cu < 1) { fprintf(stderr, "kernel_launch: occupancy query says %d blocks per CU\n", per_cu); (void)hipGetLastError(); grid = -1; return; }
        grid = cus;
    }
    if (grid < 0) return;
    if (hipMemsetAsync((char*)d_ws + WS_CTL, 0, CTL_ZERO_BYTES, stream) != hipSuccess) { fprintf(stderr, "kernel_launch: memset failed\n"); return; }
    Args a{};
    for (int i = 0; i < 27; ++i) a.in[i] = (const float*)d_in[i];
    a.out = (float*)d_out; a.ws = (unsigned char*)d_ws;
    hipLaunchKernelGGL(mega_fwd, dim3(grid), dim3(NTHREADS), LDS_BYTES, stream, a);
}
```
